# Optimizing an MI355X kernel written in HIP

```python
import jax, jax.numpy as jnp
from jax import lax
import numpy as np

D_MODEL = 1024
BATCH = 8
SEQ = 4096
DEPTH = 1

GRID_W = 64
CTX_LEN = 256

F_GROUP_DIM = 64
F_DIM = D_MODEL // 2
F_GROUPS = F_DIM // F_GROUP_DIM
SSM_HEAD_DIM = 64
D_SSM = 3 * D_MODEL // 2
SSM_HEADS = D_SSM // SSM_HEAD_DIM
SSM_GROUPS = 4
D_STATE = 128
CONV_K = 5
CHUNK = 128
D_MIX = F_DIM + D_SSM
CONV_DIM = D_SSM + 2 * SSM_GROUPS * D_STATE
D_IN_PROJ = F_DIM + D_SSM + CONV_DIM + 2 * SSM_HEADS

N_EXPERTS = 16
CAPACITY_FACTOR = 2
D_EXPERT = 2048
N_MOD = 6
EPS = 1e-6

kernel_name = 'hybrid_fnet_ssd_ecmoe_diffusion'


def rms_norm(x, w):
    xf = x.astype(jnp.float32)
    y = xf * lax.rsqrt(jnp.mean(xf * xf, axis=-1, keepdims=True) + EPS)
    return (y * w.astype(jnp.float32)).astype(x.dtype)


def modulate(h, shift, scale):
    return h * (1 + scale) + shift


def centred_dwconv(u, w, b):
    out = lax.conv_general_dilated(
        u, w[:, None, :].astype(u.dtype), window_strides=(1,),
        padding=[(CONV_K // 2, CONV_K // 2)],
        dimension_numbers=('NWC', 'WIO', 'NWC'),
        feature_group_count=u.shape[-1])
    return out + b


def mixer_inputs(h, w_in, conv_w, conv_b, dt_bias):
    bsz, L, _ = h.shape
    proj = h @ w_in
    u_f, z, xbc, dt_raw = jnp.split(proj, [F_DIM, F_DIM + D_SSM, F_DIM + D_SSM + CONV_DIM], axis=-1)
    xbc = jax.nn.silu(centred_dwconv(xbc, conv_w, conv_b))
    xs, bm, cm = jnp.split(xbc, [D_SSM, D_SSM + SSM_GROUPS * D_STATE], axis=-1)
    xs = xs.reshape(bsz, L, SSM_HEADS, SSM_HEAD_DIM)
    bm = bm.reshape(bsz, L, SSM_GROUPS, D_STATE)
    cm = cm.reshape(bsz, L, SSM_GROUPS, D_STATE)
    dt = jax.nn.softplus(dt_raw.astype(jnp.float32).reshape(bsz, L, 2, SSM_HEADS)
                         + dt_bias.astype(jnp.float32))
    return u_f, z, xs, bm, cm, dt[:, :, 0], dt[:, :, 1]


def ssd_chunked(xs, dt, a, bm, cm, h0, with_output):
    bsz, L, H, P = xs.shape
    G, N = bm.shape[2], bm.shape[3]
    HG = H // G
    nc = L // CHUNK
    xs = xs.astype(jnp.float32)
    bm = bm.astype(jnp.float32).reshape(bsz, nc, CHUNK, G, N)
    cm = cm.astype(jnp.float32).reshape(bsz, nc, CHUNK, G, N)
    xdt = (xs * dt[..., None]).reshape(bsz, nc, CHUNK, G, HG, P)
    a_cs = jnp.cumsum((dt * a).reshape(bsz, nc, CHUNK, G, HG), axis=2)
    to_end = jnp.exp(a_cs[:, :, -1:] - a_cs)
    states = jnp.einsum('bclgn,bclgh,bclghp->bcghpn', bm, to_end, xdt)
    chunk_decay = jnp.exp(a_cs[:, :, -1])

    def step(h, inp):
        st, dec = inp
        return dec[..., None, None] * h + st, h

    h_last, h_prev = lax.scan(step, h0.astype(jnp.float32).reshape(bsz, G, HG, P, N),
                              (jnp.moveaxis(states, 1, 0), jnp.moveaxis(chunk_decay, 1, 0)))
    h_last = h_last.reshape(bsz, H, P, N)
    if not with_output:
        return None, h_last
    h_prev = jnp.moveaxis(h_prev, 0, 1)
    lower = jnp.tril(jnp.ones((CHUNK, CHUNK), dtype=bool))
    seg = a_cs[:, :, :, None] - a_cs[:, :, None, :]
    decay = jnp.exp(jnp.where(lower[:, :, None, None], seg, -jnp.inf))
    cb = jnp.einsum('bclgn,bcsgn->bclsg', cm, bm)
    y_diag = jnp.einsum('bclsg,bclsgh,bcsghp->bclghp', cb, decay, xdt)
    y_off = jnp.einsum('bclgn,bcghpn,bclgh->bclghp', cm, h_prev, jnp.exp(a_cs))
    return (y_diag + y_off).reshape(bsz, L, H, P), h_last


def ssd_bidir(xs, bm, cm, dt_f, dt_b, a_log, h0_f, h0_b, with_output):
    a = -jnp.exp(a_log.astype(jnp.float32))
    flip = lambda t: jnp.flip(t, axis=1)
    y_f, h_f = ssd_chunked(xs, dt_f, a[0], bm, cm, h0_f, with_output)
    y_b, h_b = ssd_chunked(flip(xs), flip(dt_b), a[1], flip(bm), flip(cm), h0_b, with_output)
    y = y_f + flip(y_b) if with_output else None
    return y, h_f, h_b


def fourier_mix(u_f, w_fourier):
    bsz, L, _ = u_f.shape
    u = u_f.astype(jnp.float32).reshape(bsz, L, F_GROUPS, F_GROUP_DIM)
    spec = jnp.fft.fft2(u, axes=(1, 3), norm='ortho').real
    out = jnp.einsum('blgi,gij->blgj', spec, w_fourier.astype(jnp.float32))
    return out.reshape(bsz, L, F_DIM).astype(u_f.dtype)


def mixer_out(u_f, y_ssm, xs, z, d_skip, ssm_norm_w, w_fourier, w_out):
    bsz, L, _ = z.shape
    y = y_ssm + d_skip.astype(jnp.float32)[:, None] * xs.astype(jnp.float32)
    y = y.reshape(bsz, L, D_SSM) * jax.nn.silu(z.astype(jnp.float32))
    yg = y.reshape(bsz, L, SSM_GROUPS, D_SSM // SSM_GROUPS)
    yg = yg * lax.rsqrt(jnp.mean(yg * yg, axis=-1, keepdims=True) + EPS)
    y = (yg.reshape(bsz, L, D_SSM) * ssm_norm_w.astype(jnp.float32)).astype(z.dtype)
    return jnp.concatenate([fourier_mix(u_f, w_fourier), y], axis=-1) @ w_out


def ec_moe(h, w_router, w_gate, w_up, w_down):
    bsz, T, _ = h.shape
    cap = CAPACITY_FACTOR * T // N_EXPERTS
    probs = jax.nn.softmax((h @ w_router).astype(jnp.float32), axis=-1)
    vals, idx = lax.top_k(jnp.swapaxes(probs, 1, 2), cap)
    bidx = jnp.arange(bsz)[:, None, None]
    xg = h[bidx, idx]
    g = jnp.einsum('becd,edf->becf', xg, w_gate)
    u = jnp.einsum('becd,edf->becf', xg, w_up)
    y = jnp.einsum('becf,efd->becd', jax.nn.silu(g) * u, w_down) * vals[..., None].astype(h.dtype)
    return jnp.zeros_like(h).at[bidx, idx].add(y)


def setup_inputs(seed: int = 0) -> dict:
    key = jax.random.key(seed)
    ks = jax.random.split(key, 24)
    nrm = lambda k, shape, s: jax.random.normal(k, shape, jnp.float32) * s
    dt0 = jnp.exp(jax.random.uniform(ks[9], (DEPTH, 2, SSM_HEADS), jnp.float32,
                                     np.log(1e-3).astype(np.float32), np.log(1e-1).astype(np.float32)))
    return {
        'x': nrm(ks[0], (BATCH, SEQ, D_MODEL), 1.0),
        'c': nrm(ks[1], (BATCH, D_MODEL), 1.0),
        'ctx': nrm(ks[2], (BATCH, CTX_LEN, D_MODEL), 1.0),
        'c_ctx': nrm(ks[3], (D_MODEL,), 1.0),
        'w_ada': nrm(ks[4], (DEPTH, D_MODEL, N_MOD * D_MODEL), 0.5 * D_MODEL ** -0.5),
        'b_ada': nrm(ks[5], (DEPTH, N_MOD * D_MODEL), 0.02),
        'norm1_w': 1.0 + nrm(ks[6], (DEPTH, D_MODEL), 0.05),
        'w_in': nrm(ks[7], (DEPTH, D_MODEL, D_IN_PROJ), D_MODEL ** -0.5),
        'conv_w': nrm(ks[8], (DEPTH, CONV_K, CONV_DIM), CONV_K ** -0.5),
        'conv_b': nrm(ks[10], (DEPTH, CONV_DIM), 0.02),
        'dt_bias': dt0 + jnp.log(-jnp.expm1(-dt0)),
        'a_log': jnp.log(jax.random.uniform(ks[11], (DEPTH, 2, SSM_HEADS), jnp.float32, 1.0, 16.0)),
        'd_skip': 1.0 + nrm(ks[12], (DEPTH, SSM_HEADS), 0.1),
        'ssm_norm_w': 1.0 + nrm(ks[13], (DEPTH, D_SSM), 0.05),
        'w_fourier': nrm(ks[14], (DEPTH, F_GROUPS, F_GROUP_DIM, F_GROUP_DIM), F_GROUP_DIM ** -0.5),
        'w_out': nrm(ks[15], (DEPTH, D_MIX, D_MODEL), D_MIX ** -0.5),
        'norm2_w': 1.0 + nrm(ks[16], (DEPTH, D_MODEL), 0.05),
        'w_router': nrm(ks[17], (DEPTH, D_MODEL, N_EXPERTS), D_MODEL ** -0.5),
        'w_gate': nrm(ks[18], (DEPTH, N_EXPERTS, D_MODEL, D_EXPERT), D_MODEL ** -0.5),
        'w_up': nrm(ks[19], (DEPTH, N_EXPERTS, D_MODEL, D_EXPERT), D_MODEL ** -0.5),
        'w_down': nrm(ks[20], (DEPTH, N_EXPERTS, D_EXPERT, D_MODEL), D_EXPERT ** -0.5),
        'final_norm_w': 1.0 + nrm(ks[21], (D_MODEL,), 0.05),
    }


def reference(x, c, ctx, c_ctx, w_ada, b_ada, norm1_w, w_in, conv_w, conv_b, dt_bias, a_log,
              d_skip, ssm_norm_w, w_fourier, w_out, norm2_w, w_router, w_gate, w_up, w_down,
              final_norm_w):
    bsz = x.shape[0]
    for layer in range(DEPTH):
        last = layer == DEPTH - 1
        mod_l = (jax.nn.silu(c) @ w_ada[layer] + b_ada[layer]).reshape(bsz, N_MOD, 1, D_MODEL)
        mod_c = (jax.nn.silu(c_ctx) @ w_ada[layer] + b_ada[layer]).reshape(N_MOD, D_MODEL)
        sh1, sc1, g1, sh2, sc2, g2 = [mod_l[:, i] for i in range(N_MOD)]
        csh1, csc1, cg1, csh2, csc2, cg2 = [mod_c[i] for i in range(N_MOD)]

        h_c = modulate(rms_norm(ctx, norm1_w[layer]), csh1, csc1)
        u_fc, z_c, xs_c, bm_c, cm_c, dtf_c, dtb_c = mixer_inputs(
            h_c, w_in[layer], conv_w[layer], conv_b[layer], dt_bias[layer])
        zeros = jnp.zeros((bsz, SSM_HEADS, SSM_HEAD_DIM, D_STATE), jnp.float32)
        y_c, h_f, h_b = ssd_bidir(xs_c, bm_c, cm_c, dtf_c, dtb_c, a_log[layer], zeros, zeros, not last)

        h_l = modulate(rms_norm(x, norm1_w[layer]), sh1, sc1)
        u_fl, z_l, xs_l, bm_l, cm_l, dtf_l, dtb_l = mixer_inputs(
            h_l, w_in[layer], conv_w[layer], conv_b[layer], dt_bias[layer])
        y_l, _, _ = ssd_bidir(xs_l, bm_l, cm_l, dtf_l, dtb_l, a_log[layer], h_f, h_b, True)
        x = x + g1 * mixer_out(u_fl, y_l, xs_l, z_l, d_skip[layer], ssm_norm_w[layer],
                               w_fourier[layer], w_out[layer])
        if not last:
            ctx = ctx + cg1 * mixer_out(u_fc, y_c, xs_c, z_c, d_skip[layer], ssm_norm_w[layer],
                                        w_fourier[layer], w_out[layer])

        x = x + g2 * ec_moe(modulate(rms_norm(x, norm2_w[layer]), sh2, sc2),
                            w_router[layer], w_gate[layer], w_up[layer], w_down[layer])
        if not last:
            ctx = ctx + cg2 * ec_moe(modulate(rms_norm(ctx, norm2_w[layer]), csh2, csc2),
                                     w_router[layer], w_gate[layer], w_up[layer], w_down[layer])
    return rms_norm(x, final_norm_w)
```

```cpp
#include <hip/hip_runtime.h>
#include <hip/hip_cooperative_groups.h>
#include <cstdio>
namespace cg = cooperative_groups;

#define LAS __attribute__((address_space(3)))
#define DI __device__ __forceinline__
typedef unsigned short bf16_t;
typedef short bf16x8 __attribute__((ext_vector_type(8)));
typedef short s16x4 __attribute__((ext_vector_type(4)));
typedef float f32x4 __attribute__((ext_vector_type(4)));
typedef float f32x16 __attribute__((ext_vector_type(16)));
typedef unsigned u32x4 __attribute__((ext_vector_type(4)));
typedef unsigned u32x2 __attribute__((ext_vector_type(2)));

constexpr int NB = 8, SEQ = 4096, DM = 1024, CTXL = 256;
constexpr int NTOK = NB * SEQ;
constexpr int NCTX = NB * CTXL;
constexpr int NROWS = NTOK + NCTX;
constexpr int DIN = 4656, DIN_T = 4864;
constexpr int DSSM = 1536, NH = 24, HD = 64, NG = 4, DST = 128, CONVD = 2560, DMIX = 2048;
constexpr int NE = 16, CAP = 512, DEXP = 2048;
constexpr int LDS_BYTES = 163840;

constexpr size_t MB = 1u << 20;
constexpr size_t WS_MOD   = 4096;
constexpr size_t WS_WOUT  = 1 * MB;
constexpr size_t WS_WIN   = WS_WOUT + (size_t)DM * DMIX * 2;
constexpr size_t WS_R1    = WS_WIN + (size_t)DIN_T * DM * 2;
constexpr size_t WS_R2    = WS_R1 + (size_t)NROWS * DM * 2;
constexpr size_t WS_R4    = WS_R2 + (size_t)NTOK * DM * 2;
constexpr size_t WS_R5    = WS_R4 + (size_t)NROWS * CONVD * 2;
constexpr size_t WS_XS    = WS_R5 + (size_t)NROWS * 48 * 4;
constexpr size_t WS_BM    = WS_XS + (size_t)NROWS * DSSM * 2;
constexpr size_t WS_CM    = WS_BM + (size_t)NROWS * 512 * 2;
constexpr size_t WS_CB    = WS_CM + (size_t)NROWS * 512 * 2;
constexpr size_t WS_SS    = WS_CB + (size_t)NB * 32 * NG * 16384 * 2;
constexpr size_t WS_ARRS  = WS_SS + (size_t)NTOK * NH * 4;
constexpr int ARN = 1152;
constexpr size_t WS_END1  = WS_ARRS + (size_t)NB * 34 * NH * ARN * 4;

constexpr size_t WS_ROWMAP = 256 * 1024;
constexpr size_t WS_VAL    = 512 * 1024;
constexpr size_t WS_WGU    = WS_R2;
constexpr size_t WS_WD     = WS_R4 + (size_t)NTOK * DMIX * 2;
constexpr size_t WS_H2     = WS_R1;
constexpr size_t WS_ACT    = WS_XS;
constexpr size_t WS_PROBS  = WS_ACT + (size_t)NE * NB * CAP * DEXP;
constexpr size_t WS_INV    = WS_PROBS + (size_t)NB * NE * SEQ * 4;
constexpr size_t WS_YB     = WS_R4;
constexpr size_t WS_X1     = WS_INV + (size_t)NTOK * NE * 4;
constexpr size_t WS_END2   = WS_X1 + (size_t)NTOK * DM * 2;
constexpr size_t WS_BAR    = 768 * 1024;
static_assert(WS_WD + (size_t)NE * DM * DEXP <= WS_R5 && WS_WGU + (size_t)NE * 4096 * DM <= WS_R4 && WS_END2 <= WS_SS && WS_H2 + (size_t)NTOK * DM <= WS_R2, "MoE stage layout");
constexpr size_t WS_NEED   = WS_END1 > WS_END2 ? WS_END1 : WS_END2;

typedef __bf16 bf16v2 __attribute__((ext_vector_type(2)));
typedef float f32v2 __attribute__((ext_vector_type(2)));
DI unsigned cvt_pk_bf16(float lo, float hi) { f32v2 f = {lo, hi}; bf16v2 h = __builtin_convertvector(f, bf16v2); return __builtin_bit_cast(unsigned, h); }
DI bf16_t f2bf(float f) { return (bf16_t)(cvt_pk_bf16(f, 0.f) & 0xffffu); }
DI float bf2f(bf16_t b) { return __uint_as_float(((unsigned)b) << 16); }
DI float silu_f(float x) { return x * __builtin_amdgcn_rcpf(1.f + __expf(-x)); }
DI float softplus_f(float x) { return fmaxf(x, 0.f) + log1pf(__expf(-fabsf(x))); }
DI float wave_sum(float v) {
#pragma unroll
    for (int o = 1; o < 64; o <<= 1) v += __shfl_xor(v, o);
    return v;
}
DI unsigned pk_fp8x4(float a, float b, float c, float d) { unsigned w = 0u; w = __builtin_amdgcn_cvt_pk_fp8_f32(a, b, w, false); w = __builtin_amdgcn_cvt_pk_fp8_f32(c, d, w, true); return w; }
DI void lds_wait() { asm volatile("s_waitcnt lgkmcnt(0)" ::: "memory"); }
DI void lds_barrier() { asm volatile("s_waitcnt lgkmcnt(0)" ::: "memory"); __builtin_amdgcn_s_barrier(); asm volatile("" ::: "memory"); }

namespace pg8 {
constexpr int BM = 256, BK = 64, HALF = 128, HTB = HALF * BK * 2, STAGE_BYTES = 8 * HTB;
DI int lds_byte(int r, int c) { const int st = (r >> 4) * 2 + (c >> 5), rr = r & 15, cc = c & 31, ob = rr * 64 + cc * 2; return st * 1024 + (ob ^ (((ob >> 9) & 1) << 5)); }
DI void stage_rc(int b, int& R, int& C) { const int st = b / 1024, sb = b % 1024, swz = sb ^ (((sb >> 9) & 1) << 5); R = (st >> 1) * 16 + swz / 64; C = (st & 1) * 32 + (swz % 64) / 2; }
DI int perm32(int rho) { const int n = rho >> 4, i = rho & 15; return 8 * (i >> 2) + 4 * n + (i & 3); }
struct Unit { int pm, pn; };

template <class Ord>
DI void a_offsets(const Ord& S, const Unit& u, int KB, int tid, unsigned (&ao)[2][2]) {
#pragma unroll
    for (int h = 0; h < 2; ++h)
#pragma unroll
        for (int i = 0; i < 2; ++i) { int R, C; stage_rc(tid * 16 + i * 8192, R, C); const int r = S.rowmap[u.pm * BM + h * HALF + R]; ao[h][i] = (unsigned)r * (unsigned)KB + (unsigned)C * 2u; }
}

typedef int i32x4v __attribute__((ext_vector_type(4)));
typedef int i32x8v __attribute__((ext_vector_type(8)));
DI i32x8v cat8(bf16x8 a, bf16x8 b) { return __builtin_shufflevector(__builtin_bit_cast(i32x4v, a), __builtin_bit_cast(i32x4v, b), 0, 1, 2, 3, 4, 5, 6, 7); }
template <bool FP8, bool RS, class Epi, class Ord>
DI void gemm_phase(LAS unsigned char* lds, const void* A, const void* Bt, const int KB, const Ord& S, const Epi& E, const LAS float* rs_tab = nullptr) {
    int tid_ = threadIdx.x; asm volatile("" : "+v"(tid_));
    const int tid = tid_, wid = __builtin_amdgcn_readfirstlane(tid >> 6), lane = tid & 63, wr = wid >> 2, wc = wid & 3, fr = lane & 15, fq = lane >> 4;
    const int nt = KB / 128;
    constexpr bool GA = Ord::GATHER;
    unsigned voffA[2], voffB[2];
#pragma unroll
    for (int i = 0; i < 2; ++i) { int R, C; stage_rc(tid * 16 + i * 8192, R, C); const int Rb = Epi::PERM ? ((R & ~31) + perm32(R & 31)) : R; voffA[i] = (unsigned)(R * KB + C * 2); voffB[i] = (unsigned)(Rb * KB + C * 2); }
    const size_t tstep = (size_t)BM * KB;
    const size_t kstep = (size_t)(BK * 2);
    const size_t hstep = (size_t)HALF * KB;
    const unsigned ldsw = (unsigned)wid * 1024u;
    const int aoff = lds_byte(wr * 64 + fr, fq * 8), boff = lds_byte(wc * 32 + fr, fq * 8);
#define PG8_SA(b, h) (((b) * 2 + (h)) * HTB)
#define PG8_SB(b, h) ((4 + (b) * 2 + (h)) * HTB)
#define PG8_STAGE(bufoff, gbase, voff) do { _Pragma("unroll") for (int _i = 0; _i < 2; ++_i) \
        __builtin_amdgcn_global_load_lds((const unsigned*)((const char*)(gbase) + (voff)[_i]), (LAS unsigned*)(lds + (bufoff) + ldsw + _i * 8192), 16, 0, 0); } while (0)
#define PG8_LDA(dst, b, h) do { _Pragma("unroll") for (int m = 0; m < 4; ++m) dst[m] = cat8(*(const LAS bf16x8*)(lds + PG8_SA(b, h) + aoff + m * 2048), *(const LAS bf16x8*)(lds + PG8_SA(b, h) + aoff + m * 2048 + 1024)); } while (0)
#define PG8_LDB(dst, b, h) do { _Pragma("unroll") for (int n = 0; n < 2; ++n) dst[n] = cat8(*(const LAS bf16x8*)(lds + PG8_SB(b, h) + boff + n * 2048), *(const LAS bf16x8*)(lds + PG8_SB(b, h) + boff + n * 2048 + 1024)); } while (0)
#define PG8_LO(v) __builtin_bit_cast(bf16x8, __builtin_shufflevector(v, v, 0, 1, 2, 3))
#define PG8_HI(v) __builtin_bit_cast(bf16x8, __builtin_shufflevector(v, v, 4, 5, 6, 7))
#define PG8_MMA(ai, bj, At, Bt_) do { __builtin_amdgcn_s_setprio(1); _Pragma("unroll") for (int m = 0; m < 4; ++m) _Pragma("unroll") for (int n = 0; n < 2; ++n) { \
        if constexpr (FP8) asm volatile("v_mfma_scale_f32_16x16x128_f8f6f4 %0, %1, %2, %0, %3, %4 op_sel_hi:[0,0,0]" : "+v"(acc[ai][bj][m][n]) : "v"(Bt_[n]), "v"(At[m]), "v"(scl_w), "v"(scl_a)); \
        else { acc[ai][bj][m][n] = __builtin_amdgcn_mfma_f32_16x16x32_bf16(PG8_LO(Bt_[n]), PG8_LO(At[m]), acc[ai][bj][m][n], 0, 0, 0); \
               acc[ai][bj][m][n] = __builtin_amdgcn_mfma_f32_16x16x32_bf16(PG8_HI(Bt_[n]), PG8_HI(At[m]), acc[ai][bj][m][n], 0, 0, 0); } } \
        __builtin_amdgcn_s_setprio(0); } while (0)
#define PG8_WAIT_V(n) asm volatile("s_waitcnt vmcnt(" #n ")" ::: "memory")
#define PG8_WAIT_L(n) asm volatile("s_waitcnt lgkmcnt(" #n ")" ::: "memory")
#define PG8_BAR __builtin_amdgcn_s_barrier()
#define PG8_SCHED __builtin_amdgcn_sched_barrier(0)
    Unit cur, nxt; int ui = 0;
    if (!S.next(0, cur)) return;
    f32x4 acc[2][2][4][2];
#pragma unroll
    for (int a = 0; a < 2; ++a)
#pragma unroll
        for (int b = 0; b < 2; ++b)
#pragma unroll
            for (int m = 0; m < 4; ++m)
#pragma unroll
                for (int n = 0; n < 2; ++n) acc[a][b][m][n] = (f32x4){0.f, 0.f, 0.f, 0.f};
    i32x8v At[4], B0[2], B1[2];
    const int scl_w = 0x7a7a7a7a, scl_a = 0x7f7f7f7f;
    unsigned aoc[2][2], aon[2][2];
    if constexpr (GA) a_offsets(S, cur, KB, tid, aoc);
    const char* const Ab = (const char*)A;
    const char* cA = GA ? Ab : Ab + (size_t)cur.pm * tstep;
#define PG8_AP(p, h) (GA ? (p) : (p) + (h) * hstep)
#define PG8_AO(o, h) (GA ? (o)[h] : voffA)
    const char* cB = (const char*)Bt + S.bt_row0(cur) * (size_t)KB;
    PG8_STAGE(PG8_SB(0, 0), cB, voffB); PG8_STAGE(PG8_SA(0, 0), PG8_AP(cA, 0), PG8_AO(aoc, 0)); PG8_STAGE(PG8_SB(0, 1), cB + hstep, voffB); PG8_STAGE(PG8_SA(0, 1), PG8_AP(cA, 1), PG8_AO(aoc, 1));
    if (wr == 1) PG8_BAR;
    PG8_WAIT_V(4); PG8_BAR;
    PG8_STAGE(PG8_SB(1, 0), cB + kstep, voffB); PG8_STAGE(PG8_SA(1, 0), PG8_AP(cA + kstep, 0), PG8_AO(aoc, 0)); PG8_STAGE(PG8_SB(1, 1), cB + hstep + kstep, voffB);
    PG8_WAIT_V(6); PG8_BAR;
    for (;;) {
        const bool has_next = S.next(ui + 1, nxt);
        const char* nB = cB; const char* nA = cA;
        if (has_next) { if constexpr (GA) a_offsets(S, nxt, KB, tid, aon); else nA = Ab + (size_t)nxt.pm * tstep; nB = (const char*)Bt + S.bt_row0(nxt) * (size_t)KB; }
        else if constexpr (GA) {
#pragma unroll
            for (int h = 0; h < 2; ++h)
#pragma unroll
                for (int i = 0; i < 2; ++i) aon[h][i] = aoc[h][i];
        }
#pragma unroll 1
        for (int t = 0; t < nt; t += 2) {
            const bool last = (t == nt - 2);
            float rsv[2][4]; bool rs_now = false;
            if constexpr (RS) { const int tn = t + 2; rs_now = (tn >= 8) && ((tn - 8) % 6 == 0);
                if (rs_now) { const int bi = (tn - 8) / 6; const LAS float* tb = rs_tab + (size_t)(ui & 1) * 256 * 8 + bi;
#pragma unroll
                    for (int ai = 0; ai < 2; ++ai)
#pragma unroll
                        for (int m = 0; m < 4; ++m) rsv[ai][m] = tb[(ai * HALF + wr * 64 + m * 16 + fr) * 8]; } }
            const char* a1 = cA + (size_t)(t + 1) * kstep;
            const char* a2 = last ? nA : cA + (size_t)(t + 2) * kstep; const char* b2 = last ? nB : cB + (size_t)(t + 2) * kstep;
            const char* a3 = a2 + kstep; const char* b3 = b2 + kstep;
            unsigned o2[2][2];
            if constexpr (GA) {
#pragma unroll
                for (int h = 0; h < 2; ++h)
#pragma unroll
                    for (int i = 0; i < 2; ++i) o2[h][i] = last ? aon[h][i] : aoc[h][i];
            }
            PG8_LDB(B0, 0, 0); PG8_SCHED; PG8_LDA(At, 0, 0); PG8_STAGE(PG8_SA(1, 1), PG8_AP(a1, 1), PG8_AO(aoc, 1));
            PG8_WAIT_L(8); PG8_BAR; PG8_WAIT_L(0); PG8_MMA(0, 0, At, B0); PG8_BAR; PG8_SCHED;
            PG8_LDB(B1, 0, 1); PG8_STAGE(PG8_SB(0, 0), b2, voffB);
            PG8_BAR; PG8_WAIT_L(0); PG8_MMA(0, 1, At, B1); PG8_BAR;
            PG8_LDA(At, 0, 1); PG8_STAGE(PG8_SA(0, 0), PG8_AP(a2, 0), PG8_AO(o2, 0));
            PG8_BAR; PG8_WAIT_L(0); PG8_MMA(1, 0, At, B0); PG8_BAR; PG8_SCHED;
            PG8_STAGE(PG8_SB(0, 1), b2 + hstep, voffB);
            PG8_WAIT_V(6); PG8_BAR; PG8_MMA(1, 1, At, B1); PG8_BAR;
            PG8_LDB(B0, 1, 0); PG8_SCHED; PG8_LDA(At, 1, 0); PG8_STAGE(PG8_SA(0, 1), PG8_AP(a2, 1), PG8_AO(o2, 1));
            PG8_WAIT_L(8); PG8_BAR; PG8_WAIT_L(0); PG8_MMA(0, 0, At, B0); PG8_BAR; PG8_SCHED;
            PG8_LDB(B1, 1, 1); PG8_STAGE(PG8_SB(1, 0), b3, voffB);
            PG8_BAR; PG8_WAIT_L(0); PG8_MMA(0, 1, At, B1); PG8_BAR;
            PG8_LDA(At, 1, 1); PG8_STAGE(PG8_SA(1, 0), PG8_AP(a3, 0), PG8_AO(o2, 0));
            PG8_BAR; PG8_WAIT_L(0); PG8_MMA(1, 0, At, B0); PG8_BAR; PG8_SCHED;
            PG8_STAGE(PG8_SB(1, 1), b3 + hstep, voffB);
            PG8_WAIT_V(6); PG8_BAR; PG8_MMA(1, 1, At, B1); PG8_BAR;
            if constexpr (RS) { if (rs_now) {
#pragma unroll
                for (int ai = 0; ai < 2; ++ai)
#pragma unroll
                    for (int bj = 0; bj < 2; ++bj)
#pragma unroll
                        for (int m = 0; m < 4; ++m)
#pragma unroll
                            for (int n = 0; n < 2; ++n) acc[ai][bj][m][n] = acc[ai][bj][m][n] * rsv[ai][m]; } }
        }
        if constexpr (FP8) asm volatile("s_nop 15\n\ts_nop 15" ::: "memory");
        E(acc, cur, wr, wc, fr, fq);
        if (!has_next) break;
#pragma unroll
        for (int a = 0; a < 2; ++a)
#pragma unroll
            for (int b = 0; b < 2; ++b)
#pragma unroll
                for (int m = 0; m < 4; ++m)
#pragma unroll
                    for (int n = 0; n < 2; ++n) acc[a][b][m][n] = (f32x4){0.f, 0.f, 0.f, 0.f};
        cur = nxt; cB = nB; cA = nA; ++ui;
        if constexpr (GA) {
#pragma unroll
            for (int h = 0; h < 2; ++h)
#pragma unroll
                for (int i = 0; i < 2; ++i) aoc[h][i] = aon[h][i];
        }
    }
    PG8_WAIT_V(0);
    if (wr == 0) PG8_BAR;
    PG8_BAR;
#undef PG8_AP
#undef PG8_AO
#undef PG8_SA
#undef PG8_SB
#undef PG8_STAGE
#undef PG8_LO
#undef PG8_HI
#undef PG8_LDA
#undef PG8_LDB
#undef PG8_MMA
#undef PG8_WAIT_V
#undef PG8_WAIT_L
#undef PG8_BAR
#undef PG8_SCHED
}

struct RectOrder {
    static constexpr bool GATHER = false;
    const int* rowmap;
    int nM, nN, nwg, G, c, nextra, ex_m0, ex_n0, ex_nm;
    DI void init(int nM_, int nN_, int G_, int c_) { nM = nM_; nN = nN_; nwg = nM * nN; G = G_; c = c_; nextra = 0; ex_m0 = ex_n0 = 0; ex_nm = 1; rowmap = nullptr; }
    DI bool next(int i, Unit& u) const {
        const int L = i * G + c; if (L >= nwg + nextra) return false;
        if (L >= nwg) { const int e = L - nwg; u.pm = ex_m0 + e % ex_nm; u.pn = ex_n0 + e / ex_nm; return true; }
        int wgid = L; { const int q = nwg / 8, r = nwg % 8, xcd = wgid % 8, off = wgid / 8; wgid = (xcd < r ? xcd * (q + 1) : r * (q + 1) + (xcd - r) * q) + off; }
        const int nig = 8 * nN, gid = wgid / nig, fm = gid * 8, gsz = (nM - fm) < 8 ? (nM - fm) : 8;
        u.pm = fm + ((wgid % nig) % gsz); u.pn = (wgid % nig) / gsz; return true;
    }
    DI size_t bt_row0(const Unit& u) const { return (size_t)u.pn * BM; }
};
}


#define XB_TMO      128
#define XB_XCNT(j)  (256  + 64 * (j))
#define XB_XSUB(j)  (1280 + 64 * (j))
#define XB_XGEN(j)  (2304 + 64 * (j))
#define XB_TOP      3328
#define XB_TOPGEN   3392
#define XCD_BAR_WORDS 3456
#define XB_SPIN_CAP (1u << 18)
DI unsigned xb_ld(unsigned* p)              { return __hip_atomic_load(p, __ATOMIC_RELAXED, __HIP_MEMORY_SCOPE_AGENT); }
DI unsigned xb_add(unsigned* p, unsigned v) { return __hip_atomic_fetch_add(p, v, __ATOMIC_RELAXED, __HIP_MEMORY_SCOPE_AGENT); }
DI unsigned xb_xcc_id() { return (unsigned)__builtin_amdgcn_s_getreg((3 << 11) | 20) & 0xFu; }
#define XB_SPIN(cond, bar) do { unsigned _sp = 0; while (cond) { __builtin_amdgcn_s_sleep(1); \
    if ((++_sp & 255u) == 0u) { if (xb_ld(&(bar)[XB_TMO])) break; if (_sp > XB_SPIN_CAP) { atomicAdd(&(bar)[XB_TMO], 1u); break; } } } } while (0)
struct XcdBarrier { unsigned* bar; unsigned x; volatile LAS unsigned* st; };
DI XcdBarrier xcd_barrier_post(unsigned* bar, volatile LAS unsigned* st) {
    XcdBarrier b; b.bar = bar; b.x = xb_xcc_id(); b.st = st;
    if (threadIdx.x == 0) (void)xb_add(&bar[XB_XCNT(b.x)], 1u);
    return b;
}
DI void xcd_barrier_complete(unsigned* bar, unsigned x, unsigned& nloc, unsigned& nx) {
    const unsigned G = gridDim.x * gridDim.y * gridDim.z;
    unsigned sum, cnt, mine, sp = 0u;
    for (;;) {
        sum = 0u; cnt = 0u; mine = 0u;
#pragma unroll
        for (unsigned j = 0; j < 16; ++j) { const unsigned c = xb_ld(&bar[XB_XCNT(j)]); sum += c; cnt += (c > 0u) ? 1u : 0u; mine = (j == x) ? c : mine; }
        if (sum == G) break;
        __builtin_amdgcn_s_sleep(1);
        if ((++sp & 255u) == 0u) { if (xb_ld(&bar[XB_TMO])) break; if (sp > XB_SPIN_CAP) { atomicAdd(&bar[XB_TMO], 1u); break; } }
    }
    nloc = mine > 0u ? mine : 1u; nx = cnt > 0u ? cnt : 1u;
}
DI void xcd_barrier(const XcdBarrier& b) {
    asm volatile("s_waitcnt vmcnt(0)" ::: "memory");
    __syncthreads();
    if (threadIdx.x == 0) {
        unsigned* bar = b.bar;
        __builtin_amdgcn_s_waitcnt(0);
        unsigned nloc = b.st[0], nx = b.st[1];
        if (nloc == 0u) { xcd_barrier_complete(bar, b.x, nloc, nx); b.st[0] = nloc; b.st[1] = nx; }
        const unsigned old = xb_add(&bar[XB_XSUB(b.x)], 1u);
        const unsigned gen = old / nloc;
        if (old + 1u == (gen + 1u) * nloc) {
            __builtin_amdgcn_fence(__ATOMIC_RELEASE, "agent");
            asm volatile("s_waitcnt vmcnt(0)" ::: "memory");
            const unsigned og = xb_add(&bar[XB_TOP], 1u);
            const unsigned tg = og / nx;
            if (og + 1u == (tg + 1u) * nx) xb_add(&bar[XB_TOPGEN], 1u);
            else XB_SPIN(xb_ld(&bar[XB_TOPGEN]) == tg, bar);
            __builtin_amdgcn_fence(__ATOMIC_ACQUIRE, "agent");
            xb_add(&bar[XB_XGEN(b.x)], 1u);
            asm volatile("s_waitcnt vmcnt(0)" ::: "memory");
        } else {
            XB_SPIN(xb_ld(&bar[XB_XGEN(b.x)]) == gen, bar);
            __builtin_amdgcn_fence(__ATOMIC_ACQUIRE, "agent");
            asm volatile("s_waitcnt vmcnt(0)" ::: "memory");
        }
    }
    __syncthreads();
}

struct Params {
    const float* in[22];
    float* out;
    unsigned char* ws;
};

DI const float* kin(int i) {
    const __attribute__((address_space(4))) char* ka = (const __attribute__((address_space(4))) char*)__builtin_amdgcn_kernarg_segment_ptr();
    asm volatile("" : "+s"(ka));
    return *(const float* const __attribute__((address_space(4)))*)(ka + 8 * i);
}
struct Ctx;
DI void relaunder(Ctx& F);
struct Ctx {
    LAS unsigned char* lds;
    int tid, lane, wave, G, bid;
    float* out; unsigned char* ws;
};

DI void relaunder(Ctx& F) { int t = threadIdx.x; asm volatile("" : "+v"(t)); F.tid = t; F.lane = t & 63; F.wave = __builtin_amdgcn_readfirstlane(t >> 6); }

constexpr int TR_SCR = 64 * 65 * 4;
DI void transpose_item(const float* W, int ldw, int k0, int c0, int ncols, bf16_t* WT, int K, LAS float* scr, int lane, const float* kscale = nullptr) {
    const int r4 = lane >> 4, c4 = (lane & 15) * 4;
    f32x4 v[16];
#pragma unroll
    for (int i = 0; i < 16; ++i) { v[i] = (c4 < ncols) ? *(const f32x4*)(W + (size_t)(k0 + 4 * i + r4) * ldw + c0 + c4) : (f32x4){0.f, 0.f, 0.f, 0.f};
        if (kscale) v[i] = v[i] * kscale[4 * i + r4]; }
#pragma unroll
    for (int i = 0; i < 16; ++i) { LAS float* d = scr + (4 * i + r4) * 65 + c4; d[0] = v[i].x; d[1] = v[i].y; d[2] = v[i].z; d[3] = v[i].w; }
    lds_wait();
    const int c = lane & 7;
#pragma unroll
    for (int j = 0; j < 8; ++j) { const int n = (lane >> 3) + 8 * j; const LAS float* s = scr + (8 * c) * 65 + n;
        u32x4 o; o.x = cvt_pk_bf16(s[0 * 65], s[1 * 65]); o.y = cvt_pk_bf16(s[2 * 65], s[3 * 65]); o.z = cvt_pk_bf16(s[4 * 65], s[5 * 65]); o.w = cvt_pk_bf16(s[6 * 65], s[7 * 65]);
        if (n < ncols) *(u32x4*)(WT + (size_t)n * K + k0 + 8 * c) = o; }
    lds_wait();
}

DI void transpose_item_f8(const float* W, int ldw, int k0, int c0, unsigned char* WT, int KBy, LAS float* scr, int lane) {
    const int r4 = lane >> 4, c4 = (lane & 15) * 4;
    f32x4 v[16];
#pragma unroll
    for (int i = 0; i < 16; ++i) v[i] = *(const f32x4*)(W + (size_t)(k0 + 4 * i + r4) * ldw + c0 + c4);
#pragma unroll
    for (int i = 0; i < 16; ++i) { LAS float* d = scr + (4 * i + r4) * 65 + c4; d[0] = v[i].x; d[1] = v[i].y; d[2] = v[i].z; d[3] = v[i].w; }
    lds_wait();
    const int c = lane & 7;
#pragma unroll
    for (int j = 0; j < 8; ++j) { const int n = (lane >> 3) + 8 * j; const LAS float* s = scr + (8 * c) * 65 + n;
        u32x2 o; o.x = pk_fp8x4(s[0 * 65] * 32.f, s[1 * 65] * 32.f, s[2 * 65] * 32.f, s[3 * 65] * 32.f); o.y = pk_fp8x4(s[4 * 65] * 32.f, s[5 * 65] * 32.f, s[6 * 65] * 32.f, s[7 * 65] * 32.f);
        *(u32x2*)(WT + (size_t)n * KBy + k0 + 8 * c) = o; }
    lds_wait();
}

DI void ttab_item(const float* wf, float* TTAB, int item, const LAS float* trg  , int lane) {
    const int ib = item & 7, gc = item >> 3, g = gc & 7, cs = gc >> 3;
    const float* wfg = wf + (size_t)g * 4096;
    float wv[64];
#pragma unroll
    for (int m = 0; m < 64; ++m) wv[m] = wfg[m * 64 + lane];
#pragma unroll 1
    for (int ii = 0; ii < 8; ++ii) { const int i = ib * 8 + ii; float t = 0.f;
#pragma unroll
        for (int m = 0; m < 64; ++m) t += trg[2 * ((m * i) & 63) + cs] * wv[m];
        TTAB[((size_t)gc * 64 + i) * 64 + lane] = t; }
}
DI void fold_item(const float* w_in, const float* TTAB, bf16_t* Win_t, int item, LAS float* scr  , int lane) {
    const int kb = item & 15, gc = item >> 4, g = gc & 7, cs = gc >> 3;
    { const f32x4* tp = (const f32x4*)(TTAB + (size_t)gc * 4096) + lane;
#pragma unroll
      for (int i = 0; i < 16; ++i) *(LAS f32x4*)(scr + 4 * (lane + 64 * i)) = tp[64 * i]; }
    lds_wait();
    bf16_t* dst = Win_t + (size_t)(cs * 512 + g * 64 + lane) * DM + kb * 64;
#pragma unroll 1
    for (int k8 = 0; k8 < 8; ++k8) {
        float a[8], wv[8];
#pragma unroll
        for (int q = 0; q < 8; ++q) { a[q] = 0.f; wv[q] = w_in[(size_t)(kb * 64 + k8 * 8 + q) * DIN + g * 64 + lane]; }
#pragma unroll
        for (int i = 0; i < 64; ++i) { const float t = scr[i * 64 + lane];
#pragma unroll
            for (int q = 0; q < 8; ++q) a[q] += __builtin_bit_cast(float, __builtin_amdgcn_readlane(__builtin_bit_cast(int, wv[q]), i)) * t; }
        u32x4 o; o.x = cvt_pk_bf16(a[0], a[1]); o.y = cvt_pk_bf16(a[2], a[3]); o.z = cvt_pk_bf16(a[4], a[5]); o.w = cvt_pk_bf16(a[6], a[7]);
        *(u32x4*)(dst + k8 * 8) = o;
    }
    lds_wait();
}

DI void phase0(Ctx& F) {
    relaunder(F);
    const float* c = kin(1); const float* c_ctx = kin(3); const float* w_ada = kin(4); const float* b_ada = kin(5);
    float* MOD = (float*)(F.ws + WS_MOD);
    if (F.bid < 96) {
        LAS float* SC = (LAS float*)F.lds;
        LAS float* RED = (LAS float*)(F.lds + 9 * 1024 * 4);
        for (int i = F.tid; i < 9 * 1024; i += 512) { const float v = (i < 8192) ? c[i] : c_ctx[i - 8192]; SC[i] = silu_f(v); }
        __syncthreads();
        for (int u = F.bid; u < 96; u += F.G) {
            const int n = u * 64 + F.lane;
            float a[9];
#pragma unroll
            for (int b = 0; b < 9; ++b) a[b] = 0.f;
            const float* wp = w_ada + (size_t)(F.wave * 128) * 6144 + n;
#pragma unroll 4
            for (int k = 0; k < 128; ++k) { const float w = wp[(size_t)k * 6144];
#pragma unroll
                for (int b = 0; b < 9; ++b) a[b] += SC[b * 1024 + F.wave * 128 + k] * w; }
#pragma unroll
            for (int b = 0; b < 9; ++b) RED[(F.wave * 9 + b) * 64 + F.lane] = a[b];
            __syncthreads();
            for (int i = F.tid; i < 9 * 64; i += 512) { float s = 0.f;
#pragma unroll
                for (int w = 0; w < 8; ++w) s += RED[w * 576 + i];
                const int b = i >> 6, nn = u * 64 + (i & 63); MOD[b * 6144 + nn] = s + b_ada[nn]; }
            __syncthreads();
        }
    }
    __syncthreads();
    LAS float* scr = (LAS float*)(F.lds + F.wave * TR_SCR);
    LAS float* trg = (LAS float*)(F.lds + 8 * TR_SCR);
    if (F.tid < 64) { float s, c; sincospif((float)F.tid * (1.f / 32.f), &s, &c); trg[2 * F.tid] = c; trg[2 * F.tid + 1] = s; }
    __syncthreads();
    const int gw = F.bid * 8 + F.wave, NGW = F.G * 8;
    const float* w_in = kin(7); const float* w_out = kin(15); const float* wf = kin(14);
    bf16_t* Win_t = (bf16_t*)(F.ws + WS_WIN); bf16_t* Wout_t = (bf16_t*)(F.ws + WS_WOUT);
    float* TTAB = (float*)(F.ws + WS_SS);
    constexpr int I_IN = 16 * 73, I_OUT = 32 * 16, I_FOLD = 128, I_ZERO = 208;
    for (int it = gw; it < I_IN + I_OUT + I_FOLD + I_ZERO; it += NGW) {
        int r = it;
        if (r < I_FOLD) { ttab_item(wf, TTAB, r, trg, F.lane); continue; } r -= I_FOLD;
        if (r < I_IN) { const int kb = r / 73, nb = r % 73; const int ncols = (nb == 72) ? 48 : 64;
            transpose_item(w_in, DIN, kb * 64, nb * 64, ncols, Win_t + (size_t)(nb * 64) * DM, DM, scr, F.lane); continue; } r -= I_IN;
        if (r < I_OUT) { const int kb = r / 16, nb = r % 16; transpose_item(w_out, DM, kb * 64, nb * 64, 64, Wout_t + (size_t)(nb * 64) * DMIX, DMIX, scr, F.lane, kb >= 8 ? kin(13) + (kb * 64 - 512) : nullptr); continue; }
        { u32x4 z = {0u, 0u, 0u, 0u}; u32x4* p = (u32x4*)(Win_t + (size_t)(4656 + r) * DM); p[F.lane] = z; p[F.lane + 64] = z; }
    }
}

DI void phase_h(Ctx& F) {
    relaunder(F);
    const float* x = kin(0); const float* ctx = kin(2); const float* nw = kin(6);
    const float* MOD = (const float*)(F.ws + WS_MOD);
    bf16_t* HALL = (bf16_t*)(F.ws + WS_R1);
    const int gw = F.bid * 8 + F.wave, NGW = F.G * 8;
    f32x4 nx[4];
    if (gw < NROWS) { const f32x4* xr = (const f32x4*)((gw < NTOK) ? x + (size_t)gw * DM : ctx + (size_t)(gw - NTOK) * DM) + F.lane;
#pragma unroll
        for (int j = 0; j < 4; ++j) nx[j] = xr[64 * j]; }
    for (int m = gw; m < NROWS; m += NGW) {
        const int b = (m < NTOK) ? (m >> 12) : 8;
        f32x4 v[4]; float s = 0.f;
#pragma unroll
        for (int j = 0; j < 4; ++j) v[j] = nx[j];
        { const int mn = m + NGW;
          if (mn < NROWS) { const f32x4* xr = (const f32x4*)((mn < NTOK) ? x + (size_t)mn * DM : ctx + (size_t)(mn - NTOK) * DM) + F.lane;
#pragma unroll
            for (int j = 0; j < 4; ++j) nx[j] = xr[64 * j]; } }
#pragma unroll
        for (int j = 0; j < 4; ++j) s += (v[j].x * v[j].x + v[j].y * v[j].y) + (v[j].z * v[j].z + v[j].w * v[j].w);
        const float rstd = rsqrtf(wave_sum(s) * (1.f / DM) + 1e-6f);
        const f32x4* w4 = (const f32x4*)nw + F.lane; const f32x4* sh4 = (const f32x4*)(MOD + b * 6144) + F.lane; const f32x4* sc4 = (const f32x4*)(MOD + b * 6144 + 1024) + F.lane;
        u32x2* o = (u32x2*)(HALL + (size_t)m * DM) + F.lane;
#pragma unroll
        for (int j = 0; j < 4; ++j) { const f32x4 w = w4[64 * j], sh = sh4[64 * j], sc = sc4[64 * j];
            const f32x4 h = (v[j] * rstd * w) * (sc + 1.f) + sh;
            u32x2 p; p.x = cvt_pk_bf16(h.x, h.y); p.y = cvt_pk_bf16(h.z, h.w); o[64 * j] = p; }
    }
}

struct EpiInProj {
    static constexpr bool PERM = true;
    bf16_t* FIN; bf16_t* ZS; bf16_t* XBC; float* DT; const float* dt_bias;
    DI void operator()(const f32x4 (&acc)[2][2][4][2], const pg8::Unit& u, int wr, int wc, int fr, int fq) const {
        const int row0 = u.pm * 256 + wr * 64 + fr, cl = wc * 32 + 8 * fq;
        if (u.pn < 18) {
            bf16_t* base; int ld, c0; bool act = false;
            if (u.pn < 2) { base = FIN; ld = 512; c0 = u.pn * 256; }
            else if (u.pn < 8) { base = ZS; ld = DSSM; c0 = (u.pn - 2) * 256; act = true; }
            else { base = XBC; ld = CONVD; c0 = (u.pn - 8) * 256; }
#pragma unroll
            for (int ai = 0; ai < 2; ++ai)
#pragma unroll
                for (int m = 0; m < 4; ++m) { bf16_t* rowp = base + (size_t)(row0 + ai * 128 + m * 16) * ld + c0 + cl;
#pragma unroll
                    for (int bj = 0; bj < 2; ++bj) { f32x4 v0 = acc[ai][bj][m][0], v1 = acc[ai][bj][m][1];
                        if (act) {
#pragma unroll
                            for (int j = 0; j < 4; ++j) { v0[j] = silu_f(v0[j]); v1[j] = silu_f(v1[j]); } }
                        u32x4 w; w.x = cvt_pk_bf16(v0[0], v0[1]); w.y = cvt_pk_bf16(v0[2], v0[3]); w.z = cvt_pk_bf16(v1[0], v1[1]); w.w = cvt_pk_bf16(v1[2], v1[3]);
                        *(u32x4*)(rowp + bj * 128) = w; } }
        } else if (cl < 48) {
            float bia[8];
#pragma unroll
            for (int q = 0; q < 8; ++q) bia[q] = dt_bias[cl + q];
#pragma unroll
            for (int ai = 0; ai < 2; ++ai)
#pragma unroll
                for (int m = 0; m < 4; ++m) { float* rowp = DT + (size_t)(row0 + ai * 128 + m * 16) * 48 + cl;
                    f32x4 o0, o1;
#pragma unroll
                    for (int j = 0; j < 4; ++j) { o0[j] = softplus_f(acc[ai][0][m][0][j] + bia[j]); o1[j] = softplus_f(acc[ai][0][m][1][j] + bia[4 + j]); }
                    *(f32x4*)rowp = o0; *(f32x4*)(rowp + 4) = o1; }
        }
    }
};

constexpr int FT_T = 0;
constexpr int FT_TAB = 73728;
constexpr int FT_TW = FT_TAB + 128 * 272;
constexpr int FT_TR = FT_TW + 512;
constexpr int F1_U = 0, F1_TT = 64 * 528, F1_TAB = F1_TT + 8 * 64 * 144, F1_TW = F1_TAB + 128 * 272, F1_TR = F1_TW + 512;
static_assert(F1_TR + 512 <= LDS_BYTES - 32, "FFT step 1 LDS layout");

DI bf16x8 tr_read2(unsigned a0, unsigned a1) {
    s16x4 lo, hi;
    asm volatile("ds_read_b64_tr_b16 %0, %2\n\tds_read_b64_tr_b16 %1, %3\n\ts_waitcnt lgkmcnt(0)" : "=&v"(lo), "=&v"(hi) : "v"(a0), "v"(a1) : "memory");
    return __builtin_shufflevector(lo, hi, 0, 1, 2, 3, 4, 5, 6, 7);
}
DI int crow(int reg, int h) { return (reg & 3) + 8 * (reg >> 2) + 4 * h; }

DI void fft_step1(Ctx& F) {
    relaunder(F);
    const bf16_t* FIN = (const bf16_t*)(F.ws + WS_R2); bf16_t* A1 = (bf16_t*)(F.ws + WS_R1); const float* TTAB = (const float*)(F.ws + WS_SS);
    LAS unsigned char* lds = F.lds;
    LAS float* TR = (LAS float*)(lds + F1_TR);
    const int chh = F.bid & 1;
    if (F.tid < 64) { float s, c; sincospif((float)F.tid * (1.f / 32.f), &s, &c); TR[2 * F.tid] = c; TR[2 * F.tid + 1] = s; }
    __syncthreads();
    for (int i = F.tid; i < 128 * 128; i += 512) { const int m = i >> 7, k = i & 127, ri = m >> 6, k1 = m & 63, cs = k >> 6, l1 = k & 63, t = (k1 * l1) & 63;
        const float c = TR[2 * t], s = TR[2 * t + 1]; const float v = (ri == 0) ? (cs == 0 ? c : -s) : (cs == 0 ? -s : -c);
        *(LAS bf16_t*)(lds + F1_TAB + m * 272 + k * 2) = f2bf(v); }
    for (int idx = F.tid; idx < 8 * 64 * 64; idx += 512) { const int j = idx & 63, i = (idx >> 6) & 63, gc = idx >> 12, gg = gc >> 1, cs = gc & 1;
        const float v = TTAB[((size_t)(cs * 8 + 4 * chh + gg) * 64 + i) * 64 + j];
        *(LAS bf16_t*)(lds + F1_TT + ((gg * 2 + cs) * 64 + j) * 144 + i * 2) = f2bf(v); }
    __syncthreads();
    const int lane = F.lane, w = F.wave, h = lane >> 5, c31 = lane & 31, gg = w >> 1, jb = w & 1;
    u32x4 pfv[4];
    if (F.bid < NB * 64 * 2) { const int u = F.bid, l2 = (u >> 1) & 63, b = u >> 7;
#pragma unroll
        for (int i = 0; i < 4; ++i) { const int idx = F.tid + 512 * i, row = idx >> 5, c16 = idx & 31;
            pfv[i] = *(const u32x4*)(FIN + (size_t)(b * SEQ + 64 * row + l2) * 512 + chh * 256 + c16 * 8); } }
    for (int u = F.bid; u < NB * 64 * 2; u += F.G) {
        const int l2 = (u >> 1) & 63, b = u >> 7;
        LAS float* TW = (LAS float*)(lds + F1_TW);
        if (F.tid < 64) { float s, c; sincospif((float)(F.tid * l2) * (1.f / 2048.f), &s, &c); TW[2 * F.tid] = c; TW[2 * F.tid + 1] = s; }
#pragma unroll
        for (int i = 0; i < 4; ++i) { const int idx = F.tid + 512 * i, row = idx >> 5, c16 = idx & 31; *(LAS u32x4*)(lds + F1_U + row * 528 + c16 * 16) = pfv[i]; }
        __syncthreads();
        { const int un = u + F.G;
          if (un < NB * 64 * 2) { const int l2n = (un >> 1) & 63, bn = un >> 7;
#pragma unroll
            for (int i = 0; i < 4; ++i) { const int idx = F.tid + 512 * i, row = idx >> 5, c16 = idx & 31;
                pfv[i] = *(const u32x4*)(FIN + (size_t)(bn * SEQ + 64 * row + l2n) * 512 + chh * 256 + c16 * 8); } } }
        f32x16 px[2][2];
#pragma unroll
        for (int rb = 0; rb < 2; ++rb)
#pragma unroll
            for (int cs = 0; cs < 2; ++cs) {
#pragma unroll
                for (int i = 0; i < 16; ++i) px[rb][cs][i] = 0.f;
#pragma unroll
                for (int ks = 0; ks < 4; ++ks) {
                    const bf16x8 af = *(const LAS bf16x8*)(lds + F1_U + (32 * rb + c31) * 528 + (gg * 64 + 16 * ks + 8 * h) * 2);
                    const bf16x8 bf = *(const LAS bf16x8*)(lds + F1_TT + ((gg * 2 + cs) * 64 + 32 * jb + c31) * 144 + (16 * ks + 8 * h) * 2);
                    px[rb][cs] = __builtin_amdgcn_mfma_f32_32x32x16_bf16(af, bf, px[rb][cs], 0, 0, 0);
                }
            }
        f32x16 acc[4];
#pragma unroll
        for (int rbo = 0; rbo < 4; ++rbo)
#pragma unroll
            for (int i = 0; i < 16; ++i) acc[rbo][i] = 0.f;
#pragma unroll
        for (int cs = 0; cs < 2; ++cs)
#pragma unroll
            for (int rb = 0; rb < 2; ++rb)
#pragma unroll
                for (int s2 = 0; s2 < 2; ++s2) {
                    u32x4 bw; bw.x = cvt_pk_bf16(px[rb][cs][8 * s2], px[rb][cs][8 * s2 + 1]); bw.y = cvt_pk_bf16(px[rb][cs][8 * s2 + 2], px[rb][cs][8 * s2 + 3]);
                    bw.z = cvt_pk_bf16(px[rb][cs][8 * s2 + 4], px[rb][cs][8 * s2 + 5]); bw.w = cvt_pk_bf16(px[rb][cs][8 * s2 + 6], px[rb][cs][8 * s2 + 7]);
                    const bf16x8 bfr = __builtin_bit_cast(bf16x8, bw);
                    const int kc = cs * 64 + 32 * rb + 16 * s2 + 4 * h;
#pragma unroll
                    for (int rbo = 0; rbo < 4; ++rbo) {
                        const LAS unsigned char* ap = lds + F1_TAB + (32 * rbo + c31) * 272 + kc * 2;
                        const u32x2 lo = *(const LAS u32x2*)ap, hi = *(const LAS u32x2*)(ap + 16);
                        const u32x4 aw = {lo.x, lo.y, hi.x, hi.y};
                        acc[rbo] = __builtin_amdgcn_mfma_f32_32x32x16_bf16(__builtin_bit_cast(bf16x8, aw), bfr, acc[rbo], 0, 0, 0);
                    }
                }
        const int ch = chh * 256 + 32 * w + c31;
#pragma unroll
        for (int rb = 0; rb < 2; ++rb)
#pragma unroll
            for (int r = 0; r < 16; ++r) { const int k1 = 32 * rb + crow(r, h); const float ct = TW[2 * k1], st = TW[2 * k1 + 1];
                const float ar = acc[rb][r], ai = acc[rb + 2][r];
                const float orr = (ar * ct + ai * st) * (1.f / 64.f), oi = (ai * ct - ar * st) * (1.f / 64.f);
                bf16_t* dst = A1 + ((size_t)((b * 64 + k1) * 2) * 64 + l2) * 512 + ch;
                dst[0] = f2bf(orr); dst[(size_t)64 * 512] = f2bf(oi); }
        __syncthreads();
    }
}

DI void fft_step2(Ctx& F) {
    relaunder(F);
    const bf16_t* A1 = (const bf16_t*)(F.ws + WS_R1); bf16_t* AO = (bf16_t*)(F.ws + WS_R4);
    LAS unsigned char* lds = F.lds;
    LAS float* TR = (LAS float*)(lds + FT_TR);
    if (F.tid < 64) { float s, c; sincospif((float)F.tid * (1.f / 32.f), &s, &c); TR[2 * F.tid] = c; TR[2 * F.tid + 1] = s; }
    __syncthreads();
    for (int i = F.tid; i < 64 * 128; i += 512) { const int k2 = i >> 7, k = i & 127, ri = k >> 6, l2 = k & 63, t = (k2 * l2) & 63;
        *(LAS bf16_t*)(lds + FT_TAB + k2 * 272 + k * 2) = f2bf(ri ? TR[2 * t + 1] : TR[2 * t]); }
    __syncthreads();
    const int lane = F.lane, w = F.wave, h = lane >> 5, blk = (lane >> 4) & 1, q = (lane & 15) >> 2, p = lane & 3;
    const unsigned tbase = (unsigned)(size_t)(lds + FT_T);
    for (int u = F.bid; u < NB * 64 * 2; u += F.G) {
        const int chh = u & 1, k1 = (u >> 1) & 63, b = u >> 7;
#pragma unroll
        for (int i = 0; i < 8; ++i) { const int idx = F.tid + 512 * i, row = idx >> 5, c16 = idx & 31;
            const u32x4 v = *(const u32x4*)(A1 + ((size_t)(b * 64 + k1) * 128 + row) * 512 + chh * 256 + c16 * 8);
            *(LAS u32x4*)(lds + FT_T + row * 576 + c16 * 16) = v; }
        __syncthreads();
        f32x16 acc[2];
#pragma unroll
        for (int rb = 0; rb < 2; ++rb)
#pragma unroll
            for (int i = 0; i < 16; ++i) acc[rb][i] = 0.f;
#pragma unroll
        for (int ks = 0; ks < 8; ++ks) {
            const unsigned a0 = tbase + (unsigned)((16 * ks + 8 * h + q) * 576 + (32 * w + 16 * blk + 4 * p) * 2);
            const bf16x8 bfrag = tr_read2(a0, a0 + 4 * 576);
#pragma unroll
            for (int rb = 0; rb < 2; ++rb) { const bf16x8 afrag = *(const LAS bf16x8*)(lds + FT_TAB + (32 * rb + (lane & 31)) * 272 + (16 * ks + 8 * h) * 2);
                acc[rb] = __builtin_amdgcn_mfma_f32_32x32x16_bf16(afrag, bfrag, acc[rb], 0, 0, 0); }
        }
        const int ch = chh * 256 + 32 * w + (lane & 31);
#pragma unroll
        for (int rb = 0; rb < 2; ++rb)
#pragma unroll
            for (int r = 0; r < 16; ++r) { const int k2 = 32 * rb + crow(r, h);
                AO[(size_t)(b * SEQ + k1 + 64 * k2) * DMIX + ch] = f2bf(acc[rb][r] * 0.125f); }
        __syncthreads();
    }
}

constexpr int CV_B = 0, CV_C = 128 * 272;
DI void unpack8(const u32x4 v, float (&f)[8]) {
    f[0] = __uint_as_float(v.x << 16); f[1] = __uint_as_float(v.x & 0xffff0000u); f[2] = __uint_as_float(v.y << 16); f[3] = __uint_as_float(v.y & 0xffff0000u);
    f[4] = __uint_as_float(v.z << 16); f[5] = __uint_as_float(v.z & 0xffff0000u); f[6] = __uint_as_float(v.w << 16); f[7] = __uint_as_float(v.w & 0xffff0000u);
}
DI void conv_cb_phase(Ctx& F) {
    relaunder(F);
    const bf16_t* XBC = (const bf16_t*)(F.ws + WS_R4);
    bf16_t* XS = (bf16_t*)(F.ws + WS_XS); bf16_t* BMg = (bf16_t*)(F.ws + WS_BM); bf16_t* CMg = (bf16_t*)(F.ws + WS_CM); bf16_t* CBG = (bf16_t*)(F.ws + WS_CB);
    const float* conv_w = kin(8); const float* conv_b = kin(9);
    LAS unsigned char* lds = F.lds;
    const int lane = F.lane, h = lane >> 5;
    for (int u = F.bid; u < NB * 34 * NG; u += F.G) {
        const int g = u & 3, c = (u >> 2) % 34, b = (u >> 2) / 34;
        const bool lat = c < 32;
        const int seqbase = lat ? b * SEQ : NTOK + b * CTXL, L = lat ? SEQ : CTXL, t0 = lat ? c * 128 : (c - 32) * 128;
#pragma unroll
        for (int pass = 0; pass < 2; ++pass) {
            constexpr int NT0 = 16, NT1 = 4;
            const int NT = pass == 0 ? NT0 : NT1;
            int chunk, seg;
            if (pass == 0) { chunk = F.tid & 63; seg = F.tid >> 6; } else { chunk = 64 + (F.tid & 15); seg = F.tid >> 4; }
            int scol, dcol, kind;
            if (chunk < 48) { kind = 0; scol = g * 384 + chunk * 8; dcol = scol; }
            else if (chunk < 64) { kind = 1; dcol = g * 128 + (chunk - 48) * 8; scol = 1536 + dcol; }
            else { kind = 2; dcol = g * 128 + (chunk - 64) * 8; scol = 2048 + dcol; }
            const int tb = t0 + seg * NT;
            u32x4 raw[NT0 + 4];
#pragma unroll
            for (int k = 0; k < NT0 + 4; ++k) if (k < NT + 4) { const int t = tb - 2 + k; u32x4 v = {0u, 0u, 0u, 0u};
                if (t >= 0 && t < L) v = *(const u32x4*)(XBC + (size_t)(seqbase + t) * CONVD + scol);
                raw[k] = v; }
            float w[5][8], bias[8];
#pragma unroll
            for (int k = 0; k < 5; ++k) { const f32x4 a = *(const f32x4*)(conv_w + k * CONVD + scol), bb = *(const f32x4*)(conv_w + k * CONVD + scol + 4);
                w[k][0] = a.x; w[k][1] = a.y; w[k][2] = a.z; w[k][3] = a.w; w[k][4] = bb.x; w[k][5] = bb.y; w[k][6] = bb.z; w[k][7] = bb.w; }
            { const f32x4 a = *(const f32x4*)(conv_b + scol), bb = *(const f32x4*)(conv_b + scol + 4);
              bias[0] = a.x; bias[1] = a.y; bias[2] = a.z; bias[3] = a.w; bias[4] = bb.x; bias[5] = bb.y; bias[6] = bb.z; bias[7] = bb.w; }
            float win[5][8];
#pragma unroll
            for (int k = 0; k < 4; ++k) unpack8(raw[k], win[k]);
#pragma unroll
            for (int j = 0; j < NT0; ++j) if (j < NT) {
                unpack8(raw[j + 4], win[4]);
                float o[8];
#pragma unroll
                for (int e = 0; e < 8; ++e) { float a = bias[e];
#pragma unroll
                    for (int k = 0; k < 5; ++k) a += w[k][e] * win[k][e];
                    o[e] = silu_f(a); }
                u32x4 pk; pk.x = cvt_pk_bf16(o[0], o[1]); pk.y = cvt_pk_bf16(o[2], o[3]); pk.z = cvt_pk_bf16(o[4], o[5]); pk.w = cvt_pk_bf16(o[6], o[7]);
                const size_t row = (size_t)(seqbase + tb + j); const int tl = seg * NT + j;
                (void)row;
                if (kind == 0) *(u32x4*)(XS + ((size_t)((b * 34 + c) * NH + g * 6 + (chunk >> 3)) * 128 + tl) * 64 + (chunk & 7) * 8) = pk;
                else if (kind == 1) { *(u32x4*)(BMg + ((size_t)((b * 34 + c) * NG + g) * 128 + tl) * 128 + (chunk - 48) * 8) = pk; *(LAS u32x4*)(lds + CV_B + tl * 272 + (chunk - 48) * 16) = pk; }
                else { *(u32x4*)(CMg + ((size_t)((b * 34 + c) * NG + g) * 128 + tl) * 128 + (chunk - 64) * 8) = pk; *(LAS u32x4*)(lds + CV_C + tl * 272 + (chunk - 64) * 16) = pk; }
#pragma unroll
                for (int k = 0; k < 4; ++k)
#pragma unroll
                    for (int e = 0; e < 8; ++e) win[k][e] = win[k + 1][e];
            }
        }
        if (F.wave < 6) {
            const int hd = 6 * g + F.wave; const float a_f = -__expf(kin(11)[hd]), a_b = -__expf(kin(11)[24 + hd]);
            const float* DT = (const float*)(F.ws + WS_R5); float* AR = (float*)(F.ws + WS_ARRS) + (size_t)((b * 34 + c) * NH + hd) * ARN;
            const size_t r0 = (size_t)(seqbase + t0);
            {
                const float d0 = DT[(r0 + 2 * lane) * 48 + hd], d1 = DT[(r0 + 2 * lane + 1) * 48 + hd], v0 = d0 * a_f, v1 = d1 * a_f; float s = v0 + v1;
#pragma unroll
                for (int o = 1; o < 64; o <<= 1) { const float t = __shfl_up(s, o); if (lane >= o) s += t; }
                const float ex = s - (v0 + v1), A0 = ex + v0, A1 = ex + v0 + v1, tot = __shfl(s, 63);
                *(f32v2*)(AR + 2 * lane) = (f32v2){A0, A1}; *(f32v2*)(AR + 128 + 2 * lane) = (f32v2){__logf(d0) - A0, __logf(d1) - A1};
                *(f32v2*)(AR + 896 + 2 * lane) = (f32v2){d0 * __expf(tot - A0), d1 * __expf(tot - A1)};
#pragma unroll 1
                for (int q = 1; q < 4; ++q) { int ln = lane; asm volatile("" : "+v"(ln)); const float R = __shfl(A1, 16 * q - 1);
                    if (ln < 16 * q) *(f32v2*)(AR + 512 + 16 * q * (q - 1) + 2 * ln) = (f32v2){d0 * __expf(R - A0), d1 * __expf(R - A1)}; }
            }
            {
                const int e0 = 127 - 2 * lane, e1 = 126 - 2 * lane;
                const float d0 = DT[(r0 + e0) * 48 + 24 + hd], d1 = DT[(r0 + e1) * 48 + 24 + hd], v0 = d0 * a_b, v1 = d1 * a_b; float s = v0 + v1;
#pragma unroll
                for (int o = 1; o < 64; o <<= 1) { const float t = __shfl_up(s, o); if (lane >= o) s += t; }
                const float ex = s - (v0 + v1), A0 = ex + v0, A1 = ex + v0 + v1, tot = __shfl(s, 63);
                *(f32v2*)(AR + 256 + e1) = (f32v2){A1, A0}; *(f32v2*)(AR + 384 + e1) = (f32v2){__logf(d1) - A1, __logf(d0) - A0};
                *(f32v2*)(AR + 1024 + e1) = (f32v2){d1 * __expf(tot - A1), d0 * __expf(tot - A0)};
#pragma unroll 1
                for (int q = 0; q < 3; ++q) { int ln = lane; asm volatile("" : "+v"(ln)); const float Q = __shfl(A1, 47 - 16 * q);
                    if (ln < 16 * (3 - q)) *(f32v2*)(AR + 704 + 96 * q - 16 * q * (q - 1) + (126 - 2 * ln - 32 * (q + 1))) = (f32v2){d1 * __expf(Q - A1), d0 * __expf(Q - A0)}; }
            }
        }
        __syncthreads();
        if (lat) {
#pragma unroll
            for (int bi = 0; bi < 2; ++bi) {
                const int blk = 2 * F.wave + bi, sb = blk >> 2, lb = blk & 3;
                f32x16 acc;
#pragma unroll
                for (int i = 0; i < 16; ++i) acc[i] = 0.f;
#pragma unroll
                for (int ks = 0; ks < 8; ++ks) {
                    const bf16x8 af = *(const LAS bf16x8*)(lds + CV_B + (32 * sb + (lane & 31)) * 272 + (16 * ks + 8 * h) * 2);
                    const bf16x8 bf = *(const LAS bf16x8*)(lds + CV_C + (32 * lb + (lane & 31)) * 272 + (16 * ks + 8 * h) * 2);
                    acc = __builtin_amdgcn_mfma_f32_32x32x16_bf16(af, bf, acc, 0, 0, 0);
                }
                u32x4 o0, o1;
                o0.x = cvt_pk_bf16(acc[0], acc[1]); o0.y = cvt_pk_bf16(acc[2], acc[3]); o0.z = cvt_pk_bf16(acc[4], acc[5]); o0.w = cvt_pk_bf16(acc[6], acc[7]);
                o1.x = cvt_pk_bf16(acc[8], acc[9]); o1.y = cvt_pk_bf16(acc[10], acc[11]); o1.z = cvt_pk_bf16(acc[12], acc[13]); o1.w = cvt_pk_bf16(acc[14], acc[15]);
                u32x4* dst = (u32x4*)(CBG + ((size_t)(((b * 32 + c) * 4 + g) * 16 + blk) * 64 + lane) * 16);
                dst[0] = o0; dst[1] = o1;
            }
        }
        __syncthreads();
    }
}

constexpr int SD_C = 0;
constexpr int SD_B = SD_C + 128 * 272;
constexpr int SD_X = SD_B + 128 * 288;
constexpr int SD_XW = SD_X + 128 * 192;
constexpr int SD_H = SD_XW + 128 * 192;
constexpr int SD_ARR = SD_H + 64 * 272;
constexpr int SD_Y = SD_ARR + (896 + 256) * 4;
static_assert(SD_Y + 128 * 144 <= LDS_BYTES - 16, "SSD LDS layout");
DI float bflo(unsigned w) { return __uint_as_float(w << 16); }
DI float bfhi(unsigned w) { return __uint_as_float(w & 0xffff0000u); }
DI void tr_read4(unsigned a0, unsigned a1, unsigned b0, unsigned b1, bf16x8& fa, bf16x8& fb) {
    s16x4 alo, ahi, blo, bhi;
    asm volatile("ds_read_b64_tr_b16 %0, %4\n\tds_read_b64_tr_b16 %1, %5\n\tds_read_b64_tr_b16 %2, %6\n\tds_read_b64_tr_b16 %3, %7\n\ts_waitcnt lgkmcnt(0)"
                 : "=&v"(alo), "=&v"(ahi), "=&v"(blo), "=&v"(bhi) : "v"(a0), "v"(a1), "v"(b0), "v"(b1) : "memory");
    fa = __builtin_shufflevector(alo, ahi, 0, 1, 2, 3, 4, 5, 6, 7); fb = __builtin_shufflevector(blo, bhi, 0, 1, 2, 3, 4, 5, 6, 7);
}
DI void tr_read_state4(unsigned b0, unsigned b1, s16x4 (&o)[16]) {
    asm volatile("ds_read_b64_tr_b16 %0, %16 offset:0\n\tds_read_b64_tr_b16 %1, %16 offset:768\n\tds_read_b64_tr_b16 %2, %17 offset:0\n\tds_read_b64_tr_b16 %3, %17 offset:1152\n\tds_read_b64_tr_b16 %4, %16 offset:3072\n\tds_read_b64_tr_b16 %5, %16 offset:3840\n\tds_read_b64_tr_b16 %6, %17 offset:4608\n\tds_read_b64_tr_b16 %7, %17 offset:5760\n\tds_read_b64_tr_b16 %8, %16 offset:6144\n\tds_read_b64_tr_b16 %9, %16 offset:6912\n\tds_read_b64_tr_b16 %10, %17 offset:9216\n\tds_read_b64_tr_b16 %11, %17 offset:10368\n\tds_read_b64_tr_b16 %12, %16 offset:9216\n\tds_read_b64_tr_b16 %13, %16 offset:9984\n\tds_read_b64_tr_b16 %14, %17 offset:13824\n\tds_read_b64_tr_b16 %15, %17 offset:14976\n\ts_waitcnt lgkmcnt(0)"
                 : "=&v"(o[0]), "=&v"(o[1]), "=&v"(o[2]), "=&v"(o[3]), "=&v"(o[4]), "=&v"(o[5]), "=&v"(o[6]), "=&v"(o[7]), "=&v"(o[8]), "=&v"(o[9]), "=&v"(o[10]), "=&v"(o[11]), "=&v"(o[12]), "=&v"(o[13]), "=&v"(o[14]), "=&v"(o[15]) : "v"(b0), "v"(b1) : "memory");
}
DI void tr_read_diag16(unsigned b0, unsigned b1, unsigned b2, unsigned b3, s16x4 (&o)[16]) {
    asm volatile("ds_read_b64_tr_b16 %0, %16 offset:0\n\tds_read_b64_tr_b16 %1, %16 offset:1536\n\tds_read_b64_tr_b16 %2, %16 offset:3072\n\tds_read_b64_tr_b16 %3, %16 offset:4608\n\tds_read_b64_tr_b16 %4, %17 offset:0\n\tds_read_b64_tr_b16 %5, %17 offset:1536\n\tds_read_b64_tr_b16 %6, %17 offset:3072\n\tds_read_b64_tr_b16 %7, %17 offset:4608\n\tds_read_b64_tr_b16 %8, %18 offset:0\n\tds_read_b64_tr_b16 %9, %18 offset:1536\n\tds_read_b64_tr_b16 %10, %18 offset:3072\n\tds_read_b64_tr_b16 %11, %18 offset:4608\n\tds_read_b64_tr_b16 %12, %19 offset:0\n\tds_read_b64_tr_b16 %13, %19 offset:1536\n\tds_read_b64_tr_b16 %14, %19 offset:3072\n\tds_read_b64_tr_b16 %15, %19 offset:4608\n\ts_waitcnt lgkmcnt(0)"
                 : "=&v"(o[0]), "=&v"(o[1]), "=&v"(o[2]), "=&v"(o[3]), "=&v"(o[4]), "=&v"(o[5]), "=&v"(o[6]), "=&v"(o[7]), "=&v"(o[8]), "=&v"(o[9]), "=&v"(o[10]), "=&v"(o[11]), "=&v"(o[12]), "=&v"(o[13]), "=&v"(o[14]), "=&v"(o[15]) : "v"(b0), "v"(b1), "v"(b2), "v"(b3) : "memory");
}
DI void tr_read_diag8(unsigned b0, unsigned b1, s16x4 (&o)[8]) {
    asm volatile("ds_read_b64_tr_b16 %0, %8 offset:0\n\tds_read_b64_tr_b16 %1, %8 offset:1536\n\tds_read_b64_tr_b16 %2, %8 offset:3072\n\tds_read_b64_tr_b16 %3, %8 offset:4608\n\tds_read_b64_tr_b16 %4, %9 offset:0\n\tds_read_b64_tr_b16 %5, %9 offset:1536\n\tds_read_b64_tr_b16 %6, %9 offset:3072\n\tds_read_b64_tr_b16 %7, %9 offset:4608\n\ts_waitcnt lgkmcnt(0)"
                 : "=&v"(o[0]), "=&v"(o[1]), "=&v"(o[2]), "=&v"(o[3]), "=&v"(o[4]), "=&v"(o[5]), "=&v"(o[6]), "=&v"(o[7]) : "v"(b0), "v"(b1) : "memory");
}
struct SsdPF { u32x4 c[4], b[4], x[2], yz[4]; float w[2]; f32v2 arr; };

DI void ssd_unit(Ctx& F, const int b, const int hd) {
    relaunder(F);
    const bf16_t* XS = (const bf16_t*)(F.ws + WS_XS); const bf16_t* BMg = (const bf16_t*)(F.ws + WS_BM); const bf16_t* CMg = (const bf16_t*)(F.ws + WS_CM);
    const bf16_t* CBG = (const bf16_t*)(F.ws + WS_CB); const float* ARRS = (const float*)(F.ws + WS_ARRS);
    bf16_t* AO = (bf16_t*)(F.ws + WS_R4); const bf16_t* ZS = (const bf16_t*)F.out; float* SS = (float*)(F.ws + WS_SS);
    LAS unsigned char* lds = F.lds;
    LAS float* ARR = (LAS float*)(lds + SD_ARR);
    LAS float *AF = ARR, *LF = ARR + 128, *ABS = ARR + 256, *LB = ARR + 384, *SSP = ARR + 896;
    const int g = hd / 6, tid = F.tid, lane = F.lane, wave = F.wave;
    const int pb = wave >> 2, lb = wave & 3, h = lane >> 5, blk = (lane >> 4) & 1, q = (lane & 15) >> 2, pp = lane & 3, c31 = lane & 31;
    const float dsk = kin(12)[hd];
    const unsigned xbase = (unsigned)(size_t)(lds + SD_X), xwbase = (unsigned)(size_t)(lds + SD_XW), bbase = (unsigned)(size_t)(lds + SD_B);
    const int l = 32 * lb + c31;
#define SSD_CHUNK(dir_, step_) ((dir_) == 0 ? ((step_) >= 2 ? (step_) - 2 : 32 + (step_)) : 33 - (step_))
#define SSD_ROW0(c_) (((c_) < 32) ? b * SEQ + (c_) * 128 : NTOK + b * CTXL + ((c_) - 32) * 128)
#define SSD_ISSUE(pf, dir_, step_) do { const int c_ = SSD_CHUNK(dir_, step_), row0_ = SSD_ROW0(c_); const bool lat_ = (step_) >= 2; \
        const float* ar_ = ARRS + (size_t)((b * 34 + c_) * NH + hd) * ARN; \
        _Pragma("unroll") for (int i = 0; i < 4; ++i) { const int idx = tid + 512 * i, r = idx >> 4, c16 = idx & 15; \
            if (lat_) pf.c[i] = *(const u32x4*)(CMg + (size_t)((b * 34 + c_) * NG + g) * 16384 + (size_t)idx * 8); \
            pf.b[i] = *(const u32x4*)(BMg + (size_t)((b * 34 + c_) * NG + g) * 16384 + (size_t)idx * 8); (void)r; (void)c16; } \
        _Pragma("unroll") for (int i = 0; i < 2; ++i) { const int idx = tid + 512 * i, r = idx >> 3, c16 = idx & 7; \
            pf.x[i] = *(const u32x4*)(XS + (size_t)((b * 34 + c_) * NH + hd) * 8192 + (size_t)idx * 8); pf.w[i] = ar_[((dir_) ? 1024 : 896) + r]; \
            if (lat_ && (dir_) == 1) { pf.yz[i] = *(const u32x4*)(AO + (size_t)(row0_ + r) * DMIX + 512 + hd * 64 + c16 * 8); pf.yz[2 + i] = *(const u32x4*)(ZS + (size_t)(row0_ + r) * DSSM + hd * 64 + c16 * 8); } } \
        if (tid < ((dir_) ? 256 : 448)) pf.arr = *(const f32v2*)(ar_ + 2 * tid); \
    } while (0)
#define SSD_ISSUE2(cbr, step_) do { const int c_ = SSD_CHUNK(0, step_); \
        const u32x4* cbp = (const u32x4*)(CBG + ((size_t)(((b * 32 + c_) * 4 + g) * 16 + lb) * 64 + lane) * 16); \
        _Pragma("unroll") for (int d = 0; d < 4; ++d) { const int sb = (lb + d) & 3; cbr[2 * d] = cbp[(size_t)sb * 512]; cbr[2 * d + 1] = cbp[(size_t)sb * 512 + 1]; } \
    } while (0)

#pragma unroll 1
    for (int dir = 0; dir < 2; ++dir) {
        f32x16 Hacc;
#pragma unroll
        for (int i = 0; i < 16; ++i) Hacc[i] = 0.f;
        SsdPF pf;
        u32x4 cbr[8];
#pragma unroll
        for (int i = 0; i < 8; ++i) cbr[i] = (u32x4){0u, 0u, 0u, 0u};
        u32x4 ytmp[2] = {(u32x4){0u, 0u, 0u, 0u}, (u32x4){0u, 0u, 0u, 0u}}; float sstmp = 0.f; int prow0 = 0; bool pylat = false;
        SSD_ISSUE(pf, dir, 0);
#pragma unroll 1
        for (int step = 0; step < 34; ++step) {
            const bool lat = step >= 2;
            const int c = SSD_CHUNK(dir, step), row0 = SSD_ROW0(c);
            if (lat) {
#pragma unroll
                for (int i = 0; i < 4; ++i) { const int idx = tid + 512 * i, r = idx >> 4, c16 = idx & 15; *(LAS u32x4*)(lds + SD_C + r * 272 + c16 * 16) = pf.c[i]; }
            }
#pragma unroll
            for (int i = 0; i < 4; ++i) { const int idx = tid + 512 * i, r = idx >> 4, c16 = idx & 15; *(LAS u32x4*)(lds + SD_B + r * 288 + c16 * 16) = pf.b[i]; }
#pragma unroll
            for (int i = 0; i < 2; ++i) { const int idx = tid + 512 * i, r = idx >> 3, c16 = idx & 7;
                if (dir == 0) *(LAS u32x4*)(lds + SD_X + r * 192 + c16 * 16) = pf.x[i];
                else if (lat) { *(LAS u32x4*)(lds + SD_X + r * 144 + c16 * 16) = pf.yz[i]; *(LAS u32x4*)(lds + SD_Y + r * 144 + c16 * 16) = pf.yz[2 + i]; }
                float f[8]; unpack8(pf.x[i], f); const float wv = pf.w[i];
                u32x4 o; o.x = cvt_pk_bf16(f[0] * wv, f[1] * wv); o.y = cvt_pk_bf16(f[2] * wv, f[3] * wv); o.z = cvt_pk_bf16(f[4] * wv, f[5] * wv); o.w = cvt_pk_bf16(f[6] * wv, f[7] * wv);
                *(LAS u32x4*)(lds + SD_XW + r * 192 + c16 * 16) = o; }
            if (tid < (dir ? 256 : 448)) *(LAS f32v2*)(ARR + 2 * tid) = pf.arr;
#pragma unroll
            for (int r = 0; r < 16; ++r) *(LAS bf16_t*)(lds + SD_H + (32 * pb + crow(r, h)) * 272 + (32 * lb + c31) * 2) = f2bf(Hacc[r]);
            if (pylat) {
#pragma unroll
                for (int i = 0; i < 2; ++i) { const int idx = tid + 512 * i, r = idx >> 3, c16 = idx & 7;
                    *(u32x4*)(AO + (size_t)(prow0 + r) * DMIX + 512 + hd * 64 + c16 * 8) = ytmp[i]; }
                if (dir == 1 && tid < 128) SS[(size_t)(prow0 + tid) * NH + hd] = sstmp;
            }
            lds_barrier();
            if (step + 1 < 34) SSD_ISSUE(pf, dir, step + 1);
            if (lat) {
                f32x16 y;
#pragma unroll
                for (int i = 0; i < 16; ++i) y[i] = 0.f;
                {
#pragma unroll
                    for (int half = 0; half < 2; ++half) {
                        bf16x8 afv[4], bfv[4];
#pragma unroll
                        for (int k4 = 0; k4 < 4; ++k4) { const int ks = 4 * half + k4; afv[k4] = *(const LAS bf16x8*)(lds + SD_H + (32 * pb + c31) * 272 + (16 * ks + 8 * h) * 2);
                            bfv[k4] = *(const LAS bf16x8*)(lds + SD_C + l * 272 + (16 * ks + 8 * h) * 2); }
                        asm volatile("s_waitcnt lgkmcnt(0)" ::: "memory");
#pragma unroll
                        for (int k4 = 0; k4 < 4; ++k4) y = __builtin_amdgcn_mfma_f32_32x32x16_bf16(afv[k4], bfv[k4], y, 0, 0, 0);
                    }
                }
                const float AFl = AF[l], ABSl = ABS[l];
                const float sc = __expf(dir ? ABSl : AFl);
#pragma unroll
                for (int i = 0; i < 16; ++i) y[i] *= sc;
                if (dir == 0) {
                    int c31v = c31, hv = h; asm volatile("" : "+v"(c31v), "+v"(hv));
                    s16x4 xf[8];
                    const unsigned xcol = xbase + (unsigned)((4 * hv + q) * 192 + (32 * pb + 16 * blk + 4 * pp) * 2);
#pragma unroll
                    for (int d = 0; d < 4; ++d) {
                        const int sb = (lb + d) & 3;
                        if ((d & 1) == 0) tr_read_diag8(xcol + (unsigned)(sb * 32 * 192), xcol + (unsigned)(((sb + 1) & 3) * 32 * 192), xf);
                        const unsigned cw[8] = {cbr[2 * d].x, cbr[2 * d].y, cbr[2 * d].z, cbr[2 * d].w, cbr[2 * d + 1].x, cbr[2 * d + 1].y, cbr[2 * d + 1].z, cbr[2 * d + 1].w};
                        float mt[16];
                        if (d == 0) {
                            const float ddg = __expf(AFl + LF[l]) + __expf(ABSl + LB[l]);
#pragma unroll
                            for (int r = 0; r < 16; ++r) {
                                const int sl = crow(r, hv), s = 32 * sb + sl;
                                const float cb = (r & 1) ? bfhi(cw[r >> 1]) : bflo(cw[r >> 1]);
                                const float wo = __expf(sl < c31v ? AFl + LF[s] : ABSl + LB[s]);
                                mt[r] = (sl == c31v) ? cb * ddg + dsk : cb * wo;
                            }
                        } else {
                            const bool fw = sb < lb;
                            const LAS float* Ep = fw ? ARR + 512 + (lb == 3 ? 96 : (lb == 2 ? 32 : 0)) + 32 * sb : ARR + 704 + (lb == 0 ? 0 : (lb == 1 ? 96 : 160)) + 32 * (sb - lb - 1);
                            const float el = fw ? __expf(AFl - AF[32 * lb - 1]) : __expf(ABSl - ABS[32 * lb + 32]);
#pragma unroll
                            for (int r = 0; r < 16; ++r) {
                                const float cb = (r & 1) ? bfhi(cw[r >> 1]) : bflo(cw[r >> 1]);
                                mt[r] = (cb * el) * Ep[crow(r, hv)];
                            }
                        }
#pragma unroll
                        for (int s2 = 0; s2 < 2; ++s2) {
                            u32x4 bw; bw.x = cvt_pk_bf16(mt[8 * s2], mt[8 * s2 + 1]); bw.y = cvt_pk_bf16(mt[8 * s2 + 2], mt[8 * s2 + 3]);
                            bw.z = cvt_pk_bf16(mt[8 * s2 + 4], mt[8 * s2 + 5]); bw.w = cvt_pk_bf16(mt[8 * s2 + 6], mt[8 * s2 + 7]);
                            const bf16x8 bfr = __builtin_bit_cast(bf16x8, bw);
                            const bf16x8 afr = __builtin_shufflevector(xf[4 * (d & 1) + 2 * s2], xf[4 * (d & 1) + 2 * s2 + 1], 0, 1, 2, 3, 4, 5, 6, 7);
                            y = __builtin_amdgcn_mfma_f32_32x32x16_bf16(afr, bfr, y, 0, 0, 0);
                        }
                        asm volatile("" ::: "memory");
                    }
#pragma unroll
                    for (int g4 = 0; g4 < 4; ++g4) { u32x2 o; o.x = cvt_pk_bf16(y[4 * g4], y[4 * g4 + 1]); o.y = cvt_pk_bf16(y[4 * g4 + 2], y[4 * g4 + 3]); *(LAS u32x2*)(lds + SD_Y + l * 144 + (32 * pb + 8 * g4 + 4 * h) * 2) = o; }
                } else {
                    float ssq = 0.f;
#pragma unroll
                    for (int g4 = 0; g4 < 4; ++g4) {
                        const u32x2 yf = *(const LAS u32x2*)(lds + SD_X + l * 144 + (32 * pb + 8 * g4 + 4 * h) * 2), zz = *(const LAS u32x2*)(lds + SD_Y + l * 144 + (32 * pb + 8 * g4 + 4 * h) * 2);
                        const float o0 = (y[4 * g4] + bflo(yf.x)) * bflo(zz.x), o1 = (y[4 * g4 + 1] + bfhi(yf.x)) * bfhi(zz.x);
                        const float o2 = (y[4 * g4 + 2] + bflo(yf.y)) * bflo(zz.y), o3 = (y[4 * g4 + 3] + bfhi(yf.y)) * bfhi(zz.y);
                        ssq += (o0 * o0 + o1 * o1) + (o2 * o2 + o3 * o3);
                        u32x2 o; o.x = cvt_pk_bf16(o0, o1); o.y = cvt_pk_bf16(o2, o3); *(LAS u32x2*)(lds + SD_X + l * 144 + (32 * pb + 8 * g4 + 4 * h) * 2) = o;
                    }
                    ssq += __shfl_xor(ssq, 32);
                    if (lane < 32) SSP[pb * 128 + l] = ssq;
                }
            }
            if (dir == 0 && step + 1 < 34 && step + 1 >= 2) SSD_ISSUE2(cbr, step + 1);
            {
                const float dec = __expf(dir ? ABS[0] : AF[127]);
#pragma unroll
                for (int i = 0; i < 16; ++i) Hacc[i] *= dec;
                const unsigned ab = xwbase + (unsigned)((8 * h + q) * 192 + (32 * pb + 16 * blk + 4 * pp) * 2);
                const unsigned bb = bbase + (unsigned)((8 * h + q) * 288 + (32 * lb + 16 * blk + 4 * pp) * 2);
#pragma unroll
                for (int half = 0; half < 2; ++half) {
                    s16x4 f[16];
                    tr_read_state4(ab + half * 4 * 3072, bb + half * 4 * 4608, f);
#pragma unroll
                    for (int ks = 0; ks < 4; ++ks) {
                        const bf16x8 afr = __builtin_shufflevector(f[4 * ks], f[4 * ks + 1], 0, 1, 2, 3, 4, 5, 6, 7), bfr = __builtin_shufflevector(f[4 * ks + 2], f[4 * ks + 3], 0, 1, 2, 3, 4, 5, 6, 7);
                        Hacc = __builtin_amdgcn_mfma_f32_32x32x16_bf16(afr, bfr, Hacc, 0, 0, 0);
                    }
                }
            }
            lds_barrier();
            pylat = lat; prow0 = row0;
            if (lat) {
                const int ybase = dir ? SD_X : SD_Y;
#pragma unroll
                for (int i = 0; i < 2; ++i) { const int idx = tid + 512 * i, r = idx >> 3, c16 = idx & 7; ytmp[i] = *(const LAS u32x4*)(lds + ybase + r * 144 + c16 * 16); }
                if (dir == 1 && tid < 128) sstmp = SSP[tid] + SSP[128 + tid];
            }
        }
        if (pylat) {
#pragma unroll
            for (int i = 0; i < 2; ++i) { const int idx = tid + 512 * i, r = idx >> 3, c16 = idx & 7;
                *(u32x4*)(AO + (size_t)(prow0 + r) * DMIX + 512 + hd * 64 + c16 * 8) = ytmp[i]; }
            if (dir == 1 && tid < 128) SS[(size_t)(prow0 + tid) * NH + hd] = sstmp;
        }
        asm volatile("s_waitcnt vmcnt(0)" ::: "memory");
        __syncthreads();
    }
#undef SSD_ISSUE
#undef SSD_ISSUE2
#undef SSD_CHUNK
#undef SSD_ROW0
}

struct EpiOutProj {
    static constexpr bool PERM = true;
    const float* x; const float* MOD; bf16_t* x1;
    DI void operator()(const f32x4 (&acc)[2][2][4][2], const pg8::Unit& u, int wr, int wc, int fr, int fq) const {
        const int row0 = u.pm * 256 + wr * 64 + fr, col0 = u.pn * 256 + wc * 32 + 8 * fq;
        const int b = (u.pm * 256) >> 12;
        f32x4 g[2][2];
#pragma unroll
        for (int bj = 0; bj < 2; ++bj)
#pragma unroll
            for (int n = 0; n < 2; ++n) g[bj][n] = *(const f32x4*)(MOD + b * 6144 + 2048 + col0 + bj * 128 + n * 4);
#pragma unroll
        for (int ai = 0; ai < 2; ++ai)
#pragma unroll
            for (int m = 0; m < 4; ++m) { const size_t off = (size_t)(row0 + ai * 128 + m * 16) * DM + col0;
#pragma unroll
                for (int bj = 0; bj < 2; ++bj) { const f32x4 x0 = *(const f32x4*)(x + off + bj * 128), x4 = *(const f32x4*)(x + off + bj * 128 + 4);
                    const f32x4 v0 = x0 + g[bj][0] * acc[ai][bj][m][0], v1 = x4 + g[bj][1] * acc[ai][bj][m][1];
                    u32x4 w; w.x = cvt_pk_bf16(v0[0], v0[1]); w.y = cvt_pk_bf16(v0[2], v0[3]); w.z = cvt_pk_bf16(v1[0], v1[1]); w.w = cvt_pk_bf16(v1[2], v1[3]);
                    *(u32x4*)(x1 + off + bj * 128) = w; } }
    }
};

DI void phase_router(Ctx& F) {
    relaunder(F);
    const float* nw = kin(16); const float* wr = kin(17);
    const float* MOD = (const float*)(F.ws + WS_MOD);
    unsigned char* H2 = F.ws + WS_H2; float* PROBS = (float*)(F.ws + WS_PROBS); int* INV = (int*)(F.ws + WS_INV);
    LAS float* WR = (LAS float*)F.lds;
    for (int i = F.tid; i < 16 * 1024; i += 512) { const int d = i >> 4, e = i & 15; WR[e * 1024 + d] = wr[i]; }
    __syncthreads();
    const int gw = F.bid * 8 + F.wave, NGW = F.G * 8, lane = F.lane;
    f32x4 nx[4];
    const bf16_t* X1 = (const bf16_t*)(F.ws + WS_X1);
    if (gw < NTOK) { const u32x2* xr = (const u32x2*)(X1 + (size_t)gw * DM) + lane;
#pragma unroll
        for (int j = 0; j < 4; ++j) { const u32x2 q = xr[64 * j]; nx[j] = (f32x4){bflo(q.x), bfhi(q.x), bflo(q.y), bfhi(q.y)}; } }
    for (int m = gw; m < NTOK; m += NGW) {
        const int b = m >> 12, t = m & 4095;
        f32x4 v[4]; float s = 0.f;
#pragma unroll
        for (int j = 0; j < 4; ++j) v[j] = nx[j];
        if (m + NGW < NTOK) { const u32x2* xr = (const u32x2*)(X1 + (size_t)(m + NGW) * DM) + lane;
#pragma unroll
            for (int j = 0; j < 4; ++j) { const u32x2 q = xr[64 * j]; nx[j] = (f32x4){bflo(q.x), bfhi(q.x), bflo(q.y), bfhi(q.y)}; } }
#pragma unroll
        for (int j = 0; j < 4; ++j) s += (v[j].x * v[j].x + v[j].y * v[j].y) + (v[j].z * v[j].z + v[j].w * v[j].w);
        const float rstd = rsqrtf(wave_sum(s) * (1.f / DM) + 1e-6f);
        const f32x4* w4 = (const f32x4*)nw + lane; const f32x4* sh4 = (const f32x4*)(MOD + b * 6144 + 3072) + lane; const f32x4* sc4 = (const f32x4*)(MOD + b * 6144 + 4096) + lane;
        unsigned* o = (unsigned*)(H2 + (size_t)m * DM) + lane;
#pragma unroll
        for (int j = 0; j < 4; ++j) { const f32x4 w = w4[64 * j], sh = sh4[64 * j], sc = sc4[64 * j];
            v[j] = (v[j] * rstd * w) * (sc + 1.f) + sh;
            o[64 * j] = pk_fp8x4(v[j].x, v[j].y, v[j].z, v[j].w); }
        float lg[16];
#pragma unroll
        for (int e = 0; e < 16; ++e) { float a = 0.f;
#pragma unroll
            for (int j = 0; j < 4; ++j) { const f32x4 w = *(const LAS f32x4*)(WR + e * 1024 + 4 * lane + 256 * j); a += (v[j].x * w.x + v[j].y * w.y) + (v[j].z * w.z + v[j].w * w.w); }
            lg[e] = a; asm volatile("" ::: "memory"); }
        float r1[8], r2[4], r3[2], r4;
        { const bool hi = (lane & 32) != 0;
#pragma unroll
          for (int i = 0; i < 8; ++i) { const float keep = hi ? lg[i + 8] : lg[i], send = hi ? lg[i] : lg[i + 8]; r1[i] = keep + __shfl_xor(send, 32); } }
        { const bool hi = (lane & 16) != 0;
#pragma unroll
          for (int i = 0; i < 4; ++i) { const float keep = hi ? r1[i + 4] : r1[i], send = hi ? r1[i] : r1[i + 4]; r2[i] = keep + __shfl_xor(send, 16); } }
        { const bool hi = (lane & 8) != 0;
#pragma unroll
          for (int i = 0; i < 2; ++i) { const float keep = hi ? r2[i + 2] : r2[i], send = hi ? r2[i] : r2[i + 2]; r3[i] = keep + __shfl_xor(send, 8); } }
        { const bool hi = (lane & 4) != 0; const float keep = hi ? r3[1] : r3[0], send = hi ? r3[0] : r3[1]; r4 = keep + __shfl_xor(send, 4); }
        r4 += __shfl_xor(r4, 1); r4 += __shfl_xor(r4, 2);
        float mx = r4;
        mx = fmaxf(mx, __shfl_xor(mx, 4)); mx = fmaxf(mx, __shfl_xor(mx, 8)); mx = fmaxf(mx, __shfl_xor(mx, 16)); mx = fmaxf(mx, __shfl_xor(mx, 32));
        const float ex = expf(r4 - mx);
        float den = ex;
        den += __shfl_xor(den, 4); den += __shfl_xor(den, 8); den += __shfl_xor(den, 16); den += __shfl_xor(den, 32);
        if ((lane & 3) == 0) { const int e = lane >> 2; PROBS[(size_t)(b * 16 + e) * SEQ + t] = ex / den; INV[(size_t)m * 16 + e] = -1; }
    }
}

DI void moe_weight_items(Ctx& F, int w, int nw) {
    relaunder(F);
    const int lane = F.lane;
    LAS float* scr = (LAS float*)(F.lds + F.wave * TR_SCR);
    const float* w_gate = kin(18); const float* w_up = kin(19); const float* w_down = kin(20);
    unsigned char* Wgu = F.ws + WS_WGU; unsigned char* Wd = F.ws + WS_WD;
    constexpr int I_G = NE * 16 * 32, I_D = NE * 32 * 16;
    for (int it = w; it < 2 * I_G + I_D; it += nw) {
        int r = it;
        if (r < 2 * I_G) { const int up = r >= I_G; if (up) r -= I_G; const int e = r / 512, kb = (r % 512) / 32, nb = r % 32, f0 = nb * 64;
            transpose_item_f8((up ? w_up : w_gate) + (size_t)e * DM * DEXP, DEXP, kb * 64, f0, Wgu + ((size_t)e * 4096 + (f0 >> 7) * 256 + (f0 & 127) + up * 128) * DM, DM, scr, lane); continue; }
        r -= 2 * I_G;
        { const int e = r / 512, kb = (r % 512) / 16, nb = r % 16;
          transpose_item_f8(w_down + (size_t)e * DEXP * DM, DM, kb * 64, nb * 64, Wd + ((size_t)e * DM + nb * 64) * DEXP, DEXP, scr, lane); }
    }
}

DI void phase_topk(Ctx& F) {
    relaunder(F);
    const float* PROBS = (const float*)(F.ws + WS_PROBS); int* ROWMAP = (int*)(F.ws + WS_ROWMAP); float* VAL = (float*)(F.ws + WS_VAL); int* INV = (int*)(F.ws + WS_INV);
    LAS unsigned* HIST = (LAS unsigned*)F.lds;
    LAS unsigned* CTL = HIST + 256;
    LAS unsigned* WS1 = HIST + 272;
    const int tid = F.tid, lane = F.lane, wave = F.wave;
    for (int u = F.bid; u < NB * NE; u += F.G) {
        const int b = u >> 4, e = u & 15;
        const float* pr = PROBS + (size_t)u * SEQ + tid * 8;
        const f32x4 p0 = *(const f32x4*)pr, p1 = *(const f32x4*)(pr + 4);
        unsigned key[8] = {__float_as_uint(p0.x), __float_as_uint(p0.y), __float_as_uint(p0.z), __float_as_uint(p0.w), __float_as_uint(p1.x), __float_as_uint(p1.y), __float_as_uint(p1.z), __float_as_uint(p1.w)};
        unsigned prefix = 0u, kk = CAP;
        for (int pass = 0; pass < 4; ++pass) {
            const int shift = 24 - 8 * pass;
            if (tid < 256) HIST[tid] = 0u;
            __syncthreads();
            const unsigned himask = pass == 0 ? 0u : (0xffffffffu << (shift + 8));
#pragma unroll
            for (int i = 0; i < 8; ++i) if ((key[i] & himask) == prefix) __hip_atomic_fetch_add(&HIST[(key[i] >> shift) & 255u], 1u, __ATOMIC_RELAXED, __HIP_MEMORY_SCOPE_WORKGROUP);
            __syncthreads();
            if (wave == 0) {
                const unsigned h0 = HIST[4 * lane], h1 = HIST[4 * lane + 1], h2 = HIST[4 * lane + 2], h3 = HIST[4 * lane + 3];
                const unsigned tot = h0 + h1 + h2 + h3; unsigned sfx = tot;
#pragma unroll
                for (int o = 1; o < 64; o <<= 1) { const unsigned t = __shfl_down(sfx, o); if (lane + o < 64) sfx += t; }
                const unsigned above = sfx - tot;
                const unsigned a3 = above, a2 = a3 + h3, a1 = a2 + h2, a0 = a1 + h1;
                int bin = -1; unsigned cum = 0u;
                if (a3 < kk && kk <= a3 + h3) { bin = 4 * lane + 3; cum = a3; }
                else if (a2 < kk && kk <= a2 + h2) { bin = 4 * lane + 2; cum = a2; }
                else if (a1 < kk && kk <= a1 + h1) { bin = 4 * lane + 1; cum = a1; }
                else if (a0 < kk && kk <= a0 + h0) { bin = 4 * lane; cum = a0; }
                if (bin >= 0) { CTL[0] = prefix | ((unsigned)bin << shift); CTL[1] = kk - cum; }
            }
            __syncthreads();
            prefix = CTL[0]; kk = CTL[1];
            __syncthreads();
        }
        int ceq = 0;
#pragma unroll
        for (int i = 0; i < 8; ++i) ceq += (key[i] == prefix);
        int seq = ceq;
#pragma unroll
        for (int o = 1; o < 64; o <<= 1) { const int t = __shfl_up(seq, o); if (lane >= o) seq += t; }
        if (lane == 63) WS1[wave] = (unsigned)seq;
        __syncthreads();
        int eqbase = seq - ceq;
        for (int w = 0; w < wave; ++w) eqbase += (int)WS1[w];
        int csel = 0; unsigned selmask = 0u; int er = eqbase;
#pragma unroll
        for (int i = 0; i < 8; ++i) { bool s = key[i] > prefix; if (key[i] == prefix) { s = (unsigned)er < kk; ++er; } if (s) { selmask |= 1u << i; ++csel; } }
        int ssel = csel;
#pragma unroll
        for (int o = 1; o < 64; o <<= 1) { const int t = __shfl_up(ssel, o); if (lane >= o) ssel += t; }
        if (lane == 63) WS1[8 + wave] = (unsigned)ssel;
        __syncthreads();
        int pos = ssel - csel;
        for (int w = 0; w < wave; ++w) pos += (int)WS1[8 + w];
        const int obase = (e * 8 + b) * CAP;
#pragma unroll
        for (int i = 0; i < 8; ++i) if (selmask & (1u << i)) { if (pos < CAP) { const int tok = b * SEQ + tid * 8 + i; ROWMAP[obase + pos] = tok; VAL[obase + pos] = __uint_as_float(key[i]); INV[(size_t)tok * 16 + e] = obase + pos; } ++pos; }
        __syncthreads();
    }
}

struct MoeGUOrder {
    static constexpr bool GATHER = true;
    const int* rowmap; int G, c;
    DI bool next(int i, pg8::Unit& u) const {
        const int cc = (G % 8 == 0) ? (c % 8) * (G / 8) + c / 8 : c;
        const int L = i * G + cc; if (L >= NE * 256) return false;
        const int e = L >> 8, loc = L & 255, xg = loc >> 5, r = loc & 31;
        u.pm = e * 16 + (xg >> 1) * 4 + (r >> 3); u.pn = (xg & 1) * 8 + (r & 7); return true;
    }
    DI size_t bt_row0(const pg8::Unit& u) const { return (size_t)(u.pm >> 4) * 4096 + (size_t)u.pn * 256; }
};
struct EpiGU {
    static constexpr bool PERM = true;
    unsigned char* ACT; LAS unsigned char* ebuf;
    DI void operator()(const f32x4 (&acc)[2][2][4][2], const pg8::Unit& u, int wr, int wc, int fr, int fq) const {
        int tid = threadIdx.x; asm volatile("" : "+v"(tid));
        if (wr == 0) __builtin_amdgcn_s_barrier();
#pragma unroll
        for (int ai = 0; ai < 2; ++ai) {
            if (ai) lds_barrier();
#pragma unroll
            for (int m = 0; m < 4; ++m) { float o[8];
#pragma unroll
                for (int n = 0; n < 2; ++n)
#pragma unroll
                    for (int j = 0; j < 4; ++j) o[4 * n + j] = silu_f(acc[ai][0][m][n][j]) * acc[ai][1][m][n][j];
                u32x2 w; w.x = pk_fp8x4(o[0], o[1], o[2], o[3]); w.y = pk_fp8x4(o[4], o[5], o[6], o[7]);
                *(LAS u32x2*)(ebuf + (wr * 64 + m * 16 + fr) * 144 + wc * 32 + 8 * fq) = w; }
            lds_barrier();
#pragma unroll
            for (int i = 0; i < 2; ++i) { const int q = tid + 512 * i, row = q >> 3, c16 = q & 7;
                const u32x4 v = *(const LAS u32x4*)(ebuf + row * 144 + c16 * 16);
                *(u32x4*)(ACT + (size_t)(u.pm * 256 + ai * 128 + row) * DEXP + u.pn * 128 + c16 * 16) = v; }
        }
        if (wr == 1) __builtin_amdgcn_s_barrier();
    }
};
struct MoeDownOrder {
    static constexpr bool GATHER = false;
    const int* rowmap; int G, c;
    DI bool next(int i, pg8::Unit& u) const {
        const int cc = (G % 8 == 0) ? (c % 8) * (G / 8) + c / 8 : c;
        const int L = i * G + cc; if (L >= 1024) return false;
        u.pm = L >> 2; u.pn = L & 3; return true;
    }
    DI size_t bt_row0(const pg8::Unit& u) const { return (size_t)(u.pm >> 4) * 1024 + (size_t)u.pn * 256; }
};
struct EpiDown {
    static constexpr bool PERM = true;
    const float* val; unsigned char* YB; LAS unsigned char* ebuf;
    DI void operator()(const f32x4 (&acc)[2][2][4][2], const pg8::Unit& u, int wr, int wc, int fr, int fq) const {
        int tid = threadIdx.x; asm volatile("" : "+v"(tid));
        if (wr == 0) __builtin_amdgcn_s_barrier();
#pragma unroll
        for (int ps = 0; ps < 4; ++ps) { const int ai = ps >> 1, mh = ps & 1;
            if (ps) lds_barrier();
#pragma unroll
            for (int mm = 0; mm < 2; ++mm) { const int m = 2 * mh + mm; const int r = u.pm * 256 + ai * 128 + wr * 64 + m * 16 + fr; const float v = val[r] * 16.f;
#pragma unroll
                for (int bj = 0; bj < 2; ++bj) { const f32x4 v0 = acc[ai][bj][m][0] * v, v1 = acc[ai][bj][m][1] * v;
                    u32x2 w; w.x = pk_fp8x4(v0[0], v0[1], v0[2], v0[3]); w.y = pk_fp8x4(v1[0], v1[1], v1[2], v1[3]);
                    *(LAS u32x2*)(ebuf + (wr * 32 + mm * 16 + fr) * 272 + bj * 128 + wc * 32 + 8 * fq) = w; } }
            lds_barrier();
#pragma unroll
            for (int i = 0; i < 2; ++i) { const int q = tid + 512 * i, lr = q >> 4, c16 = q & 15;
                const u32x4 vv = *(const LAS u32x4*)(ebuf + lr * 272 + c16 * 16);
                *(u32x4*)(YB + (size_t)(u.pm * 256 + ai * 128 + (lr >> 5) * 64 + mh * 32 + (lr & 31)) * DM + u.pn * 256 + c16 * 16) = vv; }
        }
        if (wr == 1) __builtin_amdgcn_s_barrier();
    }
};

DI void final_slots(const unsigned char* YB, int inv, int lane, unsigned& mask, int& cnt, unsigned (&yb)[4][4]) {
    mask = (unsigned)(__ballot(inv >= 0) & 0xffffull); cnt = __builtin_popcount(mask);
    unsigned mm = mask;
#pragma unroll
    for (int k = 0; k < 4; ++k) { if (mm != 0u) { const int e = __builtin_ctz(mm); mm &= mm - 1u; const int r = __builtin_amdgcn_readlane(inv, e);
            const unsigned* yr = (const unsigned*)(YB + (size_t)r * DM) + lane;
#pragma unroll
            for (int j = 0; j < 4; ++j) yb[k][j] = yr[64 * j]; } }
}
DI void phase_final(Ctx& F) {
    relaunder(F);
    const float* fw = kin(21); const float* MOD = (const float*)(F.ws + WS_MOD);
    const int* INV = (const int*)(F.ws + WS_INV); const unsigned char* YB = F.ws + WS_YB; const bf16_t* X1 = (const bf16_t*)(F.ws + WS_X1);
    const int gw = F.bid * 8 + F.wave, NGW = F.G * 8, lane = F.lane;
    if (gw >= NTOK) return;
    int inv_c = (lane < 16) ? INV[(size_t)gw * 16 + lane] : -1;
    int inv_n = (lane < 16 && gw + NGW < NTOK) ? INV[(size_t)(gw + NGW) * 16 + lane] : -1;
    u32x2 xc[4], xn[4];
    { const u32x2* x1r = (const u32x2*)(X1 + (size_t)gw * DM) + lane;
#pragma unroll
      for (int j = 0; j < 4; ++j) { xc[j] = x1r[64 * j]; xn[j] = xc[j]; } }
    unsigned ybc[4][4], ybn[4][4]; unsigned mask_c = 0u, mask_n = 0u; int cnt_c = 0, cnt_n = 0;
#pragma unroll
    for (int k = 0; k < 4; ++k)
#pragma unroll
        for (int j = 0; j < 4; ++j) { ybc[k][j] = 0u; ybn[k][j] = 0u; }
    final_slots(YB, inv_c, lane, mask_c, cnt_c, ybc);
    for (int m = gw; m < NTOK; m += NGW) {
        const int b = m >> 12, mn = m + NGW, mnn = m + 2 * NGW;
        int inv_nn = -1;
        if (mn < NTOK) { const u32x2* x1r = (const u32x2*)(X1 + (size_t)mn * DM) + lane;
#pragma unroll
            for (int j = 0; j < 4; ++j) xn[j] = x1r[64 * j];
            final_slots(YB, inv_n, lane, mask_n, cnt_n, ybn);
            if (lane < 16 && mnn < NTOK) inv_nn = INV[(size_t)mnn * 16 + lane]; }
        f32x4 v[4], a[4];
#pragma unroll
        for (int j = 0; j < 4; ++j) { v[j] = (f32x4){bflo(xc[j].x), bfhi(xc[j].x), bflo(xc[j].y), bfhi(xc[j].y)}; a[j] = (f32x4){0.f, 0.f, 0.f, 0.f}; }
#pragma unroll
        for (int k = 0; k < 4; ++k) if (k < cnt_c) {
#pragma unroll
            for (int j = 0; j < 4; ++j) { const f32v2 lo = __builtin_amdgcn_cvt_pk_f32_fp8(ybc[k][j], false), hi = __builtin_amdgcn_cvt_pk_f32_fp8(ybc[k][j], true);
                a[j].x += lo.x; a[j].y += lo.y; a[j].z += hi.x; a[j].w += hi.y; } }
        if (cnt_c > 4) {
            unsigned mm = mask_c; mm &= mm - 1u; mm &= mm - 1u; mm &= mm - 1u; mm &= mm - 1u;
            while (mm != 0u) { const int e = __builtin_ctz(mm); mm &= mm - 1u; const int r = __builtin_amdgcn_readlane(inv_c, e);
                const unsigned* yr = (const unsigned*)(YB + (size_t)r * DM) + lane;
#pragma unroll
                for (int j = 0; j < 4; ++j) { const unsigned y = yr[64 * j]; const f32v2 lo = __builtin_amdgcn_cvt_pk_f32_fp8(y, false), hi = __builtin_amdgcn_cvt_pk_f32_fp8(y, true);
                    a[j].x += lo.x; a[j].y += lo.y; a[j].z += hi.x; a[j].w += hi.y; } } }
        const f32x4* g4 = (const f32x4*)(MOD + b * 6144 + 5120) + lane;
        float s = 0.f;
#pragma unroll
        for (int j = 0; j < 4; ++j) { v[j] = v[j] + g4[64 * j] * a[j] * (1.f / 16.f); s += (v[j].x * v[j].x + v[j].y * v[j].y) + (v[j].z * v[j].z + v[j].w * v[j].w); }
        const float rstd = rsqrtf(wave_sum(s) * (1.f / DM) + 1e-6f);
        const f32x4* w4 = (const f32x4*)fw + lane;
        f32x4* xr = (f32x4*)(F.out + (size_t)m * DM) + lane;
#pragma unroll
        for (int j = 0; j < 4; ++j) xr[64 * j] = v[j] * rstd * w4[64 * j];
#pragma unroll
        for (int j = 0; j < 4; ++j) xc[j] = xn[j];
#pragma unroll
        for (int k = 0; k < 4; ++k)
#pragma unroll
            for (int j = 0; j < 4; ++j) ybc[k][j] = ybn[k][j];
        mask_c = mask_n; cnt_c = cnt_n; inv_c = inv_n; inv_n = inv_nn;
    }
}

__global__ void __launch_bounds__(512) fwd_megakernel(Params p) {
    extern __shared__ __attribute__((aligned(16))) unsigned char lds_raw[];
    cg::grid_group grid = cg::this_grid();
    Ctx F;
    F.lds = (LAS unsigned char*)lds_raw;
    F.tid = threadIdx.x; F.lane = F.tid & 63; F.wave = __builtin_amdgcn_readfirstlane(F.tid >> 6); F.G = gridDim.x; F.bid = blockIdx.x;
    F.out = p.out; F.ws = p.ws;

    {
        if (F.tid == 0) { ((LAS unsigned*)(F.lds + LDS_BYTES - 16))[0] = 0u; ((LAS unsigned*)(F.lds + LDS_BYTES - 16))[1] = 0u; }
        if (F.bid == 0) { unsigned* bw = (unsigned*)(F.ws + WS_BAR); for (int i = F.tid; i < XCD_BAR_WORDS + 256; i += 512) bw[i] = 0u; }
        __syncthreads();
    }
    phase0(F);
    grid.sync();
    const XcdBarrier xbar = xcd_barrier_post((unsigned*)(F.ws + WS_BAR), (volatile LAS unsigned*)(F.lds + LDS_BYTES - 16));
    phase_h(F);
    xcd_barrier(xbar);
    {
        pg8::RectOrder S; S.init(128, 19, F.G, F.bid); S.nextra = 8 * 11; S.ex_m0 = 128; S.ex_n0 = 8; S.ex_nm = 8;
        EpiInProj E{(bf16_t*)(F.ws + WS_R2), (bf16_t*)F.out, (bf16_t*)(F.ws + WS_R4), (float*)(F.ws + WS_R5), kin(10)};
        pg8::gemm_phase<false, false>(F.lds, F.ws + WS_R1, F.ws + WS_WIN, DM * 2, S, E);
    }
    xcd_barrier(xbar);
    fft_step1(F);
    conv_cb_phase(F);
    xcd_barrier(xbar);
    if (F.bid < 192) { const int x = F.bid & 7, j = F.bid >> 3, gi = x * 4 + j / 6;
        ssd_unit(F, gi >> 2, (gi & 3) * 6 + j % 6); }
    else {
        const int sb = F.bid, sg = F.G; F.bid = sb - 192; F.G = sg - 192; fft_step2(F); F.bid = sb; F.G = sg;
        __syncthreads();
        moe_weight_items(F, (sb - 192) * 8 + F.wave, (sg - 192) * 8);
    }
    xcd_barrier(xbar);
    {
        pg8::RectOrder S; S.init(128, 4, F.G, F.bid);
        EpiOutProj E{kin(0), (const float*)(F.ws + WS_MOD), (bf16_t*)(F.ws + WS_X1)};
        LAS float* rs_tab = (LAS float*)(F.lds + pg8::STAGE_BYTES);
        { const float* SS = (const float*)(F.ws + WS_SS);
          for (int i = F.tid; i < 512; i += 512) { pg8::Unit u; if (!S.next(i >> 8, u)) break;
              const float* sp = SS + (size_t)(u.pm * 256 + (i & 255)) * NH; float r[4];
#pragma unroll
              for (int g = 0; g < 4; ++g) { float t = 0.f;
#pragma unroll
                  for (int k = 0; k < 6; ++k) t += sp[g * 6 + k];
                  r[g] = rsqrtf(t * (1.f / 384.f) + 1e-6f); }
              LAS float* o = rs_tab + (size_t)i * 8;
              o[0] = 1.f / r[0]; o[1] = r[0] / r[1]; o[2] = r[1] / r[2]; o[3] = r[2] / r[3]; o[4] = r[3]; }
          __syncthreads(); }
        pg8::gemm_phase<false, true>(F.lds, F.ws + WS_R4, F.ws + WS_WOUT, DMIX * 2, S, E, rs_tab);
    }
    xcd_barrier(xbar);
    phase_router(F);
    xcd_barrier(xbar);
    phase_topk(F);
    xcd_barrier(xbar);
    {
        MoeGUOrder S; S.rowmap = (const int*)(F.ws + WS_ROWMAP); S.G = F.G; S.c = F.bid;
        EpiGU E{F.ws + WS_ACT, F.lds + pg8::STAGE_BYTES};
        pg8::gemm_phase<true, false>(F.lds, F.ws + WS_H2, F.ws + WS_WGU, DM, S, E);
    }
    xcd_barrier(xbar);
    {
        MoeDownOrder S; S.rowmap = nullptr; S.G = F.G; S.c = F.bid;
        EpiDown E{(const float*)(F.ws + WS_VAL), F.ws + WS_YB, F.lds + pg8::STAGE_BYTES};
        pg8::gemm_phase<true, false>(F.lds, F.ws + WS_ACT, F.ws + WS_WD, DEXP, S, E);
    }
    xcd_barrier(xbar);
    phase_final(F);
}

extern "C" void kernel_launch(void* const* d_in, const int* in_sizes, int n_in, void* d_out, int out_size, void* d_ws, size_t ws_size, hipStream_t stream) {
    static int grid_blocks = 0;
    if (!grid_blocks) {
        int dev = 0, cus = 0, per_cu = 0;
        (void)hipGetDevice(&dev);
        (void)hipDeviceGetAttribute(&cus, hipDeviceAttributeMultiprocessorCount, dev);
        (void)hipFuncSetAttribute((const void*)fwd_megakernel, hipFuncAttributeMaxDynamicSharedMemorySize, LDS_BYTES);
        (void)hipOccupancyMaxActiveBlocksPerMultiprocessor(&per_cu, (const void*)fwd_megakernel, 512, LDS_BYTES);
        if (per_cu < 1) per_cu = 1;
        grid_blocks = cus * per_cu;
        fprintf(stderr, "grid %d (cus %d per_cu %d) ws %zu need %zu\n", grid_blocks, cus, per_cu, ws_size, (size_t)WS_NEED);
        if (grid_blocks != 256) { fprintf(stderr, "this kernel's phase program is written for a 256-workgroup grid (one per CU); got %d\n", grid_blocks); grid_blocks = -1; }
        else if (ws_size < WS_NEED || n_in != 22) { fprintf(stderr, "workspace too small or bad inputs\n"); grid_blocks = -1; }
    }
    if (grid_blocks < 0) return;
    Params p{};
    for (int i = 0; i < 22; ++i) p.in[i] = (const float*)d_in[i];
    p.out = (float*)d_out; p.ws = (unsigned char*)d_ws;
    void* args[] = {&p};
    hipError_t e = hipLaunchCooperativeKernel((void*)fwd_megakernel, dim3(grid_blocks), dim3(512), args, LDS_BYTES, stream);
    if (e != hipSuccess) fprintf(stderr, "cooperative launch failed: %s (grid %d)\n", hipGetErrorString(e), grid_blocks);
}
```

```cpp
#include <hip/hip_runtime.h>
#include <hip/hip_cooperative_groups.h>
#include <cstdio>
namespace cg = cooperative_groups;

#define LAS __attribute__((address_space(3)))
#define DI __device__ __forceinline__
typedef unsigned short bf16_t;
typedef short bf16x8 __attribute__((ext_vector_type(8)));
typedef short s16x4 __attribute__((ext_vector_type(4)));
typedef float f32x4 __attribute__((ext_vector_type(4)));
typedef float f32x16 __attribute__((ext_vector_type(16)));
typedef unsigned u32x4 __attribute__((ext_vector_type(4)));
typedef unsigned u32x2 __attribute__((ext_vector_type(2)));

constexpr int NB = 8, SEQ = 4096, DM = 1024, CTXL = 256;
constexpr int NTOK = NB * SEQ;
constexpr int NCTX = NB * CTXL;
constexpr int NROWS = NTOK + NCTX;
constexpr int DIN = 4656, DIN_T = 4864;
constexpr int DSSM = 1536, NH = 24, HD = 64, NG = 4, DST = 128, CONVD = 2560, DMIX = 2048;
constexpr int NE = 16, CAP = 512, DEXP = 2048;
constexpr int LDS_BYTES = 163840;

constexpr size_t MB = 1u << 20;
constexpr size_t WS_MOD   = 4096;
constexpr size_t WS_WOUT  = 1 * MB;
constexpr size_t WS_WIN   = WS_WOUT + (size_t)DM * DMIX * 2;
constexpr size_t WS_R1    = WS_WIN + (size_t)DIN_T * DM * 2;
constexpr size_t WS_R2    = WS_R1 + (size_t)NROWS * DM * 2;
constexpr size_t WS_R4    = WS_R2 + (size_t)NTOK * DM * 2;
constexpr size_t WS_R5    = WS_R4 + (size_t)NROWS * CONVD * 2;
constexpr size_t WS_XS    = WS_R5 + (size_t)NROWS * 48 * 4;
constexpr size_t WS_BM    = WS_XS + (size_t)NROWS * DSSM * 2;
constexpr size_t WS_CM    = WS_BM + (size_t)NROWS * 512 * 2;
constexpr size_t WS_CB    = WS_CM + (size_t)NROWS * 512 * 2;
constexpr size_t WS_SS    = WS_CB + (size_t)NB * 32 * NG * 16384 * 2;
constexpr size_t WS_ARRS  = WS_SS + (size_t)NTOK * NH * 4;
constexpr size_t WS_END1  = WS_ARRS + (size_t)NB * 34 * NH * 768 * 4;

constexpr size_t WS_ROWMAP = 256 * 1024;
constexpr size_t WS_VAL    = 512 * 1024;
constexpr size_t WS_WGU    = WS_R2;
constexpr size_t WS_WD     = WS_R4 + (size_t)NTOK * DMIX * 2;
constexpr size_t WS_H2     = WS_R1;
constexpr size_t WS_ACT    = WS_XS;
constexpr size_t WS_PROBS  = WS_ACT + (size_t)NE * NB * CAP * DEXP;
constexpr size_t WS_INV    = WS_PROBS + (size_t)NB * NE * SEQ * 4;
constexpr size_t WS_YB     = WS_R4;
constexpr size_t WS_X1     = WS_INV + (size_t)NTOK * NE * 4;
constexpr size_t WS_END2   = WS_X1 + (size_t)NTOK * DM * 2;
constexpr size_t WS_BAR    = 768 * 1024;
static_assert(WS_WD + (size_t)NE * DM * DEXP <= WS_R5 && WS_WGU + (size_t)NE * 4096 * DM <= WS_R4 && WS_END2 <= WS_SS && WS_H2 + (size_t)NTOK * DM <= WS_R2, "MoE stage layout");
constexpr size_t WS_NEED   = WS_END1 > WS_END2 ? WS_END1 : WS_END2;

typedef __bf16 bf16v2 __attribute__((ext_vector_type(2)));
typedef float f32v2 __attribute__((ext_vector_type(2)));
DI unsigned cvt_pk_bf16(float lo, float hi) { f32v2 f = {lo, hi}; bf16v2 h = __builtin_convertvector(f, bf16v2); return __builtin_bit_cast(unsigned, h); }
DI bf16_t f2bf(float f) { return (bf16_t)(cvt_pk_bf16(f, 0.f) & 0xffffu); }
DI float bf2f(bf16_t b) { return __uint_as_float(((unsigned)b) << 16); }
DI float silu_f(float x) { return x * __builtin_amdgcn_rcpf(1.f + __expf(-x)); }
DI float softplus_f(float x) { return fmaxf(x, 0.f) + log1pf(__expf(-fabsf(x))); }
DI float wave_sum(float v) {
#pragma unroll
    for (int o = 1; o < 64; o <<= 1) v += __shfl_xor(v, o);
    return v;
}
DI unsigned pk_fp8x4(float a, float b, float c, float d) { unsigned w = 0u; w = __builtin_amdgcn_cvt_pk_fp8_f32(a, b, w, false); w = __builtin_amdgcn_cvt_pk_fp8_f32(c, d, w, true); return w; }
DI void lds_wait() { asm volatile("s_waitcnt lgkmcnt(0)" ::: "memory"); }
DI void lds_barrier() { asm volatile("s_waitcnt lgkmcnt(0)" ::: "memory"); __builtin_amdgcn_s_barrier(); asm volatile("" ::: "memory"); }

namespace pg8 {
constexpr int BM = 256, BK = 64, HALF = 128, HTB = HALF * BK * 2, STAGE_BYTES = 8 * HTB;
DI int lds_byte(int r, int c) { const int st = (r >> 4) * 2 + (c >> 5), rr = r & 15, cc = c & 31, ob = rr * 64 + cc * 2; return st * 1024 + (ob ^ (((ob >> 9) & 1) << 5)); }
DI void stage_rc(int b, int& R, int& C) { const int st = b / 1024, sb = b % 1024, swz = sb ^ (((sb >> 9) & 1) << 5); R = (st >> 1) * 16 + swz / 64; C = (st & 1) * 32 + (swz % 64) / 2; }
DI int perm32(int rho) { const int n = rho >> 4, i = rho & 15; return 8 * (i >> 2) + 4 * n + (i & 3); }
struct Unit { int pm, pn; };

template <class Ord>
DI void a_offsets(const Ord& S, const Unit& u, int KB, int tid, unsigned (&ao)[2][2]) {
#pragma unroll
    for (int h = 0; h < 2; ++h)
#pragma unroll
        for (int i = 0; i < 2; ++i) { int R, C; stage_rc(tid * 16 + i * 8192, R, C); const int r = S.rowmap[u.pm * BM + h * HALF + R]; ao[h][i] = (unsigned)r * (unsigned)KB + (unsigned)C * 2u; }
}

typedef int i32x4v __attribute__((ext_vector_type(4)));
typedef int i32x8v __attribute__((ext_vector_type(8)));
DI i32x8v cat8(bf16x8 a, bf16x8 b) { return __builtin_shufflevector(__builtin_bit_cast(i32x4v, a), __builtin_bit_cast(i32x4v, b), 0, 1, 2, 3, 4, 5, 6, 7); }
template <bool FP8, bool RS, class Epi, class Ord>
DI void gemm_phase(LAS unsigned char* lds, const void* A, const void* Bt, const int KB, const Ord& S, const Epi& E, const LAS float* rs_tab = nullptr) {
    int tid_ = threadIdx.x; asm volatile("" : "+v"(tid_));
    const int tid = tid_, wid = __builtin_amdgcn_readfirstlane(tid >> 6), lane = tid & 63, wr = wid >> 2, wc = wid & 3, fr = lane & 15, fq = lane >> 4;
    const int nt = KB / 128;
    constexpr bool GA = Ord::GATHER;
    unsigned voffA[2], voffB[2];
#pragma unroll
    for (int i = 0; i < 2; ++i) { int R, C; stage_rc(tid * 16 + i * 8192, R, C); const int Rb = Epi::PERM ? ((R & ~31) + perm32(R & 31)) : R; voffA[i] = (unsigned)(R * KB + C * 2); voffB[i] = (unsigned)(Rb * KB + C * 2); }
    const size_t tstep = (size_t)BM * KB;
    const size_t kstep = (size_t)(BK * 2);
    const size_t hstep = (size_t)HALF * KB;
    const unsigned ldsw = (unsigned)wid * 1024u;
    const int aoff = lds_byte(wr * 64 + fr, fq * 8), boff = lds_byte(wc * 32 + fr, fq * 8);
#define PG8_SA(b, h) (((b) * 2 + (h)) * HTB)
#define PG8_SB(b, h) ((4 + (b) * 2 + (h)) * HTB)
#define PG8_STAGE(bufoff, gbase, voff) do { _Pragma("unroll") for (int _i = 0; _i < 2; ++_i) \
        __builtin_amdgcn_global_load_lds((const unsigned*)((const char*)(gbase) + (voff)[_i]), (LAS unsigned*)(lds + (bufoff) + ldsw + _i * 8192), 16, 0, 0); } while (0)
#define PG8_LDA(dst, b, h) do { _Pragma("unroll") for (int m = 0; m < 4; ++m) dst[m] = cat8(*(const LAS bf16x8*)(lds + PG8_SA(b, h) + aoff + m * 2048), *(const LAS bf16x8*)(lds + PG8_SA(b, h) + aoff + m * 2048 + 1024)); } while (0)
#define PG8_LDB(dst, b, h) do { _Pragma("unroll") for (int n = 0; n < 2; ++n) dst[n] = cat8(*(const LAS bf16x8*)(lds + PG8_SB(b, h) + boff + n * 2048), *(const LAS bf16x8*)(lds + PG8_SB(b, h) + boff + n * 2048 + 1024)); } while (0)
#define PG8_LO(v) __builtin_bit_cast(bf16x8, __builtin_shufflevector(v, v, 0, 1, 2, 3))
#define PG8_HI(v) __builtin_bit_cast(bf16x8, __builtin_shufflevector(v, v, 4, 5, 6, 7))
#define PG8_MMA(ai, bj, At, Bt_) do { __builtin_amdgcn_s_setprio(1); _Pragma("unroll") for (int m = 0; m < 4; ++m) _Pragma("unroll") for (int n = 0; n < 2; ++n) { \
        if constexpr (FP8) asm volatile("v_mfma_scale_f32_16x16x128_f8f6f4 %0, %1, %2, %0, %3, %4 op_sel_hi:[0,0,0]" : "+v"(acc[ai][bj][m][n]) : "v"(Bt_[n]), "v"(At[m]), "v"(scl_w), "v"(scl_a)); \
        else { acc[ai][bj][m][n] = __builtin_amdgcn_mfma_f32_16x16x32_bf16(PG8_LO(Bt_[n]), PG8_LO(At[m]), acc[ai][bj][m][n], 0, 0, 0); \
               acc[ai][bj][m][n] = __builtin_amdgcn_mfma_f32_16x16x32_bf16(PG8_HI(Bt_[n]), PG8_HI(At[m]), acc[ai][bj][m][n], 0, 0, 0); } } \
        __builtin_amdgcn_s_setprio(0); } while (0)
#define PG8_WAIT_V(n) asm volatile("s_waitcnt vmcnt(" #n ")" ::: "memory")
#define PG8_WAIT_L(n) asm volatile("s_waitcnt lgkmcnt(" #n ")" ::: "memory")
#define PG8_BAR __builtin_amdgcn_s_barrier()
#define PG8_SCHED __builtin_amdgcn_sched_barrier(0)
    Unit cur, nxt; int ui = 0;
    if (!S.next(0, cur)) return;
    f32x4 acc[2][2][4][2];
#pragma unroll
    for (int a = 0; a < 2; ++a)
#pragma unroll
        for (int b = 0; b < 2; ++b)
#pragma unroll
            for (int m = 0; m < 4; ++m)
#pragma unroll
                for (int n = 0; n < 2; ++n) acc[a][b][m][n] = (f32x4){0.f, 0.f, 0.f, 0.f};
    i32x8v At[4], B0[2], B1[2];
    const int scl_w = 0x7a7a7a7a, scl_a = 0x7f7f7f7f;
    unsigned aoc[2][2], aon[2][2];
    if constexpr (GA) a_offsets(S, cur, KB, tid, aoc);
    const char* const Ab = (const char*)A;
    const char* cA = GA ? Ab : Ab + (size_t)cur.pm * tstep;
#define PG8_AP(p, h) (GA ? (p) : (p) + (h) * hstep)
#define PG8_AO(o, h) (GA ? (o)[h] : voffA)
    const char* cB = (const char*)Bt + S.bt_row0(cur) * (size_t)KB;
    PG8_STAGE(PG8_SB(0, 0), cB, voffB); PG8_STAGE(PG8_SA(0, 0), PG8_AP(cA, 0), PG8_AO(aoc, 0)); PG8_STAGE(PG8_SB(0, 1), cB + hstep, voffB); PG8_STAGE(PG8_SA(0, 1), PG8_AP(cA, 1), PG8_AO(aoc, 1));
    if (wr == 1) PG8_BAR;
    PG8_WAIT_V(4); PG8_BAR;
    PG8_STAGE(PG8_SB(1, 0), cB + kstep, voffB); PG8_STAGE(PG8_SA(1, 0), PG8_AP(cA + kstep, 0), PG8_AO(aoc, 0)); PG8_STAGE(PG8_SB(1, 1), cB + hstep + kstep, voffB);
    PG8_WAIT_V(6); PG8_BAR;
    for (;;) {
        const bool has_next = S.next(ui + 1, nxt);
        const char* nB = cB; const char* nA = cA;
        if (has_next) { if constexpr (GA) a_offsets(S, nxt, KB, tid, aon); else nA = Ab + (size_t)nxt.pm * tstep; nB = (const char*)Bt + S.bt_row0(nxt) * (size_t)KB; }
        else if constexpr (GA) {
#pragma unroll
            for (int h = 0; h < 2; ++h)
#pragma unroll
                for (int i = 0; i < 2; ++i) aon[h][i] = aoc[h][i];
        }
#pragma unroll 1
        for (int t = 0; t < nt; t += 2) {
            const bool last = (t == nt - 2);
            float rsv[2][4]; bool rs_now = false;
            if constexpr (RS) { const int tn = t + 2; rs_now = (tn >= 8) && ((tn - 8) % 6 == 0);
                if (rs_now) { const int bi = (tn - 8) / 6; const LAS float* tb = rs_tab + (size_t)(ui & 1) * 256 * 8 + bi;
#pragma unroll
                    for (int ai = 0; ai < 2; ++ai)
#pragma unroll
                        for (int m = 0; m < 4; ++m) rsv[ai][m] = tb[(ai * HALF + wr * 64 + m * 16 + fr) * 8]; } }
            const char* a1 = cA + (size_t)(t + 1) * kstep;
            const char* a2 = last ? nA : cA + (size_t)(t + 2) * kstep; const char* b2 = last ? nB : cB + (size_t)(t + 2) * kstep;
            const char* a3 = a2 + kstep; const char* b3 = b2 + kstep;
            unsigned o2[2][2];
            if constexpr (GA) {
#pragma unroll
                for (int h = 0; h < 2; ++h)
#pragma unroll
                    for (int i = 0; i < 2; ++i) o2[h][i] = last ? aon[h][i] : aoc[h][i];
            }
            PG8_LDB(B0, 0, 0); PG8_SCHED; PG8_LDA(At, 0, 0); PG8_STAGE(PG8_SA(1, 1), PG8_AP(a1, 1), PG8_AO(aoc, 1));
            PG8_WAIT_L(8); PG8_BAR; PG8_WAIT_L(0); PG8_MMA(0, 0, At, B0); PG8_BAR; PG8_SCHED;
            PG8_LDB(B1, 0, 1); PG8_STAGE(PG8_SB(0, 0), b2, voffB);
            PG8_BAR; PG8_WAIT_L(0); PG8_MMA(0, 1, At, B1); PG8_BAR;
            PG8_LDA(At, 0, 1); PG8_STAGE(PG8_SA(0, 0), PG8_AP(a2, 0), PG8_AO(o2, 0));
            PG8_BAR; PG8_WAIT_L(0); PG8_MMA(1, 0, At, B0); PG8_BAR; PG8_SCHED;
            PG8_STAGE(PG8_SB(0, 1), b2 + hstep, voffB);
            PG8_WAIT_V(6); PG8_BAR; PG8_MMA(1, 1, At, B1); PG8_BAR;
            PG8_LDB(B0, 1, 0); PG8_SCHED; PG8_LDA(At, 1, 0); PG8_STAGE(PG8_SA(0, 1), PG8_AP(a2, 1), PG8_AO(o2, 1));
            PG8_WAIT_L(8); PG8_BAR; PG8_WAIT_L(0); PG8_MMA(0, 0, At, B0); PG8_BAR; PG8_SCHED;
            PG8_LDB(B1, 1, 1); PG8_STAGE(PG8_SB(1, 0), b3, voffB);
            PG8_BAR; PG8_WAIT_L(0); PG8_MMA(0, 1, At, B1); PG8_BAR;
            PG8_LDA(At, 1, 1); PG8_STAGE(PG8_SA(1, 0), PG8_AP(a3, 0), PG8_AO(o2, 0));
            PG8_BAR; PG8_WAIT_L(0); PG8_MMA(1, 0, At, B0); PG8_BAR; PG8_SCHED;
            PG8_STAGE(PG8_SB(1, 1), b3 + hstep, voffB);
            PG8_WAIT_V(6); PG8_BAR; PG8_MMA(1, 1, At, B1); PG8_BAR;
            if constexpr (RS) { if (rs_now) {
#pragma unroll
                for (int ai = 0; ai < 2; ++ai)
#pragma unroll
                    for (int bj = 0; bj < 2; ++bj)
#pragma unroll
                        for (int m = 0; m < 4; ++m)
#pragma unroll
                            for (int n = 0; n < 2; ++n) acc[ai][bj][m][n] = acc[ai][bj][m][n] * rsv[ai][m]; } }
        }
        if constexpr (FP8) asm volatile("s_nop 15\n\ts_nop 15" ::: "memory");
        E(acc, cur, wr, wc, fr, fq);
        if (!has_next) break;
#pragma unroll
        for (int a = 0; a < 2; ++a)
#pragma unroll
            for (int b = 0; b < 2; ++b)
#pragma unroll
                for (int m = 0; m < 4; ++m)
#pragma unroll
                    for (int n = 0; n < 2; ++n) acc[a][b][m][n] = (f32x4){0.f, 0.f, 0.f, 0.f};
        cur = nxt; cB = nB; cA = nA; ++ui;
        if constexpr (GA) {
#pragma unroll
            for (int h = 0; h < 2; ++h)
#pragma unroll
                for (int i = 0; i < 2; ++i) aoc[h][i] = aon[h][i];
        }
    }
    PG8_WAIT_V(0);
    if (wr == 0) PG8_BAR;
    PG8_BAR;
#undef PG8_AP
#undef PG8_AO
#undef PG8_SA
#undef PG8_SB
#undef PG8_STAGE
#undef PG8_LO
#undef PG8_HI
#undef PG8_LDA
#undef PG8_LDB
#undef PG8_MMA
#undef PG8_WAIT_V
#undef PG8_WAIT_L
#undef PG8_BAR
#undef PG8_SCHED
}

struct RectOrder {
    static constexpr bool GATHER = false;
    const int* rowmap;
    int nM, nN, nwg, G, c, nextra, ex_m0, ex_n0, ex_nm;
    DI void init(int nM_, int nN_, int G_, int c_) { nM = nM_; nN = nN_; nwg = nM * nN; G = G_; c = c_; nextra = 0; ex_m0 = ex_n0 = 0; ex_nm = 1; rowmap = nullptr; }
    DI bool next(int i, Unit& u) const {
        const int L = i * G + c; if (L >= nwg + nextra) return false;
        if (L >= nwg) { const int e = L - nwg; u.pm = ex_m0 + e % ex_nm; u.pn = ex_n0 + e / ex_nm; return true; }
        int wgid = L; { const int q = nwg / 8, r = nwg % 8, xcd = wgid % 8, off = wgid / 8; wgid = (xcd < r ? xcd * (q + 1) : r * (q + 1) + (xcd - r) * q) + off; }
        const int nig = 8 * nN, gid = wgid / nig, fm = gid * 8, gsz = (nM - fm) < 8 ? (nM - fm) : 8;
        u.pm = fm + ((wgid % nig) % gsz); u.pn = (wgid % nig) / gsz; return true;
    }
    DI size_t bt_row0(const Unit& u) const { return (size_t)u.pn * BM; }
};
}


#define XB_TMO      128
#define XB_XCNT(j)  (256  + 64 * (j))
#define XB_XSUB(j)  (1280 + 64 * (j))
#define XB_XGEN(j)  (2304 + 64 * (j))
#define XB_TOP      3328
#define XB_TOPGEN   3392
#define XCD_BAR_WORDS 3456
#define XB_SPIN_CAP (1u << 18)
DI unsigned xb_ld(unsigned* p)              { return __hip_atomic_load(p, __ATOMIC_RELAXED, __HIP_MEMORY_SCOPE_AGENT); }
DI unsigned xb_add(unsigned* p, unsigned v) { return __hip_atomic_fetch_add(p, v, __ATOMIC_RELAXED, __HIP_MEMORY_SCOPE_AGENT); }
DI unsigned xb_xcc_id() { return (unsigned)__builtin_amdgcn_s_getreg((3 << 11) | 20) & 0xFu; }
#define XB_SPIN(cond, bar) do { unsigned _sp = 0; while (cond) { __builtin_amdgcn_s_sleep(1); \
    if ((++_sp & 255u) == 0u) { if (xb_ld(&(bar)[XB_TMO])) break; if (_sp > XB_SPIN_CAP) { atomicAdd(&(bar)[XB_TMO], 1u); break; } } } } while (0)
struct XcdBarrier { unsigned* bar; unsigned x; volatile LAS unsigned* st; };
DI XcdBarrier xcd_barrier_post(unsigned* bar, volatile LAS unsigned* st) {
    XcdBarrier b; b.bar = bar; b.x = xb_xcc_id(); b.st = st;
    if (threadIdx.x == 0) (void)xb_add(&bar[XB_XCNT(b.x)], 1u);
    return b;
}
DI void xcd_barrier_complete(unsigned* bar, unsigned x, unsigned& nloc, unsigned& nx) {
    const unsigned G = gridDim.x * gridDim.y * gridDim.z;
    unsigned sum, cnt, mine, sp = 0u;
    for (;;) {
        sum = 0u; cnt = 0u; mine = 0u;
#pragma unroll
        for (unsigned j = 0; j < 16; ++j) { const unsigned c = xb_ld(&bar[XB_XCNT(j)]); sum += c; cnt += (c > 0u) ? 1u : 0u; mine = (j == x) ? c : mine; }
        if (sum == G) break;
        __builtin_amdgcn_s_sleep(1);
        if ((++sp & 255u) == 0u) { if (xb_ld(&bar[XB_TMO])) break; if (sp > XB_SPIN_CAP) { atomicAdd(&bar[XB_TMO], 1u); break; } }
    }
    nloc = mine > 0u ? mine : 1u; nx = cnt > 0u ? cnt : 1u;
}
DI void xcd_barrier(const XcdBarrier& b) {
    asm volatile("s_waitcnt vmcnt(0)" ::: "memory");
    __syncthreads();
    if (threadIdx.x == 0) {
        unsigned* bar = b.bar;
        __builtin_amdgcn_s_waitcnt(0);
        unsigned nloc = b.st[0], nx = b.st[1];
        if (nloc == 0u) { xcd_barrier_complete(bar, b.x, nloc, nx); b.st[0] = nloc; b.st[1] = nx; }
        const unsigned old = xb_add(&bar[XB_XSUB(b.x)], 1u);
        const unsigned gen = old / nloc;
        if (old + 1u == (gen + 1u) * nloc) {
            __builtin_amdgcn_fence(__ATOMIC_RELEASE, "agent");
            asm volatile("s_waitcnt vmcnt(0)" ::: "memory");
            const unsigned og = xb_add(&bar[XB_TOP], 1u);
            const unsigned tg = og / nx;
            if (og + 1u == (tg + 1u) * nx) xb_add(&bar[XB_TOPGEN], 1u);
            else XB_SPIN(xb_ld(&bar[XB_TOPGEN]) == tg, bar);
            __builtin_amdgcn_fence(__ATOMIC_ACQUIRE, "agent");
            xb_add(&bar[XB_XGEN(b.x)], 1u);
            asm volatile("s_waitcnt vmcnt(0)" ::: "memory");
        } else {
            XB_SPIN(xb_ld(&bar[XB_XGEN(b.x)]) == gen, bar);
            __builtin_amdgcn_fence(__ATOMIC_ACQUIRE, "agent");
            asm volatile("s_waitcnt vmcnt(0)" ::: "memory");
        }
    }
    __syncthreads();
}

struct Params {
    const float* in[22];
    float* out;
    unsigned char* ws;
};

DI const float* kin(int i) {
    const __attribute__((address_space(4))) char* ka = (const __attribute__((address_space(4))) char*)__builtin_amdgcn_kernarg_segment_ptr();
    asm volatile("" : "+s"(ka));
    return *(const float* const __attribute__((address_space(4)))*)(ka + 8 * i);
}
struct Ctx;
DI void relaunder(Ctx& F);
struct Ctx {
    LAS unsigned char* lds;
    int tid, lane, wave, G, bid;
    float* out; unsigned char* ws;
};

DI void relaunder(Ctx& F) { int t = threadIdx.x; asm volatile("" : "+v"(t)); F.tid = t; F.lane = t & 63; F.wave = __builtin_amdgcn_readfirstlane(t >> 6); }

constexpr int TR_SCR = 64 * 65 * 4;
DI void transpose_item(const float* W, int ldw, int k0, int c0, int ncols, bf16_t* WT, int K, LAS float* scr, int lane, const float* kscale = nullptr) {
    const int r4 = lane >> 4, c4 = (lane & 15) * 4;
    f32x4 v[16];
#pragma unroll
    for (int i = 0; i < 16; ++i) { v[i] = (c4 < ncols) ? *(const f32x4*)(W + (size_t)(k0 + 4 * i + r4) * ldw + c0 + c4) : (f32x4){0.f, 0.f, 0.f, 0.f};
        if (kscale) v[i] = v[i] * kscale[4 * i + r4]; }
#pragma unroll
    for (int i = 0; i < 16; ++i) { LAS float* d = scr + (4 * i + r4) * 65 + c4; d[0] = v[i].x; d[1] = v[i].y; d[2] = v[i].z; d[3] = v[i].w; }
    lds_wait();
    const int c = lane & 7;
#pragma unroll
    for (int j = 0; j < 8; ++j) { const int n = (lane >> 3) + 8 * j; const LAS float* s = scr + (8 * c) * 65 + n;
        u32x4 o; o.x = cvt_pk_bf16(s[0 * 65], s[1 * 65]); o.y = cvt_pk_bf16(s[2 * 65], s[3 * 65]); o.z = cvt_pk_bf16(s[4 * 65], s[5 * 65]); o.w = cvt_pk_bf16(s[6 * 65], s[7 * 65]);
        if (n < ncols) *(u32x4*)(WT + (size_t)n * K + k0 + 8 * c) = o; }
    lds_wait();
}

DI void transpose_item_f8(const float* W, int ldw, int k0, int c0, unsigned char* WT, int KBy, LAS float* scr, int lane) {
    const int r4 = lane >> 4, c4 = (lane & 15) * 4;
    f32x4 v[16];
#pragma unroll
    for (int i = 0; i < 16; ++i) v[i] = *(const f32x4*)(W + (size_t)(k0 + 4 * i + r4) * ldw + c0 + c4);
#pragma unroll
    for (int i = 0; i < 16; ++i) { LAS float* d = scr + (4 * i + r4) * 65 + c4; d[0] = v[i].x; d[1] = v[i].y; d[2] = v[i].z; d[3] = v[i].w; }
    lds_wait();
    const int c = lane & 3;
#pragma unroll
    for (int j = 0; j < 4; ++j) { const int n = (lane >> 2) + 16 * j; const LAS float* s = scr + (16 * c) * 65 + n;
        u32x4 o;
        o.x = pk_fp8x4(s[0 * 65] * 32.f, s[1 * 65] * 32.f, s[2 * 65] * 32.f, s[3 * 65] * 32.f); o.y = pk_fp8x4(s[4 * 65] * 32.f, s[5 * 65] * 32.f, s[6 * 65] * 32.f, s[7 * 65] * 32.f);
        o.z = pk_fp8x4(s[8 * 65] * 32.f, s[9 * 65] * 32.f, s[10 * 65] * 32.f, s[11 * 65] * 32.f); o.w = pk_fp8x4(s[12 * 65] * 32.f, s[13 * 65] * 32.f, s[14 * 65] * 32.f, s[15 * 65] * 32.f);
        *(u32x4*)(WT + (size_t)n * KBy + k0 + 16 * c) = o; }
    lds_wait();
}

DI void ttab_item(const float* wf, float* TTAB, int item, const LAS float* trg  , int lane) {
    const int ib = item & 7, gc = item >> 3, g = gc & 7, cs = gc >> 3;
    const float* wfg = wf + (size_t)g * 4096;
    float wv[64];
#pragma unroll
    for (int m = 0; m < 64; ++m) wv[m] = wfg[m * 64 + lane];
#pragma unroll 1
    for (int ii = 0; ii < 8; ++ii) { const int i = ib * 8 + ii; float t = 0.f;
#pragma unroll
        for (int m = 0; m < 64; ++m) t += trg[2 * ((m * i) & 63) + cs] * wv[m];
        TTAB[((size_t)gc * 64 + i) * 64 + lane] = t; }
}
DI void fold_item(const float* w_in, const float* TTAB, bf16_t* Win_t, int item, LAS float* scr  , int lane) {
    const int kb = item & 15, gc = item >> 4, g = gc & 7, cs = gc >> 3;
    { const f32x4* tp = (const f32x4*)(TTAB + (size_t)gc * 4096) + lane;
#pragma unroll
      for (int i = 0; i < 16; ++i) *(LAS f32x4*)(scr + 4 * (lane + 64 * i)) = tp[64 * i]; }
    lds_wait();
    bf16_t* dst = Win_t + (size_t)(cs * 512 + g * 64 + lane) * DM + kb * 64;
#pragma unroll 1
    for (int k8 = 0; k8 < 8; ++k8) {
        float a[8], wv[8];
#pragma unroll
        for (int q = 0; q < 8; ++q) { a[q] = 0.f; wv[q] = w_in[(size_t)(kb * 64 + k8 * 8 + q) * DIN + g * 64 + lane]; }
#pragma unroll
        for (int i = 0; i < 64; ++i) { const float t = scr[i * 64 + lane];
#pragma unroll
            for (int q = 0; q < 8; ++q) a[q] += __builtin_bit_cast(float, __builtin_amdgcn_readlane(__builtin_bit_cast(int, wv[q]), i)) * t; }
        u32x4 o; o.x = cvt_pk_bf16(a[0], a[1]); o.y = cvt_pk_bf16(a[2], a[3]); o.z = cvt_pk_bf16(a[4], a[5]); o.w = cvt_pk_bf16(a[6], a[7]);
        *(u32x4*)(dst + k8 * 8) = o;
    }
    lds_wait();
}

DI void phase0(Ctx& F) {
    relaunder(F);
    const float* c = kin(1); const float* c_ctx = kin(3); const float* w_ada = kin(4); const float* b_ada = kin(5);
    float* MOD = (float*)(F.ws + WS_MOD);
    if (F.bid < 96) {
        LAS float* SC = (LAS float*)F.lds;
        LAS float* RED = (LAS float*)(F.lds + 9 * 1024 * 4);
        for (int i = F.tid; i < 9 * 1024; i += 512) { const float v = (i < 8192) ? c[i] : c_ctx[i - 8192]; SC[i] = silu_f(v); }
        __syncthreads();
        for (int u = F.bid; u < 96; u += F.G) {
            const int n = u * 64 + F.lane;
            float a[9];
#pragma unroll
            for (int b = 0; b < 9; ++b) a[b] = 0.f;
            const float* wp = w_ada + (size_t)(F.wave * 128) * 6144 + n;
#pragma unroll 4
            for (int k = 0; k < 128; ++k) { const float w = wp[(size_t)k * 6144];
#pragma unroll
                for (int b = 0; b < 9; ++b) a[b] += SC[b * 1024 + F.wave * 128 + k] * w; }
#pragma unroll
            for (int b = 0; b < 9; ++b) RED[(F.wave * 9 + b) * 64 + F.lane] = a[b];
            __syncthreads();
            for (int i = F.tid; i < 9 * 64; i += 512) { float s = 0.f;
#pragma unroll
                for (int w = 0; w < 8; ++w) s += RED[w * 576 + i];
                const int b = i >> 6, nn = u * 64 + (i & 63); MOD[b * 6144 + nn] = s + b_ada[nn]; }
            __syncthreads();
        }
    }
    __syncthreads();
    LAS float* scr = (LAS float*)(F.lds + F.wave * TR_SCR);
    LAS float* trg = (LAS float*)(F.lds + 8 * TR_SCR);
    if (F.tid < 64) { float s, c; sincospif((float)F.tid * (1.f / 32.f), &s, &c); trg[2 * F.tid] = c; trg[2 * F.tid + 1] = s; }
    __syncthreads();
    const int gw = F.bid * 8 + F.wave, NGW = F.G * 8;
    const float* w_in = kin(7); const float* w_out = kin(15); const float* wf = kin(14);
    bf16_t* Win_t = (bf16_t*)(F.ws + WS_WIN); bf16_t* Wout_t = (bf16_t*)(F.ws + WS_WOUT);
    float* TTAB = (float*)(F.ws + WS_SS);
    constexpr int I_IN = 16 * 73, I_OUT = 32 * 16, I_FOLD = 128, I_ZERO = 208;
    for (int it = gw; it < I_IN + I_OUT + I_FOLD + I_ZERO; it += NGW) {
        int r = it;
        if (r < I_FOLD) { ttab_item(wf, TTAB, r, trg, F.lane); continue; } r -= I_FOLD;
        if (r < I_IN) { const int kb = r / 73, nb = r % 73; const int ncols = (nb == 72) ? 48 : 64;
            transpose_item(w_in, DIN, kb * 64, nb * 64, ncols, Win_t + (size_t)(nb * 64) * DM, DM, scr, F.lane); continue; } r -= I_IN;
        if (r < I_OUT) { const int kb = r / 16, nb = r % 16; transpose_item(w_out, DM, kb * 64, nb * 64, 64, Wout_t + (size_t)(nb * 64) * DMIX, DMIX, scr, F.lane, kb >= 8 ? kin(13) + (kb * 64 - 512) : nullptr); continue; }
        { u32x4 z = {0u, 0u, 0u, 0u}; u32x4* p = (u32x4*)(Win_t + (size_t)(4656 + r) * DM); p[F.lane] = z; p[F.lane + 64] = z; }
    }
}

DI void phase_h(Ctx& F) {
    relaunder(F);
    const float* x = kin(0); const float* ctx = kin(2); const float* nw = kin(6);
    const float* MOD = (const float*)(F.ws + WS_MOD);
    bf16_t* HALL = (bf16_t*)(F.ws + WS_R1);
    const int gw = F.bid * 8 + F.wave, NGW = F.G * 8;
    f32x4 nx[4];
    if (gw < NROWS) { const f32x4* xr = (const f32x4*)((gw < NTOK) ? x + (size_t)gw * DM : ctx + (size_t)(gw - NTOK) * DM) + F.lane;
#pragma unroll
        for (int j = 0; j < 4; ++j) nx[j] = xr[64 * j]; }
    for (int m = gw; m < NROWS; m += NGW) {
        const int b = (m < NTOK) ? (m >> 12) : 8;
        f32x4 v[4]; float s = 0.f;
#pragma unroll
        for (int j = 0; j < 4; ++j) v[j] = nx[j];
        { const int mn = m + NGW;
          if (mn < NROWS) { const f32x4* xr = (const f32x4*)((mn < NTOK) ? x + (size_t)mn * DM : ctx + (size_t)(mn - NTOK) * DM) + F.lane;
#pragma unroll
            for (int j = 0; j < 4; ++j) nx[j] = xr[64 * j]; } }
#pragma unroll
        for (int j = 0; j < 4; ++j) s += (v[j].x * v[j].x + v[j].y * v[j].y) + (v[j].z * v[j].z + v[j].w * v[j].w);
        const float rstd = rsqrtf(wave_sum(s) * (1.f / DM) + 1e-6f);
        const f32x4* w4 = (const f32x4*)nw + F.lane; const f32x4* sh4 = (const f32x4*)(MOD + b * 6144) + F.lane; const f32x4* sc4 = (const f32x4*)(MOD + b * 6144 + 1024) + F.lane;
        u32x2* o = (u32x2*)(HALL + (size_t)m * DM) + F.lane;
#pragma unroll
        for (int j = 0; j < 4; ++j) { const f32x4 w = w4[64 * j], sh = sh4[64 * j], sc = sc4[64 * j];
            const f32x4 h = (v[j] * rstd * w) * (sc + 1.f) + sh;
            u32x2 p; p.x = cvt_pk_bf16(h.x, h.y); p.y = cvt_pk_bf16(h.z, h.w); o[64 * j] = p; }
    }
}

struct EpiInProj {
    static constexpr bool PERM = true;
    bf16_t* FIN; bf16_t* ZS; bf16_t* XBC; float* DT; const float* dt_bias;
    DI void operator()(const f32x4 (&acc)[2][2][4][2], const pg8::Unit& u, int wr, int wc, int fr, int fq) const {
        const int row0 = u.pm * 256 + wr * 64 + fr, cl = wc * 32 + 8 * fq;
        if (u.pn < 18) {
            bf16_t* base; int ld, c0; bool act = false;
            if (u.pn < 2) { base = FIN; ld = 512; c0 = u.pn * 256; }
            else if (u.pn < 8) { base = ZS; ld = DSSM; c0 = (u.pn - 2) * 256; act = true; }
            else { base = XBC; ld = CONVD; c0 = (u.pn - 8) * 256; }
#pragma unroll
            for (int ai = 0; ai < 2; ++ai)
#pragma unroll
                for (int m = 0; m < 4; ++m) { bf16_t* rowp = base + (size_t)(row0 + ai * 128 + m * 16) * ld + c0 + cl;
#pragma unroll
                    for (int bj = 0; bj < 2; ++bj) { f32x4 v0 = acc[ai][bj][m][0], v1 = acc[ai][bj][m][1];
                        if (act) {
#pragma unroll
                            for (int j = 0; j < 4; ++j) { v0[j] = silu_f(v0[j]); v1[j] = silu_f(v1[j]); } }
                        u32x4 w; w.x = cvt_pk_bf16(v0[0], v0[1]); w.y = cvt_pk_bf16(v0[2], v0[3]); w.z = cvt_pk_bf16(v1[0], v1[1]); w.w = cvt_pk_bf16(v1[2], v1[3]);
                        *(u32x4*)(rowp + bj * 128) = w; } }
        } else if (cl < 48) {
            float bia[8];
#pragma unroll
            for (int q = 0; q < 8; ++q) bia[q] = dt_bias[cl + q];
#pragma unroll
            for (int ai = 0; ai < 2; ++ai)
#pragma unroll
                for (int m = 0; m < 4; ++m) { float* rowp = DT + (size_t)(row0 + ai * 128 + m * 16) * 48 + cl;
                    f32x4 o0, o1;
#pragma unroll
                    for (int j = 0; j < 4; ++j) { o0[j] = softplus_f(acc[ai][0][m][0][j] + bia[j]); o1[j] = softplus_f(acc[ai][0][m][1][j] + bia[4 + j]); }
                    *(f32x4*)rowp = o0; *(f32x4*)(rowp + 4) = o1; }
        }
    }
};

constexpr int FT_T = 0;
constexpr int FT_TAB = 73728;
constexpr int FT_TW = FT_TAB + 128 * 272;
constexpr int FT_TR = FT_TW + 512;
constexpr int F1_U = 0, F1_TT = 64 * 528, F1_TAB = F1_TT + 8 * 64 * 144, F1_TW = F1_TAB + 128 * 272, F1_TR = F1_TW + 512;
static_assert(F1_TR + 512 <= LDS_BYTES - 32, "FFT step 1 LDS layout");

DI bf16x8 tr_read2(unsigned a0, unsigned a1) {
    s16x4 lo, hi;
    asm volatile("ds_read_b64_tr_b16 %0, %2\n\tds_read_b64_tr_b16 %1, %3\n\ts_waitcnt lgkmcnt(0)" : "=&v"(lo), "=&v"(hi) : "v"(a0), "v"(a1) : "memory");
    return __builtin_shufflevector(lo, hi, 0, 1, 2, 3, 4, 5, 6, 7);
}
DI int crow(int reg, int h) { return (reg & 3) + 8 * (reg >> 2) + 4 * h; }

DI void fft_step1(Ctx& F) {
    relaunder(F);
    const bf16_t* FIN = (const bf16_t*)(F.ws + WS_R2); bf16_t* A1 = (bf16_t*)(F.ws + WS_R1); const float* TTAB = (const float*)(F.ws + WS_SS);
    LAS unsigned char* lds = F.lds;
    LAS float* TR = (LAS float*)(lds + F1_TR);
    const int chh = F.bid & 1;
    if (F.tid < 64) { float s, c; sincospif((float)F.tid * (1.f / 32.f), &s, &c); TR[2 * F.tid] = c; TR[2 * F.tid + 1] = s; }
    __syncthreads();
    for (int i = F.tid; i < 128 * 128; i += 512) { const int m = i >> 7, k = i & 127, ri = m >> 6, k1 = m & 63, cs = k >> 6, l1 = k & 63, t = (k1 * l1) & 63;
        const float c = TR[2 * t], s = TR[2 * t + 1]; const float v = (ri == 0) ? (cs == 0 ? c : -s) : (cs == 0 ? -s : -c);
        *(LAS bf16_t*)(lds + F1_TAB + m * 272 + k * 2) = f2bf(v); }
    for (int idx = F.tid; idx < 8 * 64 * 64; idx += 512) { const int j = idx & 63, i = (idx >> 6) & 63, gc = idx >> 12, gg = gc >> 1, cs = gc & 1;
        const float v = TTAB[((size_t)(cs * 8 + 4 * chh + gg) * 64 + i) * 64 + j];
        *(LAS bf16_t*)(lds + F1_TT + ((gg * 2 + cs) * 64 + j) * 144 + i * 2) = f2bf(v); }
    __syncthreads();
    const int lane = F.lane, w = F.wave, h = lane >> 5, c31 = lane & 31, gg = w >> 1, jb = w & 1;
    u32x4 pfv[4];
    if (F.bid < NB * 64 * 2) { const int u = F.bid, l2 = (u >> 1) & 63, b = u >> 7;
#pragma unroll
        for (int i = 0; i < 4; ++i) { const int idx = F.tid + 512 * i, row = idx >> 5, c16 = idx & 31;
            pfv[i] = *(const u32x4*)(FIN + (size_t)(b * SEQ + 64 * row + l2) * 512 + chh * 256 + c16 * 8); } }
    for (int u = F.bid; u < NB * 64 * 2; u += F.G) {
        const int l2 = (u >> 1) & 63, b = u >> 7;
        LAS float* TW = (LAS float*)(lds + F1_TW);
        if (F.tid < 64) { float s, c; sincospif((float)(F.tid * l2) * (1.f / 2048.f), &s, &c); TW[2 * F.tid] = c; TW[2 * F.tid + 1] = s; }
#pragma unroll
        for (int i = 0; i < 4; ++i) { const int idx = F.tid + 512 * i, row = idx >> 5, c16 = idx & 31; *(LAS u32x4*)(lds + F1_U + row * 528 + c16 * 16) = pfv[i]; }
        __syncthreads();
        { const int un = u + F.G;
          if (un < NB * 64 * 2) { const int l2n = (un >> 1) & 63, bn = un >> 7;
#pragma unroll
            for (int i = 0; i < 4; ++i) { const int idx = F.tid + 512 * i, row = idx >> 5, c16 = idx & 31;
                pfv[i] = *(const u32x4*)(FIN + (size_t)(bn * SEQ + 64 * row + l2n) * 512 + chh * 256 + c16 * 8); } } }
        f32x16 px[2][2];
#pragma unroll
        for (int rb = 0; rb < 2; ++rb)
#pragma unroll
            for (int cs = 0; cs < 2; ++cs) {
#pragma unroll
                for (int i = 0; i < 16; ++i) px[rb][cs][i] = 0.f;
#pragma unroll
                for (int ks = 0; ks < 4; ++ks) {
                    const bf16x8 af = *(const LAS bf16x8*)(lds + F1_U + (32 * rb + c31) * 528 + (gg * 64 + 16 * ks + 8 * h) * 2);
                    const bf16x8 bf = *(const LAS bf16x8*)(lds + F1_TT + ((gg * 2 + cs) * 64 + 32 * jb + c31) * 144 + (16 * ks + 8 * h) * 2);
                    px[rb][cs] = __builtin_amdgcn_mfma_f32_32x32x16_bf16(af, bf, px[rb][cs], 0, 0, 0);
                }
            }
        f32x16 acc[4];
#pragma unroll
        for (int rbo = 0; rbo < 4; ++rbo)
#pragma unroll
            for (int i = 0; i < 16; ++i) acc[rbo][i] = 0.f;
#pragma unroll
        for (int cs = 0; cs < 2; ++cs)
#pragma unroll
            for (int rb = 0; rb < 2; ++rb)
#pragma unroll
                for (int s2 = 0; s2 < 2; ++s2) {
                    u32x4 bw; bw.x = cvt_pk_bf16(px[rb][cs][8 * s2], px[rb][cs][8 * s2 + 1]); bw.y = cvt_pk_bf16(px[rb][cs][8 * s2 + 2], px[rb][cs][8 * s2 + 3]);
                    bw.z = cvt_pk_bf16(px[rb][cs][8 * s2 + 4], px[rb][cs][8 * s2 + 5]); bw.w = cvt_pk_bf16(px[rb][cs][8 * s2 + 6], px[rb][cs][8 * s2 + 7]);
                    const bf16x8 bfr = __builtin_bit_cast(bf16x8, bw);
                    const int kc = cs * 64 + 32 * rb + 16 * s2 + 4 * h;
#pragma unroll
                    for (int rbo = 0; rbo < 4; ++rbo) {
                        const LAS unsigned char* ap = lds + F1_TAB + (32 * rbo + c31) * 272 + kc * 2;
                        const u32x2 lo = *(const LAS u32x2*)ap, hi = *(const LAS u32x2*)(ap + 16);
                        const u32x4 aw = {lo.x, lo.y, hi.x, hi.y};
                        acc[rbo] = __builtin_amdgcn_mfma_f32_32x32x16_bf16(__builtin_bit_cast(bf16x8, aw), bfr, acc[rbo], 0, 0, 0);
                    }
                }
        const int ch = chh * 256 + 32 * w + c31;
#pragma unroll
        for (int rb = 0; rb < 2; ++rb)
#pragma unroll
            for (int r = 0; r < 16; ++r) { const int k1 = 32 * rb + crow(r, h); const float ct = TW[2 * k1], st = TW[2 * k1 + 1];
                const float ar = acc[rb][r], ai = acc[rb + 2][r];
                const float orr = (ar * ct + ai * st) * (1.f / 64.f), oi = (ai * ct - ar * st) * (1.f / 64.f);
                bf16_t* dst = A1 + ((size_t)((b * 64 + k1) * 2) * 64 + l2) * 512 + ch;
                dst[0] = f2bf(orr); dst[(size_t)64 * 512] = f2bf(oi); }
        __syncthreads();
    }
}

DI void fft_step2(Ctx& F) {
    relaunder(F);
    const bf16_t* A1 = (const bf16_t*)(F.ws + WS_R1); bf16_t* AO = (bf16_t*)(F.ws + WS_R4);
    LAS unsigned char* lds = F.lds;
    LAS float* TR = (LAS float*)(lds + FT_TR);
    if (F.tid < 64) { float s, c; sincospif((float)F.tid * (1.f / 32.f), &s, &c); TR[2 * F.tid] = c; TR[2 * F.tid + 1] = s; }
    __syncthreads();
    for (int i = F.tid; i < 64 * 128; i += 512) { const int k2 = i >> 7, k = i & 127, ri = k >> 6, l2 = k & 63, t = (k2 * l2) & 63;
        *(LAS bf16_t*)(lds + FT_TAB + k2 * 272 + k * 2) = f2bf(ri ? TR[2 * t + 1] : TR[2 * t]); }
    __syncthreads();
    const int lane = F.lane, w = F.wave, h = lane >> 5, blk = (lane >> 4) & 1, q = (lane & 15) >> 2, p = lane & 3;
    const unsigned tbase = (unsigned)(size_t)(lds + FT_T);
    for (int u = F.bid; u < NB * 64 * 2; u += F.G) {
        const int chh = u & 1, k1 = (u >> 1) & 63, b = u >> 7;
#pragma unroll
        for (int i = 0; i < 8; ++i) { const int idx = F.tid + 512 * i, row = idx >> 5, c16 = idx & 31;
            const u32x4 v = *(const u32x4*)(A1 + ((size_t)(b * 64 + k1) * 128 + row) * 512 + chh * 256 + c16 * 8);
            *(LAS u32x4*)(lds + FT_T + row * 576 + c16 * 16) = v; }
        __syncthreads();
        f32x16 acc[2];
#pragma unroll
        for (int rb = 0; rb < 2; ++rb)
#pragma unroll
            for (int i = 0; i < 16; ++i) acc[rb][i] = 0.f;
#pragma unroll
        for (int ks = 0; ks < 8; ++ks) {
            const unsigned a0 = tbase + (unsigned)((16 * ks + 8 * h + q) * 576 + (32 * w + 16 * blk + 4 * p) * 2);
            const bf16x8 bfrag = tr_read2(a0, a0 + 4 * 576);
#pragma unroll
            for (int rb = 0; rb < 2; ++rb) { const bf16x8 afrag = *(const LAS bf16x8*)(lds + FT_TAB + (32 * rb + (lane & 31)) * 272 + (16 * ks + 8 * h) * 2);
                acc[rb] = __builtin_amdgcn_mfma_f32_32x32x16_bf16(afrag, bfrag, acc[rb], 0, 0, 0); }
        }
        const int ch = chh * 256 + 32 * w + (lane & 31);
#pragma unroll
        for (int rb = 0; rb < 2; ++rb)
#pragma unroll
            for (int r = 0; r < 16; ++r) { const int k2 = 32 * rb + crow(r, h);
                AO[(size_t)(b * SEQ + k1 + 64 * k2) * DMIX + ch] = f2bf(acc[rb][r] * 0.125f); }
        __syncthreads();
    }
}

constexpr int CV_B = 0, CV_C = 128 * 272;
DI void unpack8(const u32x4 v, float (&f)[8]) {
    f[0] = __uint_as_float(v.x << 16); f[1] = __uint_as_float(v.x & 0xffff0000u); f[2] = __uint_as_float(v.y << 16); f[3] = __uint_as_float(v.y & 0xffff0000u);
    f[4] = __uint_as_float(v.z << 16); f[5] = __uint_as_float(v.z & 0xffff0000u); f[6] = __uint_as_float(v.w << 16); f[7] = __uint_as_float(v.w & 0xffff0000u);
}
DI void conv_cb_phase(Ctx& F) {
    relaunder(F);
    const bf16_t* XBC = (const bf16_t*)(F.ws + WS_R4);
    bf16_t* XS = (bf16_t*)(F.ws + WS_XS); bf16_t* BMg = (bf16_t*)(F.ws + WS_BM); bf16_t* CMg = (bf16_t*)(F.ws + WS_CM); bf16_t* CBG = (bf16_t*)(F.ws + WS_CB);
    const float* conv_w = kin(8); const float* conv_b = kin(9);
    LAS unsigned char* lds = F.lds;
    const int lane = F.lane, h = lane >> 5;
    for (int u = F.bid; u < NB * 34 * NG; u += F.G) {
        const int g = u & 3, c = (u >> 2) % 34, b = (u >> 2) / 34;
        const bool lat = c < 32;
        const int seqbase = lat ? b * SEQ : NTOK + b * CTXL, L = lat ? SEQ : CTXL, t0 = lat ? c * 128 : (c - 32) * 128;
#pragma unroll
        for (int pass = 0; pass < 2; ++pass) {
            constexpr int NT0 = 16, NT1 = 4;
            const int NT = pass == 0 ? NT0 : NT1;
            int chunk, seg;
            if (pass == 0) { chunk = F.tid & 63; seg = F.tid >> 6; } else { chunk = 64 + (F.tid & 15); seg = F.tid >> 4; }
            int scol, dcol, kind;
            if (chunk < 48) { kind = 0; scol = g * 384 + chunk * 8; dcol = scol; }
            else if (chunk < 64) { kind = 1; dcol = g * 128 + (chunk - 48) * 8; scol = 1536 + dcol; }
            else { kind = 2; dcol = g * 128 + (chunk - 64) * 8; scol = 2048 + dcol; }
            const int tb = t0 + seg * NT;
            u32x4 raw[NT0 + 4];
#pragma unroll
            for (int k = 0; k < NT0 + 4; ++k) if (k < NT + 4) { const int t = tb - 2 + k; u32x4 v = {0u, 0u, 0u, 0u};
                if (t >= 0 && t < L) v = *(const u32x4*)(XBC + (size_t)(seqbase + t) * CONVD + scol);
                raw[k] = v; }
            float w[5][8], bias[8];
#pragma unroll
            for (int k = 0; k < 5; ++k) { const f32x4 a = *(const f32x4*)(conv_w + k * CONVD + scol), bb = *(const f32x4*)(conv_w + k * CONVD + scol + 4);
                w[k][0] = a.x; w[k][1] = a.y; w[k][2] = a.z; w[k][3] = a.w; w[k][4] = bb.x; w[k][5] = bb.y; w[k][6] = bb.z; w[k][7] = bb.w; }
            { const f32x4 a = *(const f32x4*)(conv_b + scol), bb = *(const f32x4*)(conv_b + scol + 4);
              bias[0] = a.x; bias[1] = a.y; bias[2] = a.z; bias[3] = a.w; bias[4] = bb.x; bias[5] = bb.y; bias[6] = bb.z; bias[7] = bb.w; }
            float win[5][8];
#pragma unroll
            for (int k = 0; k < 4; ++k) unpack8(raw[k], win[k]);
#pragma unroll
            for (int j = 0; j < NT0; ++j) if (j < NT) {
                unpack8(raw[j + 4], win[4]);
                float o[8];
#pragma unroll
                for (int e = 0; e < 8; ++e) { float a = bias[e];
#pragma unroll
                    for (int k = 0; k < 5; ++k) a += w[k][e] * win[k][e];
                    o[e] = silu_f(a); }
                u32x4 pk; pk.x = cvt_pk_bf16(o[0], o[1]); pk.y = cvt_pk_bf16(o[2], o[3]); pk.z = cvt_pk_bf16(o[4], o[5]); pk.w = cvt_pk_bf16(o[6], o[7]);
                const size_t row = (size_t)(seqbase + tb + j); const int tl = seg * NT + j;
                (void)row;
                if (kind == 0) *(u32x4*)(XS + ((size_t)((b * 34 + c) * NH + g * 6 + (chunk >> 3)) * 128 + tl) * 64 + (chunk & 7) * 8) = pk;
                else if (kind == 1) { *(u32x4*)(BMg + ((size_t)((b * 34 + c) * NG + g) * 128 + tl) * 128 + (chunk - 48) * 8) = pk; *(LAS u32x4*)(lds + CV_B + tl * 272 + (chunk - 48) * 16) = pk; }
                else { *(u32x4*)(CMg + ((size_t)((b * 34 + c) * NG + g) * 128 + tl) * 128 + (chunk - 64) * 8) = pk; *(LAS u32x4*)(lds + CV_C + tl * 272 + (chunk - 64) * 16) = pk; }
#pragma unroll
                for (int k = 0; k < 4; ++k)
#pragma unroll
                    for (int e = 0; e < 8; ++e) win[k][e] = win[k + 1][e];
            }
        }
        if (F.wave < 6) {
            const int hd = 6 * g + F.wave; const float a_f = -__expf(kin(11)[hd]), a_b = -__expf(kin(11)[24 + hd]);
            const float* DT = (const float*)(F.ws + WS_R5); float* AR = (float*)(F.ws + WS_ARRS) + (size_t)((b * 34 + c) * NH + hd) * 768;
            const size_t r0 = (size_t)(seqbase + t0);
            {
                const float d0 = DT[(r0 + 2 * lane) * 48 + hd], d1 = DT[(r0 + 2 * lane + 1) * 48 + hd], v0 = d0 * a_f, v1 = d1 * a_f; float s = v0 + v1;
#pragma unroll
                for (int o = 1; o < 64; o <<= 1) { const float t = __shfl_up(s, o); if (lane >= o) s += t; }
                const float ex = s - (v0 + v1), A0 = ex + v0, A1 = ex + v0 + v1, tot = __shfl(s, 63);
                *(f32v2*)(AR + 2 * lane) = (f32v2){A0, A1}; *(f32v2*)(AR + 128 + 2 * lane) = (f32v2){__logf(d0) - A0, __logf(d1) - A1};
                *(f32v2*)(AR + 256 + 2 * lane) = (f32v2){d0 * __expf(tot - A0), d1 * __expf(tot - A1)};
            }
            {
                const int e0 = 127 - 2 * lane, e1 = 126 - 2 * lane;
                const float d0 = DT[(r0 + e0) * 48 + 24 + hd], d1 = DT[(r0 + e1) * 48 + 24 + hd], v0 = d0 * a_b, v1 = d1 * a_b; float s = v0 + v1;
#pragma unroll
                for (int o = 1; o < 64; o <<= 1) { const float t = __shfl_up(s, o); if (lane >= o) s += t; }
                const float ex = s - (v0 + v1), A0 = ex + v0, A1 = ex + v0 + v1, tot = __shfl(s, 63);
                *(f32v2*)(AR + 384 + e1) = (f32v2){A1, A0}; *(f32v2*)(AR + 512 + e1) = (f32v2){__logf(d1) - A1, __logf(d0) - A0};
                *(f32v2*)(AR + 640 + e1) = (f32v2){d1 * __expf(tot - A1), d0 * __expf(tot - A0)};
            }
        }
        __syncthreads();
        if (lat) {
#pragma unroll
            for (int bi = 0; bi < 2; ++bi) {
                const int blk = 2 * F.wave + bi, sb = blk >> 2, lb = blk & 3;
                f32x16 acc;
#pragma unroll
                for (int i = 0; i < 16; ++i) acc[i] = 0.f;
#pragma unroll
                for (int ks = 0; ks < 8; ++ks) {
                    const bf16x8 af = *(const LAS bf16x8*)(lds + CV_B + (32 * sb + (lane & 31)) * 272 + (16 * ks + 8 * h) * 2);
                    const bf16x8 bf = *(const LAS bf16x8*)(lds + CV_C + (32 * lb + (lane & 31)) * 272 + (16 * ks + 8 * h) * 2);
                    acc = __builtin_amdgcn_mfma_f32_32x32x16_bf16(af, bf, acc, 0, 0, 0);
                }
                u32x4 o0, o1;
                o0.x = cvt_pk_bf16(acc[0], acc[1]); o0.y = cvt_pk_bf16(acc[2], acc[3]); o0.z = cvt_pk_bf16(acc[4], acc[5]); o0.w = cvt_pk_bf16(acc[6], acc[7]);
                o1.x = cvt_pk_bf16(acc[8], acc[9]); o1.y = cvt_pk_bf16(acc[10], acc[11]); o1.z = cvt_pk_bf16(acc[12], acc[13]); o1.w = cvt_pk_bf16(acc[14], acc[15]);
                u32x4* dst = (u32x4*)(CBG + ((size_t)(((b * 32 + c) * 4 + g) * 16 + blk) * 64 + lane) * 16);
                dst[0] = o0; dst[1] = o1;
            }
        }
        __syncthreads();
    }
}

constexpr int SD_C = 0;
constexpr int SD_B = SD_C + 128 * 272;
constexpr int SD_X = SD_B + 128 * 288;
constexpr int SD_XW = SD_X + 128 * 192;
constexpr int SD_H = SD_XW + 128 * 192;
constexpr int SD_ARR = SD_H + 64 * 272;
constexpr int SD_Y = SD_ARR + 8 * 512;
static_assert(SD_Y + 128 * 144 <= LDS_BYTES - 16, "SSD LDS layout");
DI float bflo(unsigned w) { return __uint_as_float(w << 16); }
DI float bfhi(unsigned w) { return __uint_as_float(w & 0xffff0000u); }
DI void tr_read4(unsigned a0, unsigned a1, unsigned b0, unsigned b1, bf16x8& fa, bf16x8& fb) {
    s16x4 alo, ahi, blo, bhi;
    asm volatile("ds_read_b64_tr_b16 %0, %4\n\tds_read_b64_tr_b16 %1, %5\n\tds_read_b64_tr_b16 %2, %6\n\tds_read_b64_tr_b16 %3, %7\n\ts_waitcnt lgkmcnt(0)"
                 : "=&v"(alo), "=&v"(ahi), "=&v"(blo), "=&v"(bhi) : "v"(a0), "v"(a1), "v"(b0), "v"(b1) : "memory");
    fa = __builtin_shufflevector(alo, ahi, 0, 1, 2, 3, 4, 5, 6, 7); fb = __builtin_shufflevector(blo, bhi, 0, 1, 2, 3, 4, 5, 6, 7);
}
DI void tr_read_state4(unsigned b0, unsigned b1, s16x4 (&o)[16]) {
    asm volatile("ds_read_b64_tr_b16 %0, %16 offset:0\n\tds_read_b64_tr_b16 %1, %16 offset:768\n\tds_read_b64_tr_b16 %2, %17 offset:0\n\tds_read_b64_tr_b16 %3, %17 offset:1152\n\tds_read_b64_tr_b16 %4, %16 offset:3072\n\tds_read_b64_tr_b16 %5, %16 offset:3840\n\tds_read_b64_tr_b16 %6, %17 offset:4608\n\tds_read_b64_tr_b16 %7, %17 offset:5760\n\tds_read_b64_tr_b16 %8, %16 offset:6144\n\tds_read_b64_tr_b16 %9, %16 offset:6912\n\tds_read_b64_tr_b16 %10, %17 offset:9216\n\tds_read_b64_tr_b16 %11, %17 offset:10368\n\tds_read_b64_tr_b16 %12, %16 offset:9216\n\tds_read_b64_tr_b16 %13, %16 offset:9984\n\tds_read_b64_tr_b16 %14, %17 offset:13824\n\tds_read_b64_tr_b16 %15, %17 offset:14976\n\ts_waitcnt lgkmcnt(0)"
                 : "=&v"(o[0]), "=&v"(o[1]), "=&v"(o[2]), "=&v"(o[3]), "=&v"(o[4]), "=&v"(o[5]), "=&v"(o[6]), "=&v"(o[7]), "=&v"(o[8]), "=&v"(o[9]), "=&v"(o[10]), "=&v"(o[11]), "=&v"(o[12]), "=&v"(o[13]), "=&v"(o[14]), "=&v"(o[15]) : "v"(b0), "v"(b1) : "memory");
}
DI void tr_read_diag16(unsigned b0, unsigned b1, unsigned b2, unsigned b3, s16x4 (&o)[16]) {
    asm volatile("ds_read_b64_tr_b16 %0, %16 offset:0\n\tds_read_b64_tr_b16 %1, %16 offset:1536\n\tds_read_b64_tr_b16 %2, %16 offset:3072\n\tds_read_b64_tr_b16 %3, %16 offset:4608\n\tds_read_b64_tr_b16 %4, %17 offset:0\n\tds_read_b64_tr_b16 %5, %17 offset:1536\n\tds_read_b64_tr_b16 %6, %17 offset:3072\n\tds_read_b64_tr_b16 %7, %17 offset:4608\n\tds_read_b64_tr_b16 %8, %18 offset:0\n\tds_read_b64_tr_b16 %9, %18 offset:1536\n\tds_read_b64_tr_b16 %10, %18 offset:3072\n\tds_read_b64_tr_b16 %11, %18 offset:4608\n\tds_read_b64_tr_b16 %12, %19 offset:0\n\tds_read_b64_tr_b16 %13, %19 offset:1536\n\tds_read_b64_tr_b16 %14, %19 offset:3072\n\tds_read_b64_tr_b16 %15, %19 offset:4608\n\ts_waitcnt lgkmcnt(0)"
                 : "=&v"(o[0]), "=&v"(o[1]), "=&v"(o[2]), "=&v"(o[3]), "=&v"(o[4]), "=&v"(o[5]), "=&v"(o[6]), "=&v"(o[7]), "=&v"(o[8]), "=&v"(o[9]), "=&v"(o[10]), "=&v"(o[11]), "=&v"(o[12]), "=&v"(o[13]), "=&v"(o[14]), "=&v"(o[15]) : "v"(b0), "v"(b1), "v"(b2), "v"(b3) : "memory");
}
DI void tr_read_diag8(unsigned b0, unsigned b1, s16x4 (&o)[8]) {
    asm volatile("ds_read_b64_tr_b16 %0, %8 offset:0\n\tds_read_b64_tr_b16 %1, %8 offset:1536\n\tds_read_b64_tr_b16 %2, %8 offset:3072\n\tds_read_b64_tr_b16 %3, %8 offset:4608\n\tds_read_b64_tr_b16 %4, %9 offset:0\n\tds_read_b64_tr_b16 %5, %9 offset:1536\n\tds_read_b64_tr_b16 %6, %9 offset:3072\n\tds_read_b64_tr_b16 %7, %9 offset:4608\n\ts_waitcnt lgkmcnt(0)"
                 : "=&v"(o[0]), "=&v"(o[1]), "=&v"(o[2]), "=&v"(o[3]), "=&v"(o[4]), "=&v"(o[5]), "=&v"(o[6]), "=&v"(o[7]) : "v"(b0), "v"(b1) : "memory");
}
struct SsdPF { u32x4 c[4], b[4], x[2], yz[4]; float w[2]; f32v2 arr; };

DI void ssd_unit(Ctx& F, const int b, const int hd) {
    relaunder(F);
    const bf16_t* XS = (const bf16_t*)(F.ws + WS_XS); const bf16_t* BMg = (const bf16_t*)(F.ws + WS_BM); const bf16_t* CMg = (const bf16_t*)(F.ws + WS_CM);
    const bf16_t* CBG = (const bf16_t*)(F.ws + WS_CB); const float* ARRS = (const float*)(F.ws + WS_ARRS);
    bf16_t* AO = (bf16_t*)(F.ws + WS_R4); const bf16_t* ZS = (const bf16_t*)F.out; float* SS = (float*)(F.ws + WS_SS);
    LAS unsigned char* lds = F.lds;
    LAS float* ARR = (LAS float*)(lds + SD_ARR);
    LAS float *AF = ARR, *LF = ARR + 128, *ABS = ARR + 384, *LB = ARR + 512, *SSP = ARR + 768;
    const int g = hd / 6, tid = F.tid, lane = F.lane, wave = F.wave;
    const int pb = wave >> 2, lb = wave & 3, h = lane >> 5, blk = (lane >> 4) & 1, q = (lane & 15) >> 2, pp = lane & 3, c31 = lane & 31;
    const float dsk = kin(12)[hd];
    const unsigned xbase = (unsigned)(size_t)(lds + SD_X), xwbase = (unsigned)(size_t)(lds + SD_XW), bbase = (unsigned)(size_t)(lds + SD_B);
    const int l = 32 * lb + c31;
#define SSD_CHUNK(dir_, step_) ((dir_) == 0 ? ((step_) >= 2 ? (step_) - 2 : 32 + (step_)) : 33 - (step_))
#define SSD_ROW0(c_) (((c_) < 32) ? b * SEQ + (c_) * 128 : NTOK + b * CTXL + ((c_) - 32) * 128)
#define SSD_ISSUE(pf, dir_, step_) do { const int c_ = SSD_CHUNK(dir_, step_), row0_ = SSD_ROW0(c_); const bool lat_ = (step_) >= 2; \
        const float* ar_ = ARRS + (size_t)((b * 34 + c_) * NH + hd) * 768; \
        _Pragma("unroll") for (int i = 0; i < 4; ++i) { const int idx = tid + 512 * i, r = idx >> 4, c16 = idx & 15; \
            if (lat_) pf.c[i] = *(const u32x4*)(CMg + (size_t)((b * 34 + c_) * NG + g) * 16384 + (size_t)idx * 8); \
            pf.b[i] = *(const u32x4*)(BMg + (size_t)((b * 34 + c_) * NG + g) * 16384 + (size_t)idx * 8); (void)r; (void)c16; } \
        _Pragma("unroll") for (int i = 0; i < 2; ++i) { const int idx = tid + 512 * i, r = idx >> 3, c16 = idx & 7; \
            pf.x[i] = *(const u32x4*)(XS + (size_t)((b * 34 + c_) * NH + hd) * 8192 + (size_t)idx * 8); pf.w[i] = ar_[((dir_) ? 640 : 256) + r]; \
            if (lat_ && (dir_) == 1) { pf.yz[i] = *(const u32x4*)(AO + (size_t)(row0_ + r) * DMIX + 512 + hd * 64 + c16 * 8); pf.yz[2 + i] = *(const u32x4*)(ZS + (size_t)(row0_ + r) * DSSM + hd * 64 + c16 * 8); } } \
        if (tid < 384) pf.arr = *(const f32v2*)(ar_ + 2 * tid); \
    } while (0)
#define SSD_ISSUE2(cbr, step_) do { const int c_ = SSD_CHUNK(0, step_); \
        const u32x4* cbp = (const u32x4*)(CBG + ((size_t)(((b * 32 + c_) * 4 + g) * 16 + lb) * 64 + lane) * 16); \
        _Pragma("unroll") for (int d = 0; d < 4; ++d) { const int sb = (lb + d) & 3; cbr[2 * d] = cbp[(size_t)sb * 512]; cbr[2 * d + 1] = cbp[(size_t)sb * 512 + 1]; } \
    } while (0)

#pragma unroll 1
    for (int dir = 0; dir < 2; ++dir) {
        f32x16 Hacc;
#pragma unroll
        for (int i = 0; i < 16; ++i) Hacc[i] = 0.f;
        SsdPF pf;
        u32x4 cbr[8];
#pragma unroll
        for (int i = 0; i < 8; ++i) cbr[i] = (u32x4){0u, 0u, 0u, 0u};
        u32x4 ytmp[2] = {(u32x4){0u, 0u, 0u, 0u}, (u32x4){0u, 0u, 0u, 0u}}; float sstmp = 0.f; int prow0 = 0; bool pylat = false;
        SSD_ISSUE(pf, dir, 0);
#pragma unroll 1
        for (int step = 0; step < 34; ++step) {
            const bool lat = step >= 2;
            const int c = SSD_CHUNK(dir, step), row0 = SSD_ROW0(c);
            if (lat) {
#pragma unroll
                for (int i = 0; i < 4; ++i) { const int idx = tid + 512 * i, r = idx >> 4, c16 = idx & 15; *(LAS u32x4*)(lds + SD_C + r * 272 + c16 * 16) = pf.c[i]; }
            }
#pragma unroll
            for (int i = 0; i < 4; ++i) { const int idx = tid + 512 * i, r = idx >> 4, c16 = idx & 15; *(LAS u32x4*)(lds + SD_B + r * 288 + c16 * 16) = pf.b[i]; }
#pragma unroll
            for (int i = 0; i < 2; ++i) { const int idx = tid + 512 * i, r = idx >> 3, c16 = idx & 7;
                if (dir == 0) *(LAS u32x4*)(lds + SD_X + r * 192 + c16 * 16) = pf.x[i];
                else if (lat) { *(LAS u32x4*)(lds + SD_X + r * 144 + c16 * 16) = pf.yz[i]; *(LAS u32x4*)(lds + SD_Y + r * 144 + c16 * 16) = pf.yz[2 + i]; }
                float f[8]; unpack8(pf.x[i], f); const float wv = pf.w[i];
                u32x4 o; o.x = cvt_pk_bf16(f[0] * wv, f[1] * wv); o.y = cvt_pk_bf16(f[2] * wv, f[3] * wv); o.z = cvt_pk_bf16(f[4] * wv, f[5] * wv); o.w = cvt_pk_bf16(f[6] * wv, f[7] * wv);
                *(LAS u32x4*)(lds + SD_XW + r * 192 + c16 * 16) = o; }
            if (tid < 384) *(LAS f32v2*)(ARR + 2 * tid) = pf.arr;
#pragma unroll
            for (int r = 0; r < 16; ++r) *(LAS bf16_t*)(lds + SD_H + (32 * pb + crow(r, h)) * 272 + (32 * lb + c31) * 2) = f2bf(Hacc[r]);
            if (pylat) {
#pragma unroll
                for (int i = 0; i < 2; ++i) { const int idx = tid + 512 * i, r = idx >> 3, c16 = idx & 7;
                    *(u32x4*)(AO + (size_t)(prow0 + r) * DMIX + 512 + hd * 64 + c16 * 8) = ytmp[i]; }
                if (dir == 1 && tid < 128) SS[(size_t)(prow0 + tid) * NH + hd] = sstmp;
            }
            lds_barrier();
            if (step + 1 < 34) SSD_ISSUE(pf, dir, step + 1);
            if (lat) {
                f32x16 y;
#pragma unroll
                for (int i = 0; i < 16; ++i) y[i] = 0.f;
                {
#pragma unroll
                    for (int half = 0; half < 2; ++half) {
                        bf16x8 afv[4], bfv[4];
#pragma unroll
                        for (int k4 = 0; k4 < 4; ++k4) { const int ks = 4 * half + k4; afv[k4] = *(const LAS bf16x8*)(lds + SD_H + (32 * pb + c31) * 272 + (16 * ks + 8 * h) * 2);
                            bfv[k4] = *(const LAS bf16x8*)(lds + SD_C + l * 272 + (16 * ks + 8 * h) * 2); }
                        asm volatile("s_waitcnt lgkmcnt(0)" ::: "memory");
#pragma unroll
                        for (int k4 = 0; k4 < 4; ++k4) y = __builtin_amdgcn_mfma_f32_32x32x16_bf16(afv[k4], bfv[k4], y, 0, 0, 0);
                    }
                }
                const float AFl = AF[l], ABSl = ABS[l];
                const float sc = __expf(dir ? ABSl : AFl);
#pragma unroll
                for (int i = 0; i < 16; ++i) y[i] *= sc;
                if (dir == 0) {
                    int c31v = c31, hv = h; asm volatile("" : "+v"(c31v), "+v"(hv));
                    s16x4 xf[8];
                    const unsigned xcol = xbase + (unsigned)((4 * hv + q) * 192 + (32 * pb + 16 * blk + 4 * pp) * 2);
#pragma unroll
                    for (int d = 0; d < 4; ++d) {
                        const int sb = (lb + d) & 3;
                        if ((d & 1) == 0) tr_read_diag8(xcol + (unsigned)(sb * 32 * 192), xcol + (unsigned)(((sb + 1) & 3) * 32 * 192), xf);
                        const unsigned cw[8] = {cbr[2 * d].x, cbr[2 * d].y, cbr[2 * d].z, cbr[2 * d].w, cbr[2 * d + 1].x, cbr[2 * d + 1].y, cbr[2 * d + 1].z, cbr[2 * d + 1].w};
                        float mt[16];
                        if (d == 0) {
#pragma unroll
                            for (int r = 0; r < 16; ++r) {
                                const int sl = crow(r, hv), s = 32 * sb + sl;
                                const float cb = (r & 1) ? bfhi(cw[r >> 1]) : bflo(cw[r >> 1]);
                                const float ef = __expf(AFl + LF[s]), eb = __expf(ABSl + LB[s]);
                                const float wgt = (sl <= c31v ? ef : 0.f) + (sl >= c31v ? eb : 0.f);
                                mt[r] = cb * wgt + (sl == c31v ? dsk : 0.f);
                            }
                        } else {
                            const bool fw = sb < lb; const LAS float* Lp = (fw ? LF : LB) + 32 * sb; const float Al = fw ? AFl : ABSl;
#pragma unroll
                            for (int r = 0; r < 16; ++r) {
                                const float cb = (r & 1) ? bfhi(cw[r >> 1]) : bflo(cw[r >> 1]);
                                mt[r] = cb * __expf(Al + Lp[crow(r, hv)]);
                            }
                        }
#pragma unroll
                        for (int s2 = 0; s2 < 2; ++s2) {
                            u32x4 bw; bw.x = cvt_pk_bf16(mt[8 * s2], mt[8 * s2 + 1]); bw.y = cvt_pk_bf16(mt[8 * s2 + 2], mt[8 * s2 + 3]);
                            bw.z = cvt_pk_bf16(mt[8 * s2 + 4], mt[8 * s2 + 5]); bw.w = cvt_pk_bf16(mt[8 * s2 + 6], mt[8 * s2 + 7]);
                            const bf16x8 bfr = __builtin_bit_cast(bf16x8, bw);
                            const bf16x8 afr = __builtin_shufflevector(xf[4 * (d & 1) + 2 * s2], xf[4 * (d & 1) + 2 * s2 + 1], 0, 1, 2, 3, 4, 5, 6, 7);
                            y = __builtin_amdgcn_mfma_f32_32x32x16_bf16(afr, bfr, y, 0, 0, 0);
                        }
                        asm volatile("" ::: "memory");
                    }
#pragma unroll
                    for (int g4 = 0; g4 < 4; ++g4) { u32x2 o; o.x = cvt_pk_bf16(y[4 * g4], y[4 * g4 + 1]); o.y = cvt_pk_bf16(y[4 * g4 + 2], y[4 * g4 + 3]); *(LAS u32x2*)(lds + SD_Y + l * 144 + (32 * pb + 8 * g4 + 4 * h) * 2) = o; }
                } else {
                    float ssq = 0.f;
#pragma unroll
                    for (int g4 = 0; g4 < 4; ++g4) {
                        const u32x2 yf = *(const LAS u32x2*)(lds + SD_X + l * 144 + (32 * pb + 8 * g4 + 4 * h) * 2), zz = *(const LAS u32x2*)(lds + SD_Y + l * 144 + (32 * pb + 8 * g4 + 4 * h) * 2);
                        const float o0 = (y[4 * g4] + bflo(yf.x)) * bflo(zz.x), o1 = (y[4 * g4 + 1] + bfhi(yf.x)) * bfhi(zz.x);
                        const float o2 = (y[4 * g4 + 2] + bflo(yf.y)) * bflo(zz.y), o3 = (y[4 * g4 + 3] + bfhi(yf.y)) * bfhi(zz.y);
                        ssq += (o0 * o0 + o1 * o1) + (o2 * o2 + o3 * o3);
                        u32x2 o; o.x = cvt_pk_bf16(o0, o1); o.y = cvt_pk_bf16(o2, o3); *(LAS u32x2*)(lds + SD_X + l * 144 + (32 * pb + 8 * g4 + 4 * h) * 2) = o;
                    }
                    ssq += __shfl_xor(ssq, 32);
                    if (lane < 32) SSP[pb * 128 + l] = ssq;
                }
            }
            if (dir == 0 && step + 1 < 34 && step + 1 >= 2) SSD_ISSUE2(cbr, step + 1);
            {
                const float dec = __expf(dir ? ABS[0] : AF[127]);
#pragma unroll
                for (int i = 0; i < 16; ++i) Hacc[i] *= dec;
                const unsigned ab = xwbase + (unsigned)((8 * h + q) * 192 + (32 * pb + 16 * blk + 4 * pp) * 2);
                const unsigned bb = bbase + (unsigned)((8 * h + q) * 288 + (32 * lb + 16 * blk + 4 * pp) * 2);
#pragma unroll
                for (int half = 0; half < 2; ++half) {
                    s16x4 f[16];
                    tr_read_state4(ab + half * 4 * 3072, bb + half * 4 * 4608, f);
#pragma unroll
                    for (int ks = 0; ks < 4; ++ks) {
                        const bf16x8 afr = __builtin_shufflevector(f[4 * ks], f[4 * ks + 1], 0, 1, 2, 3, 4, 5, 6, 7), bfr = __builtin_shufflevector(f[4 * ks + 2], f[4 * ks + 3], 0, 1, 2, 3, 4, 5, 6, 7);
                        Hacc = __builtin_amdgcn_mfma_f32_32x32x16_bf16(afr, bfr, Hacc, 0, 0, 0);
                    }
                }
            }
            lds_barrier();
            pylat = lat; prow0 = row0;
            if (lat) {
                const int ybase = dir ? SD_X : SD_Y;
#pragma unroll
                for (int i = 0; i < 2; ++i) { const int idx = tid + 512 * i, r = idx >> 3, c16 = idx & 7; ytmp[i] = *(const LAS u32x4*)(lds + ybase + r * 144 + c16 * 16); }
                if (dir == 1 && tid < 128) sstmp = SSP[tid] + SSP[128 + tid];
            }
        }
        if (pylat) {
#pragma unroll
            for (int i = 0; i < 2; ++i) { const int idx = tid + 512 * i, r = idx >> 3, c16 = idx & 7;
                *(u32x4*)(AO + (size_t)(prow0 + r) * DMIX + 512 + hd * 64 + c16 * 8) = ytmp[i]; }
            if (dir == 1 && tid < 128) SS[(size_t)(prow0 + tid) * NH + hd] = sstmp;
        }
        asm volatile("s_waitcnt vmcnt(0)" ::: "memory");
        __syncthreads();
    }
#undef SSD_ISSUE
#undef SSD_ISSUE2
#undef SSD_CHUNK
#undef SSD_ROW0
}

struct EpiOutProj {
    static constexpr bool PERM = true;
    const float* x; const float* MOD; bf16_t* x1;
    DI void operator()(const f32x4 (&acc)[2][2][4][2], const pg8::Unit& u, int wr, int wc, int fr, int fq) const {
        const int row0 = u.pm * 256 + wr * 64 + fr, col0 = u.pn * 256 + wc * 32 + 8 * fq;
        const int b = (u.pm * 256) >> 12;
        f32x4 g[2][2];
#pragma unroll
        for (int bj = 0; bj < 2; ++bj)
#pragma unroll
            for (int n = 0; n < 2; ++n) g[bj][n] = *(const f32x4*)(MOD + b * 6144 + 2048 + col0 + bj * 128 + n * 4);
#pragma unroll
        for (int ai = 0; ai < 2; ++ai)
#pragma unroll
            for (int m = 0; m < 4; ++m) { const size_t off = (size_t)(row0 + ai * 128 + m * 16) * DM + col0;
#pragma unroll
                for (int bj = 0; bj < 2; ++bj) { const f32x4 x0 = *(const f32x4*)(x + off + bj * 128), x4 = *(const f32x4*)(x + off + bj * 128 + 4);
                    const f32x4 v0 = x0 + g[bj][0] * acc[ai][bj][m][0], v1 = x4 + g[bj][1] * acc[ai][bj][m][1];
                    u32x4 w; w.x = cvt_pk_bf16(v0[0], v0[1]); w.y = cvt_pk_bf16(v0[2], v0[3]); w.z = cvt_pk_bf16(v1[0], v1[1]); w.w = cvt_pk_bf16(v1[2], v1[3]);
                    *(u32x4*)(x1 + off + bj * 128) = w; } }
    }
};

DI void phase_router(Ctx& F) {
    relaunder(F);
    const float* nw = kin(16); const float* wr = kin(17);
    const float* MOD = (const float*)(F.ws + WS_MOD);
    unsigned char* H2 = F.ws + WS_H2; float* PROBS = (float*)(F.ws + WS_PROBS); int* INV = (int*)(F.ws + WS_INV);
    LAS float* WR = (LAS float*)F.lds;
    for (int i = F.tid; i < 16 * 1024; i += 512) { const int d = i >> 4, e = i & 15; WR[e * 1024 + d] = wr[i]; }
    __syncthreads();
    const int gw = F.bid * 8 + F.wave, NGW = F.G * 8, lane = F.lane;
    f32x4 nx[4];
    const bf16_t* X1 = (const bf16_t*)(F.ws + WS_X1);
    if (gw < NTOK) { const u32x2* xr = (const u32x2*)(X1 + (size_t)gw * DM) + lane;
#pragma unroll
        for (int j = 0; j < 4; ++j) { const u32x2 q = xr[64 * j]; nx[j] = (f32x4){bflo(q.x), bfhi(q.x), bflo(q.y), bfhi(q.y)}; } }
    for (int m = gw; m < NTOK; m += NGW) {
        const int b = m >> 12, t = m & 4095;
        f32x4 v[4]; float s = 0.f;
#pragma unroll
        for (int j = 0; j < 4; ++j) v[j] = nx[j];
        if (m + NGW < NTOK) { const u32x2* xr = (const u32x2*)(X1 + (size_t)(m + NGW) * DM) + lane;
#pragma unroll
            for (int j = 0; j < 4; ++j) { const u32x2 q = xr[64 * j]; nx[j] = (f32x4){bflo(q.x), bfhi(q.x), bflo(q.y), bfhi(q.y)}; } }
#pragma unroll
        for (int j = 0; j < 4; ++j) s += (v[j].x * v[j].x + v[j].y * v[j].y) + (v[j].z * v[j].z + v[j].w * v[j].w);
        const float rstd = rsqrtf(wave_sum(s) * (1.f / DM) + 1e-6f);
        const f32x4* w4 = (const f32x4*)nw + lane; const f32x4* sh4 = (const f32x4*)(MOD + b * 6144 + 3072) + lane; const f32x4* sc4 = (const f32x4*)(MOD + b * 6144 + 4096) + lane;
        unsigned* o = (unsigned*)(H2 + (size_t)m * DM) + lane;
#pragma unroll
        for (int j = 0; j < 4; ++j) { const f32x4 w = w4[64 * j], sh = sh4[64 * j], sc = sc4[64 * j];
            v[j] = (v[j] * rstd * w) * (sc + 1.f) + sh;
            o[64 * j] = pk_fp8x4(v[j].x, v[j].y, v[j].z, v[j].w); }
        float lg[16];
#pragma unroll
        for (int e = 0; e < 16; ++e) { float a = 0.f;
#pragma unroll
            for (int j = 0; j < 4; ++j) { const f32x4 w = *(const LAS f32x4*)(WR + e * 1024 + 4 * lane + 256 * j); a += (v[j].x * w.x + v[j].y * w.y) + (v[j].z * w.z + v[j].w * w.w); }
            lg[e] = a; asm volatile("" ::: "memory"); }
        float r1[8], r2[4], r3[2], r4;
        { const bool hi = (lane & 32) != 0;
#pragma unroll
          for (int i = 0; i < 8; ++i) { const float keep = hi ? lg[i + 8] : lg[i], send = hi ? lg[i] : lg[i + 8]; r1[i] = keep + __shfl_xor(send, 32); } }
        { const bool hi = (lane & 16) != 0;
#pragma unroll
          for (int i = 0; i < 4; ++i) { const float keep = hi ? r1[i + 4] : r1[i], send = hi ? r1[i] : r1[i + 4]; r2[i] = keep + __shfl_xor(send, 16); } }
        { const bool hi = (lane & 8) != 0;
#pragma unroll
          for (int i = 0; i < 2; ++i) { const float keep = hi ? r2[i + 2] : r2[i], send = hi ? r2[i] : r2[i + 2]; r3[i] = keep + __shfl_xor(send, 8); } }
        { const bool hi = (lane & 4) != 0; const float keep = hi ? r3[1] : r3[0], send = hi ? r3[0] : r3[1]; r4 = keep + __shfl_xor(send, 4); }
        r4 += __shfl_xor(r4, 1); r4 += __shfl_xor(r4, 2);
        float mx = r4;
        mx = fmaxf(mx, __shfl_xor(mx, 4)); mx = fmaxf(mx, __shfl_xor(mx, 8)); mx = fmaxf(mx, __shfl_xor(mx, 16)); mx = fmaxf(mx, __shfl_xor(mx, 32));
        const float ex = expf(r4 - mx);
        float den = ex;
        den += __shfl_xor(den, 4); den += __shfl_xor(den, 8); den += __shfl_xor(den, 16); den += __shfl_xor(den, 32);
        if ((lane & 3) == 0) { const int e = lane >> 2; PROBS[(size_t)(b * 16 + e) * SEQ + t] = ex / den; INV[(size_t)m * 16 + e] = -1; }
    }
}

DI void moe_weight_items(Ctx& F, int w, int nw) {
    relaunder(F);
    const int lane = F.lane;
    LAS float* scr = (LAS float*)(F.lds + F.wave * TR_SCR);
    const float* w_gate = kin(18); const float* w_up = kin(19); const float* w_down = kin(20);
    unsigned char* Wgu = F.ws + WS_WGU; unsigned char* Wd = F.ws + WS_WD;
    constexpr int I_G = NE * 16 * 32, I_D = NE * 32 * 16;
    for (int it = w; it < 2 * I_G + I_D; it += nw) {
        int r = it;
        if (r < 2 * I_G) { const int up = r >= I_G; if (up) r -= I_G; const int e = r / 512, kb = (r % 512) / 32, nb = r % 32, f0 = nb * 64;
            transpose_item_f8((up ? w_up : w_gate) + (size_t)e * DM * DEXP, DEXP, kb * 64, f0, Wgu + ((size_t)e * 4096 + (f0 >> 7) * 256 + (f0 & 127) + up * 128) * DM, DM, scr, lane); continue; }
        r -= 2 * I_G;
        { const int e = r / 512, kb = (r % 512) / 16, nb = r % 16;
          transpose_item_f8(w_down + (size_t)e * DEXP * DM, DM, kb * 64, nb * 64, Wd + ((size_t)e * DM + nb * 64) * DEXP, DEXP, scr, lane); }
    }
}

DI void phase_topk(Ctx& F) {
    relaunder(F);
    const float* PROBS = (const float*)(F.ws + WS_PROBS); int* ROWMAP = (int*)(F.ws + WS_ROWMAP); float* VAL = (float*)(F.ws + WS_VAL); int* INV = (int*)(F.ws + WS_INV);
    LAS unsigned* HIST = (LAS unsigned*)F.lds;
    LAS unsigned* CTL = HIST + 256;
    LAS unsigned* WS1 = HIST + 272;
    const int tid = F.tid, lane = F.lane, wave = F.wave;
    for (int u = F.bid; u < NB * NE; u += F.G) {
        const int b = u >> 4, e = u & 15;
        const float* pr = PROBS + (size_t)u * SEQ + tid * 8;
        const f32x4 p0 = *(const f32x4*)pr, p1 = *(const f32x4*)(pr + 4);
        unsigned key[8] = {__float_as_uint(p0.x), __float_as_uint(p0.y), __float_as_uint(p0.z), __float_as_uint(p0.w), __float_as_uint(p1.x), __float_as_uint(p1.y), __float_as_uint(p1.z), __float_as_uint(p1.w)};
        unsigned prefix = 0u, kk = CAP;
        for (int pass = 0; pass < 4; ++pass) {
            const int shift = 24 - 8 * pass;
            if (tid < 256) HIST[tid] = 0u;
            __syncthreads();
            const unsigned himask = pass == 0 ? 0u : (0xffffffffu << (shift + 8));
#pragma unroll
            for (int i = 0; i < 8; ++i) if ((key[i] & himask) == prefix) __hip_atomic_fetch_add(&HIST[(key[i] >> shift) & 255u], 1u, __ATOMIC_RELAXED, __HIP_MEMORY_SCOPE_WORKGROUP);
            __syncthreads();
            if (wave == 0) {
                const unsigned h0 = HIST[4 * lane], h1 = HIST[4 * lane + 1], h2 = HIST[4 * lane + 2], h3 = HIST[4 * lane + 3];
                const unsigned tot = h0 + h1 + h2 + h3; unsigned sfx = tot;
#pragma unroll
                for (int o = 1; o < 64; o <<= 1) { const unsigned t = __shfl_down(sfx, o); if (lane + o < 64) sfx += t; }
                const unsigned above = sfx - tot;
                const unsigned a3 = above, a2 = a3 + h3, a1 = a2 + h2, a0 = a1 + h1;
                int bin = -1; unsigned cum = 0u;
                if (a3 < kk && kk <= a3 + h3) { bin = 4 * lane + 3; cum = a3; }
                else if (a2 < kk && kk <= a2 + h2) { bin = 4 * lane + 2; cum = a2; }
                else if (a1 < kk && kk <= a1 + h1) { bin = 4 * lane + 1; cum = a1; }
                else if (a0 < kk && kk <= a0 + h0) { bin = 4 * lane; cum = a0; }
                if (bin >= 0) { CTL[0] = prefix | ((unsigned)bin << shift); CTL[1] = kk - cum; }
            }
            __syncthreads();
            prefix = CTL[0]; kk = CTL[1];
            __syncthreads();
        }
        int ceq = 0;
#pragma unroll
        for (int i = 0; i < 8; ++i) ceq += (key[i] == prefix);
        int seq = ceq;
#pragma unroll
        for (int o = 1; o < 64; o <<= 1) { const int t = __shfl_up(seq, o); if (lane >= o) seq += t; }
        if (lane == 63) WS1[wave] = (unsigned)seq;
        __syncthreads();
        int eqbase = seq - ceq;
        for (int w = 0; w < wave; ++w) eqbase += (int)WS1[w];
        int csel = 0; unsigned selmask = 0u; int er = eqbase;
#pragma unroll
        for (int i = 0; i < 8; ++i) { bool s = key[i] > prefix; if (key[i] == prefix) { s = (unsigned)er < kk; ++er; } if (s) { selmask |= 1u << i; ++csel; } }
        int ssel = csel;
#pragma unroll
        for (int o = 1; o < 64; o <<= 1) { const int t = __shfl_up(ssel, o); if (lane >= o) ssel += t; }
        if (lane == 63) WS1[8 + wave] = (unsigned)ssel;
        __syncthreads();
        int pos = ssel - csel;
        for (int w = 0; w < wave; ++w) pos += (int)WS1[8 + w];
        const int obase = (e * 8 + b) * CAP;
#pragma unroll
        for (int i = 0; i < 8; ++i) if (selmask & (1u << i)) { if (pos < CAP) { const int tok = b * SEQ + tid * 8 + i; ROWMAP[obase + pos] = tok; VAL[obase + pos] = __uint_as_float(key[i]); INV[(size_t)tok * 16 + e] = obase + pos; } ++pos; }
        __syncthreads();
    }
}

struct MoeGUOrder {
    static constexpr bool GATHER = true;
    const int* rowmap; int G, c;
    DI bool next(int i, pg8::Unit& u) const {
        const int cc = (G % 8 == 0) ? (c % 8) * (G / 8) + c / 8 : c;
        const int L = i * G + cc; if (L >= NE * 256) return false;
        const int e = L >> 8, loc = L & 255, xg = loc >> 5, r = loc & 31;
        u.pm = e * 16 + (xg >> 1) * 4 + (r >> 3); u.pn = (xg & 1) * 8 + (r & 7); return true;
    }
    DI size_t bt_row0(const pg8::Unit& u) const { return (size_t)(u.pm >> 4) * 4096 + (size_t)u.pn * 256; }
};
struct EpiGU {
    static constexpr bool PERM = true;
    unsigned char* ACT; LAS unsigned char* ebuf;
    DI void operator()(const f32x4 (&acc)[2][2][4][2], const pg8::Unit& u, int wr, int wc, int fr, int fq) const {
        int tid = threadIdx.x; asm volatile("" : "+v"(tid));
        if (wr == 0) __builtin_amdgcn_s_barrier();
#pragma unroll
        for (int ai = 0; ai < 2; ++ai) {
            if (ai) lds_barrier();
#pragma unroll
            for (int m = 0; m < 4; ++m) { float o[8];
#pragma unroll
                for (int n = 0; n < 2; ++n)
#pragma unroll
                    for (int j = 0; j < 4; ++j) o[4 * n + j] = silu_f(acc[ai][0][m][n][j]) * acc[ai][1][m][n][j];
                u32x2 w; w.x = pk_fp8x4(o[0], o[1], o[2], o[3]); w.y = pk_fp8x4(o[4], o[5], o[6], o[7]);
                *(LAS u32x2*)(ebuf + (wr * 64 + m * 16 + fr) * 144 + wc * 32 + 8 * fq) = w; }
            lds_barrier();
#pragma unroll
            for (int i = 0; i < 2; ++i) { const int q = tid + 512 * i, row = q >> 3, c16 = q & 7;
                const u32x4 v = *(const LAS u32x4*)(ebuf + row * 144 + c16 * 16);
                *(u32x4*)(ACT + (size_t)(u.pm * 256 + ai * 128 + row) * DEXP + u.pn * 128 + c16 * 16) = v; }
        }
        if (wr == 1) __builtin_amdgcn_s_barrier();
    }
};
struct MoeDownOrder {
    static constexpr bool GATHER = false;
    const int* rowmap; int G, c;
    DI bool next(int i, pg8::Unit& u) const {
        const int cc = (G % 8 == 0) ? (c % 8) * (G / 8) + c / 8 : c;
        const int L = i * G + cc; if (L >= 1024) return false;
        u.pm = L >> 2; u.pn = L & 3; return true;
    }
    DI size_t bt_row0(const pg8::Unit& u) const { return (size_t)(u.pm >> 4) * 1024 + (size_t)u.pn * 256; }
};
struct EpiDown {
    static constexpr bool PERM = true;
    const float* val; unsigned char* YB; LAS unsigned char* ebuf;
    DI void operator()(const f32x4 (&acc)[2][2][4][2], const pg8::Unit& u, int wr, int wc, int fr, int fq) const {
        int tid = threadIdx.x; asm volatile("" : "+v"(tid));
        if (wr == 0) __builtin_amdgcn_s_barrier();
#pragma unroll
        for (int ps = 0; ps < 4; ++ps) { const int ai = ps >> 1, mh = ps & 1;
            if (ps) lds_barrier();
#pragma unroll
            for (int mm = 0; mm < 2; ++mm) { const int m = 2 * mh + mm; const int r = u.pm * 256 + ai * 128 + wr * 64 + m * 16 + fr; const float v = val[r] * 16.f;
#pragma unroll
                for (int bj = 0; bj < 2; ++bj) { const f32x4 v0 = acc[ai][bj][m][0] * v, v1 = acc[ai][bj][m][1] * v;
                    u32x2 w; w.x = pk_fp8x4(v0[0], v0[1], v0[2], v0[3]); w.y = pk_fp8x4(v1[0], v1[1], v1[2], v1[3]);
                    *(LAS u32x2*)(ebuf + (wr * 32 + mm * 16 + fr) * 272 + bj * 128 + wc * 32 + 8 * fq) = w; } }
            lds_barrier();
#pragma unroll
            for (int i = 0; i < 2; ++i) { const int q = tid + 512 * i, lr = q >> 4, c16 = q & 15;
                const u32x4 vv = *(const LAS u32x4*)(ebuf + lr * 272 + c16 * 16);
                *(u32x4*)(YB + (size_t)(u.pm * 256 + ai * 128 + (lr >> 5) * 64 + mh * 32 + (lr & 31)) * DM + u.pn * 256 + c16 * 16) = vv; }
        }
        if (wr == 1) __builtin_amdgcn_s_barrier();
    }
};

DI void final_slots(const unsigned char* YB, int inv, int lane, unsigned& mask, int& cnt, unsigned (&yb)[4][4]) {
    mask = (unsigned)(__ballot(inv >= 0) & 0xffffull); cnt = __builtin_popcount(mask);
    unsigned mm = mask;
#pragma unroll
    for (int k = 0; k < 4; ++k) { if (mm != 0u) { const int e = __builtin_ctz(mm); mm &= mm - 1u; const int r = __builtin_amdgcn_readlane(inv, e);
            const unsigned* yr = (const unsigned*)(YB + (size_t)r * DM) + lane;
#pragma unroll
            for (int j = 0; j < 4; ++j) yb[k][j] = yr[64 * j]; } }
}
DI void phase_final(Ctx& F) {
    relaunder(F);
    const float* fw = kin(21); const float* MOD = (const float*)(F.ws + WS_MOD);
    const int* INV = (const int*)(F.ws + WS_INV); const unsigned char* YB = F.ws + WS_YB; const bf16_t* X1 = (const bf16_t*)(F.ws + WS_X1);
    const int gw = F.bid * 8 + F.wave, NGW = F.G * 8, lane = F.lane;
    if (gw >= NTOK) return;
    int inv_c = (lane < 16) ? INV[(size_t)gw * 16 + lane] : -1;
    int inv_n = (lane < 16 && gw + NGW < NTOK) ? INV[(size_t)(gw + NGW) * 16 + lane] : -1;
    u32x2 xc[4], xn[4];
    { const u32x2* x1r = (const u32x2*)(X1 + (size_t)gw * DM) + lane;
#pragma unroll
      for (int j = 0; j < 4; ++j) { xc[j] = x1r[64 * j]; xn[j] = xc[j]; } }
    unsigned ybc[4][4], ybn[4][4]; unsigned mask_c = 0u, mask_n = 0u; int cnt_c = 0, cnt_n = 0;
#pragma unroll
    for (int k = 0; k < 4; ++k)
#pragma unroll
        for (int j = 0; j < 4; ++j) { ybc[k][j] = 0u; ybn[k][j] = 0u; }
    final_slots(YB, inv_c, lane, mask_c, cnt_c, ybc);
    for (int m = gw; m < NTOK; m += NGW) {
        const int b = m >> 12, mn = m + NGW, mnn = m + 2 * NGW;
        int inv_nn = -1;
        if (mn < NTOK) { const u32x2* x1r = (const u32x2*)(X1 + (size_t)mn * DM) + lane;
#pragma unroll
            for (int j = 0; j < 4; ++j) xn[j] = x1r[64 * j];
            final_slots(YB, inv_n, lane, mask_n, cnt_n, ybn);
            if (lane < 16 && mnn < NTOK) inv_nn = INV[(size_t)mnn * 16 + lane]; }
        f32x4 v[4], a[4];
#pragma unroll
        for (int j = 0; j < 4; ++j) { v[j] = (f32x4){bflo(xc[j].x), bfhi(xc[j].x), bflo(xc[j].y), bfhi(xc[j].y)}; a[j] = (f32x4){0.f, 0.f, 0.f, 0.f}; }
#pragma unroll
        for (int k = 0; k < 4; ++k) if (k < cnt_c) {
#pragma unroll
            for (int j = 0; j < 4; ++j) { const f32v2 lo = __builtin_amdgcn_cvt_pk_f32_fp8(ybc[k][j], false), hi = __builtin_amdgcn_cvt_pk_f32_fp8(ybc[k][j], true);
                a[j].x += lo.x; a[j].y += lo.y; a[j].z += hi.x; a[j].w += hi.y; } }
        if (cnt_c > 4) {
            unsigned mm = mask_c; mm &= mm - 1u; mm &= mm - 1u; mm &= mm - 1u; mm &= mm - 1u;
            while (mm != 0u) { const int e = __builtin_ctz(mm); mm &= mm - 1u; const int r = __builtin_amdgcn_readlane(inv_c, e);
                const unsigned* yr = (const unsigned*)(YB + (size_t)r * DM) + lane;
#pragma unroll
                for (int j = 0; j < 4; ++j) { const unsigned y = yr[64 * j]; const f32v2 lo = __builtin_amdgcn_cvt_pk_f32_fp8(y, false), hi = __builtin_amdgcn_cvt_pk_f32_fp8(y, true);
                    a[j].x += lo.x; a[j].y += lo.y; a[j].z += hi.x; a[j].w += hi.y; } } }
        const f32x4* g4 = (const f32x4*)(MOD + b * 6144 + 5120) + lane;
        float s = 0.f;
#pragma unroll
        for (int j = 0; j < 4; ++j) { v[j] = v[j] + g4[64 * j] * a[j] * (1.f / 16.f); s += (v[j].x * v[j].x + v[j].y * v[j].y) + (v[j].z * v[j].z + v[j].w * v[j].w); }
        const float rstd = rsqrtf(wave_sum(s) * (1.f / DM) + 1e-6f);
        const f32x4* w4 = (const f32x4*)fw + lane;
        f32x4* xr = (f32x4*)(F.out + (size_t)m * DM) + lane;
#pragma unroll
        for (int j = 0; j < 4; ++j) xr[64 * j] = v[j] * rstd * w4[64 * j];
#pragma unroll
        for (int j = 0; j < 4; ++j) xc[j] = xn[j];
#pragma unroll
        for (int k = 0; k < 4; ++k)
#pragma unroll
            for (int j = 0; j < 4; ++j) ybc[k][j] = ybn[k][j];
        mask_c = mask_n; cnt_c = cnt_n; inv_c = inv_n; inv_n = inv_nn;
    }
}

__global__ void __launch_bounds__(512) fwd_megakernel(Params p) {
    extern __shared__ __attribute__((aligned(16))) unsigned char lds_raw[];
    cg::grid_group grid = cg::this_grid();
    Ctx F;
    F.lds = (LAS unsigned char*)lds_raw;
    F.tid = threadIdx.x; F.lane = F.tid & 63; F.wave = __builtin_amdgcn_readfirstlane(F.tid >> 6); F.G = gridDim.x; F.bid = blockIdx.x;
    F.out = p.out; F.ws = p.ws;

    {
        if (F.tid == 0) { ((LAS unsigned*)(F.lds + LDS_BYTES - 16))[0] = 0u; ((LAS unsigned*)(F.lds + LDS_BYTES - 16))[1] = 0u; }
        if (F.bid == 0) { unsigned* bw = (unsigned*)(F.ws + WS_BAR); for (int i = F.tid; i < XCD_BAR_WORDS + 256; i += 512) bw[i] = 0u; }
        __syncthreads();
    }
    phase0(F);
    grid.sync();
    const XcdBarrier xbar = xcd_barrier_post((unsigned*)(F.ws + WS_BAR), (volatile LAS unsigned*)(F.lds + LDS_BYTES - 16));
    phase_h(F);
    xcd_barrier(xbar);
    {
        pg8::RectOrder S; S.init(128, 19, F.G, F.bid); S.nextra = 8 * 11; S.ex_m0 = 128; S.ex_n0 = 8; S.ex_nm = 8;
        EpiInProj E{(bf16_t*)(F.ws + WS_R2), (bf16_t*)F.out, (bf16_t*)(F.ws + WS_R4), (float*)(F.ws + WS_R5), kin(10)};
        pg8::gemm_phase<false, false>(F.lds, F.ws + WS_R1, F.ws + WS_WIN, DM * 2, S, E);
    }
    xcd_barrier(xbar);
    fft_step1(F);
    conv_cb_phase(F);
    xcd_barrier(xbar);
    if (F.bid < 192) { const int x = F.bid & 7, j = F.bid >> 3, gi = x * 4 + j / 6;
        ssd_unit(F, gi >> 2, (gi & 3) * 6 + j % 6); }
    else {
        const int sb = F.bid, sg = F.G; F.bid = sb - 192; F.G = sg - 192; fft_step2(F); F.bid = sb; F.G = sg;
        __syncthreads();
        moe_weight_items(F, (sb - 192) * 8 + F.wave, (sg - 192) * 8);
    }
    xcd_barrier(xbar);
    {
        pg8::RectOrder S; S.init(128, 4, F.G, F.bid);
        EpiOutProj E{kin(0), (const float*)(F.ws + WS_MOD), (bf16_t*)(F.ws + WS_X1)};
        LAS float* rs_tab = (LAS float*)(F.lds + pg8::STAGE_BYTES);
        { const float* SS = (const float*)(F.ws + WS_SS);
          for (int i = F.tid; i < 512; i += 512) { pg8::Unit u; if (!S.next(i >> 8, u)) break;
              const float* sp = SS + (size_t)(u.pm * 256 + (i & 255)) * NH; float r[4];
#pragma unroll
              for (int g = 0; g < 4; ++g) { float t = 0.f;
#pragma unroll
                  for (int k = 0; k < 6; ++k) t += sp[g * 6 + k];
                  r[g] = rsqrtf(t * (1.f / 384.f) + 1e-6f); }
              LAS float* o = rs_tab + (size_t)i * 8;
              o[0] = 1.f / r[0]; o[1] = r[0] / r[1]; o[2] = r[1] / r[2]; o[3] = r[2] / r[3]; o[4] = r[3]; }
          __syncthreads(); }
        pg8::gemm_phase<false, true>(F.lds, F.ws + WS_R4, F.ws + WS_WOUT, DMIX * 2, S, E, rs_tab);
    }
    xcd_barrier(xbar);
    phase_router(F);
    xcd_barrier(xbar);
    phase_topk(F);
    xcd_barrier(xbar);
    {
        MoeGUOrder S; S.rowmap = (const int*)(F.ws + WS_ROWMAP); S.G = F.G; S.c = F.bid;
        EpiGU E{F.ws + WS_ACT, F.lds + pg8::STAGE_BYTES};
        pg8::gemm_phase<true, false>(F.lds, F.ws + WS_H2, F.ws + WS_WGU, DM, S, E);
    }
    xcd_barrier(xbar);
    {
        MoeDownOrder S; S.rowmap = nullptr; S.G = F.G; S.c = F.bid;
        EpiDown E{(const float*)(F.ws + WS_VAL), F.ws + WS_YB, F.lds + pg8::STAGE_BYTES};
        pg8::gemm_phase<true, false>(F.lds, F.ws + WS_ACT, F.ws + WS_WD, DEXP, S, E);
    }
    xcd_barrier(xbar);
    phase_final(F);
}

extern "C" void kernel_launch(void* const* d_in, const int* in_sizes, int n_in, void* d_out, int out_size, void* d_ws, size_t ws_size, hipStream_t stream) {
    static int grid_blocks = 0;
    if (!grid_blocks) {
        int dev = 0, cus = 0, per_cu = 0;
        (void)hipGetDevice(&dev);
        (void)hipDeviceGetAttribute(&cus, hipDeviceAttributeMultiprocessorCount, dev);
        (void)hipFuncSetAttribute((const void*)fwd_megakernel, hipFuncAttributeMaxDynamicSharedMemorySize, LDS_BYTES);
        (void)hipOccupancyMaxActiveBlocksPerMultiprocessor(&per_cu, (const void*)fwd_megakernel, 512, LDS_BYTES);
        if (per_cu < 1) per_cu = 1;
        grid_blocks = cus * per_cu;
        fprintf(stderr, "grid %d (cus %d per_cu %d) ws %zu need %zu\n", grid_blocks, cus, per_cu, ws_size, (size_t)WS_NEED);
        if (grid_blocks != 256) { fprintf(stderr, "this kernel's phase program is written for a 256-workgroup grid (one per CU); got %d\n", grid_blocks); grid_blocks = -1; }
        else if (ws_size < WS_NEED || n_in != 22) { fprintf(stderr, "workspace too small or bad inputs\n"); grid_blocks = -1; }
    }
    if (grid_blocks < 0) return;
    Params p{};
    for (int i = 0; i < 22; ++i) p.in[i] = (const float*)d_in[i];
    p.out = (float*)d_out; p.ws = (unsigned char*)d_ws;
    void* args[] = {&p};
    hipError_t e = hipLaunchCooperativeKernel((void*)fwd_megakernel, dim3(grid_blocks), dim3(512), args, LDS_BYTES, stream);
    if (e != hipSuccess) fprintf(stderr, "cooperative launch failed: %s (grid %d)\n", hipGetErrorString(e), grid_blocks);
}
```

```cpp
#include <hip/hip_runtime.h>
#include <hip/hip_cooperative_groups.h>
#include <cstdio>
namespace cg = cooperative_groups;

#define LAS __attribute__((address_space(3)))
#define DI __device__ __forceinline__
typedef unsigned short bf16_t;
typedef short bf16x8 __attribute__((ext_vector_type(8)));
typedef short s16x4 __attribute__((ext_vector_type(4)));
typedef float f32x4 __attribute__((ext_vector_type(4)));
typedef float f32x16 __attribute__((ext_vector_type(16)));
typedef unsigned u32x4 __attribute__((ext_vector_type(4)));
typedef unsigned u32x2 __attribute__((ext_vector_type(2)));

constexpr int NB = 8, SEQ = 4096, DM = 1024, CTXL = 256;
constexpr int NTOK = NB * SEQ;
constexpr int NCTX = NB * CTXL;
constexpr int NROWS = NTOK + NCTX;
constexpr int DIN = 4656, DIN_T = 4864;
constexpr int DSSM = 1536, NH = 24, HD = 64, NG = 4, DST = 128, CONVD = 2560, DMIX = 2048;
constexpr int NE = 16, CAP = 512, DEXP = 2048;
constexpr int LDS_BYTES = 163840;

constexpr size_t MB = 1u << 20;
constexpr size_t WS_MOD   = 4096;
constexpr size_t WS_WOUT  = 1 * MB;
constexpr size_t WS_WIN   = WS_WOUT + (size_t)DM * DMIX * 2;
constexpr size_t WS_R1    = WS_WIN + (size_t)DIN_T * DM * 2;
constexpr size_t WS_R2    = WS_R1 + (size_t)NROWS * DM * 2;
constexpr size_t WS_R4    = WS_R2 + (size_t)NTOK * DM * 2;
constexpr size_t WS_R5    = WS_R4 + (size_t)NROWS * CONVD * 2;
constexpr size_t WS_XS    = WS_R5 + (size_t)NROWS * 48 * 4;
constexpr size_t WS_BM    = WS_XS + (size_t)NROWS * DSSM * 2;
constexpr size_t WS_CM    = WS_BM + (size_t)NROWS * 512 * 2;
constexpr size_t WS_CB    = WS_CM + (size_t)NROWS * 512 * 2;
constexpr size_t WS_SS    = WS_CB + (size_t)NB * 32 * NG * 16384 * 2;
constexpr size_t WS_ARRS  = WS_SS + (size_t)NTOK * NH * 4;
constexpr size_t WS_END1  = WS_ARRS + (size_t)NB * 34 * NH * 768 * 4;

constexpr size_t WS_ROWMAP = 256 * 1024;
constexpr size_t WS_VAL    = 512 * 1024;
constexpr size_t WS_WGU    = WS_R2;
constexpr size_t WS_WD     = WS_R4 + (size_t)NTOK * DMIX * 2;
constexpr size_t WS_H2     = WS_R1;
constexpr size_t WS_ACT    = WS_XS;
constexpr size_t WS_PROBS  = WS_ACT + (size_t)NE * NB * CAP * DEXP;
constexpr size_t WS_INV    = WS_PROBS + (size_t)NB * NE * SEQ * 4;
constexpr size_t WS_YB     = WS_R4;
constexpr size_t WS_X1     = WS_INV + (size_t)NTOK * NE * 4;
constexpr size_t WS_END2   = WS_X1 + (size_t)NTOK * DM * 2;
constexpr size_t WS_BAR    = 768 * 1024;
static_assert(WS_WD + (size_t)NE * DM * DEXP <= WS_R5 && WS_WGU + (size_t)NE * 4096 * DM <= WS_R4 && WS_END2 <= WS_SS && WS_H2 + (size_t)NTOK * DM <= WS_R2, "MoE stage layout");
constexpr size_t WS_NEED   = WS_END1 > WS_END2 ? WS_END1 : WS_END2;

typedef __bf16 bf16v2 __attribute__((ext_vector_type(2)));
typedef float f32v2 __attribute__((ext_vector_type(2)));
DI unsigned cvt_pk_bf16(float lo, float hi) { f32v2 f = {lo, hi}; bf16v2 h = __builtin_convertvector(f, bf16v2); return __builtin_bit_cast(unsigned, h); }
DI bf16_t f2bf(float f) { return (bf16_t)(cvt_pk_bf16(f, 0.f) & 0xffffu); }
DI float bf2f(bf16_t b) { return __uint_as_float(((unsigned)b) << 16); }
DI float silu_f(float x) { return x * __builtin_amdgcn_rcpf(1.f + __expf(-x)); }
DI float softplus_f(float x) { return fmaxf(x, 0.f) + log1pf(__expf(-fabsf(x))); }
DI float wave_sum(float v) {
#pragma unroll
    for (int o = 1; o < 64; o <<= 1) v += __shfl_xor(v, o);
    return v;
}
DI unsigned pk_fp8x4(float a, float b, float c, float d) { unsigned w = 0u; w = __builtin_amdgcn_cvt_pk_fp8_f32(a, b, w, false); w = __builtin_amdgcn_cvt_pk_fp8_f32(c, d, w, true); return w; }
DI void lds_wait() { asm volatile("s_waitcnt lgkmcnt(0)" ::: "memory"); }
DI void lds_barrier() { asm volatile("s_waitcnt lgkmcnt(0)" ::: "memory"); __builtin_amdgcn_s_barrier(); asm volatile("" ::: "memory"); }

namespace pg8 {
constexpr int BM = 256, BK = 64, HALF = 128, HTB = HALF * BK * 2, STAGE_BYTES = 8 * HTB;
DI int lds_byte(int r, int c) { const int st = (r >> 4) * 2 + (c >> 5), rr = r & 15, cc = c & 31, ob = rr * 64 + cc * 2; return st * 1024 + (ob ^ (((ob >> 9) & 1) << 5)); }
DI void stage_rc(int b, int& R, int& C) { const int st = b / 1024, sb = b % 1024, swz = sb ^ (((sb >> 9) & 1) << 5); R = (st >> 1) * 16 + swz / 64; C = (st & 1) * 32 + (swz % 64) / 2; }
DI int perm32(int rho) { const int n = rho >> 4, i = rho & 15; return 8 * (i >> 2) + 4 * n + (i & 3); }
struct Unit { int pm, pn; };

template <class Ord>
DI void a_offsets(const Ord& S, const Unit& u, int KB, int tid, unsigned (&ao)[2][2]) {
#pragma unroll
    for (int h = 0; h < 2; ++h)
#pragma unroll
        for (int i = 0; i < 2; ++i) { int R, C; stage_rc(tid * 16 + i * 8192, R, C); const int r = S.rowmap[u.pm * BM + h * HALF + R]; ao[h][i] = (unsigned)r * (unsigned)KB + (unsigned)C * 2u; }
}

typedef int i32x4v __attribute__((ext_vector_type(4)));
typedef int i32x8v __attribute__((ext_vector_type(8)));
DI i32x8v cat8(bf16x8 a, bf16x8 b) { return __builtin_shufflevector(__builtin_bit_cast(i32x4v, a), __builtin_bit_cast(i32x4v, b), 0, 1, 2, 3, 4, 5, 6, 7); }
template <bool FP8, bool RS, class Epi, class Ord>
DI void gemm_phase(LAS unsigned char* lds, const void* A, const void* Bt, const int KB, const Ord& S, const Epi& E, const LAS float* rs_tab = nullptr) {
    int tid_ = threadIdx.x; asm volatile("" : "+v"(tid_));
    const int tid = tid_, wid = __builtin_amdgcn_readfirstlane(tid >> 6), lane = tid & 63, wr = wid >> 2, wc = wid & 3, fr = lane & 15, fq = lane >> 4;
    const int nt = KB / 128;
    constexpr bool GA = Ord::GATHER;
    unsigned voffA[2], voffB[2];
#pragma unroll
    for (int i = 0; i < 2; ++i) { int R, C; stage_rc(tid * 16 + i * 8192, R, C); const int Rb = Epi::PERM ? ((R & ~31) + perm32(R & 31)) : R; voffA[i] = (unsigned)(R * KB + C * 2); voffB[i] = (unsigned)(Rb * KB + C * 2); }
    const size_t tstep = (size_t)BM * KB;
    const size_t kstep = (size_t)(BK * 2);
    const size_t hstep = (size_t)HALF * KB;
    const unsigned ldsw = (unsigned)wid * 1024u;
    const int aoff = lds_byte(wr * 64 + fr, fq * 8), boff = lds_byte(wc * 32 + fr, fq * 8);
#define PG8_SA(b, h) (((b) * 2 + (h)) * HTB)
#define PG8_SB(b, h) ((4 + (b) * 2 + (h)) * HTB)
#define PG8_STAGE(bufoff, gbase, voff) do { _Pragma("unroll") for (int _i = 0; _i < 2; ++_i) \
        __builtin_amdgcn_global_load_lds((const unsigned*)((const char*)(gbase) + (voff)[_i]), (LAS unsigned*)(lds + (bufoff) + ldsw + _i * 8192), 16, 0, 0); } while (0)
#define PG8_LDA(dst, b, h) do { _Pragma("unroll") for (int m = 0; m < 4; ++m) dst[m] = cat8(*(const LAS bf16x8*)(lds + PG8_SA(b, h) + aoff + m * 2048), *(const LAS bf16x8*)(lds + PG8_SA(b, h) + aoff + m * 2048 + 1024)); } while (0)
#define PG8_LDB(dst, b, h) do { _Pragma("unroll") for (int n = 0; n < 2; ++n) dst[n] = cat8(*(const LAS bf16x8*)(lds + PG8_SB(b, h) + boff + n * 2048), *(const LAS bf16x8*)(lds + PG8_SB(b, h) + boff + n * 2048 + 1024)); } while (0)
#define PG8_LO(v) __builtin_bit_cast(bf16x8, __builtin_shufflevector(v, v, 0, 1, 2, 3))
#define PG8_HI(v) __builtin_bit_cast(bf16x8, __builtin_shufflevector(v, v, 4, 5, 6, 7))
#define PG8_MMA(ai, bj, At, Bt_) do { __builtin_amdgcn_s_setprio(1); _Pragma("unroll") for (int m = 0; m < 4; ++m) _Pragma("unroll") for (int n = 0; n < 2; ++n) { \
        if constexpr (FP8) asm volatile("v_mfma_scale_f32_16x16x128_f8f6f4 %0, %1, %2, %0, %3, %4 op_sel_hi:[0,0,0]" : "+v"(acc[ai][bj][m][n]) : "v"(Bt_[n]), "v"(At[m]), "v"(scl_w), "v"(scl_a)); \
        else { acc[ai][bj][m][n] = __builtin_amdgcn_mfma_f32_16x16x32_bf16(PG8_LO(Bt_[n]), PG8_LO(At[m]), acc[ai][bj][m][n], 0, 0, 0); \
               acc[ai][bj][m][n] = __builtin_amdgcn_mfma_f32_16x16x32_bf16(PG8_HI(Bt_[n]), PG8_HI(At[m]), acc[ai][bj][m][n], 0, 0, 0); } } \
        __builtin_amdgcn_s_setprio(0); } while (0)
#define PG8_WAIT_V(n) asm volatile("s_waitcnt vmcnt(" #n ")" ::: "memory")
#define PG8_WAIT_L(n) asm volatile("s_waitcnt lgkmcnt(" #n ")" ::: "memory")
#define PG8_BAR __builtin_amdgcn_s_barrier()
#define PG8_SCHED __builtin_amdgcn_sched_barrier(0)
    Unit cur, nxt; int ui = 0;
    if (!S.next(0, cur)) return;
    f32x4 acc[2][2][4][2];
#pragma unroll
    for (int a = 0; a < 2; ++a)
#pragma unroll
        for (int b = 0; b < 2; ++b)
#pragma unroll
            for (int m = 0; m < 4; ++m)
#pragma unroll
                for (int n = 0; n < 2; ++n) acc[a][b][m][n] = (f32x4){0.f, 0.f, 0.f, 0.f};
    i32x8v At[4], B0[2], B1[2];
    const int scl_w = 0x7a7a7a7a, scl_a = 0x7f7f7f7f;
    unsigned aoc[2][2], aon[2][2];
    if constexpr (GA) a_offsets(S, cur, KB, tid, aoc);
    const char* const Ab = (const char*)A;
    const char* cA = GA ? Ab : Ab + (size_t)cur.pm * tstep;
#define PG8_AP(p, h) (GA ? (p) : (p) + (h) * hstep)
#define PG8_AO(o, h) (GA ? (o)[h] : voffA)
    const char* cB = (const char*)Bt + S.bt_row0(cur) * (size_t)KB;
    PG8_STAGE(PG8_SB(0, 0), cB, voffB); PG8_STAGE(PG8_SA(0, 0), PG8_AP(cA, 0), PG8_AO(aoc, 0)); PG8_STAGE(PG8_SB(0, 1), cB + hstep, voffB); PG8_STAGE(PG8_SA(0, 1), PG8_AP(cA, 1), PG8_AO(aoc, 1));
    if (wr == 1) PG8_BAR;
    PG8_WAIT_V(4); PG8_BAR;
    PG8_STAGE(PG8_SB(1, 0), cB + kstep, voffB); PG8_STAGE(PG8_SA(1, 0), PG8_AP(cA + kstep, 0), PG8_AO(aoc, 0)); PG8_STAGE(PG8_SB(1, 1), cB + hstep + kstep, voffB);
    PG8_WAIT_V(6); PG8_BAR;
    for (;;) {
        const bool has_next = S.next(ui + 1, nxt);
        const char* nB = cB; const char* nA = cA;
        if (has_next) { if constexpr (GA) a_offsets(S, nxt, KB, tid, aon); else nA = Ab + (size_t)nxt.pm * tstep; nB = (const char*)Bt + S.bt_row0(nxt) * (size_t)KB; }
        else if constexpr (GA) {
#pragma unroll
            for (int h = 0; h < 2; ++h)
#pragma unroll
                for (int i = 0; i < 2; ++i) aon[h][i] = aoc[h][i];
        }
#pragma unroll 1
        for (int t = 0; t < nt; t += 2) {
            const bool last = (t == nt - 2);
            float rsv[2][4]; bool rs_now = false;
            if constexpr (RS) { const int tn = t + 2; rs_now = (tn >= 8) && ((tn - 8) % 6 == 0);
                if (rs_now) { const int bi = (tn - 8) / 6; const LAS float* tb = rs_tab + (size_t)(ui & 1) * 256 * 8 + bi;
#pragma unroll
                    for (int ai = 0; ai < 2; ++ai)
#pragma unroll
                        for (int m = 0; m < 4; ++m) rsv[ai][m] = tb[(ai * HALF + wr * 64 + m * 16 + fr) * 8]; } }
            const char* a1 = cA + (size_t)(t + 1) * kstep;
            const char* a2 = last ? nA : cA + (size_t)(t + 2) * kstep; const char* b2 = last ? nB : cB + (size_t)(t + 2) * kstep;
            const char* a3 = a2 + kstep; const char* b3 = b2 + kstep;
            unsigned o2[2][2];
            if constexpr (GA) {
#pragma unroll
                for (int h = 0; h < 2; ++h)
#pragma unroll
                    for (int i = 0; i < 2; ++i) o2[h][i] = last ? aon[h][i] : aoc[h][i];
            }
            PG8_LDB(B0, 0, 0); PG8_SCHED; PG8_LDA(At, 0, 0); PG8_STAGE(PG8_SA(1, 1), PG8_AP(a1, 1), PG8_AO(aoc, 1));
            PG8_WAIT_L(8); PG8_BAR; PG8_WAIT_L(0); PG8_MMA(0, 0, At, B0); PG8_BAR; PG8_SCHED;
            PG8_LDB(B1, 0, 1); PG8_STAGE(PG8_SB(0, 0), b2, voffB);
            PG8_BAR; PG8_WAIT_L(0); PG8_MMA(0, 1, At, B1); PG8_BAR;
            PG8_LDA(At, 0, 1); PG8_STAGE(PG8_SA(0, 0), PG8_AP(a2, 0), PG8_AO(o2, 0));
            PG8_BAR; PG8_WAIT_L(0); PG8_MMA(1, 0, At, B0); PG8_BAR; PG8_SCHED;
            PG8_STAGE(PG8_SB(0, 1), b2 + hstep, voffB);
            PG8_WAIT_V(6); PG8_BAR; PG8_MMA(1, 1, At, B1); PG8_BAR;
            PG8_LDB(B0, 1, 0); PG8_SCHED; PG8_LDA(At, 1, 0); PG8_STAGE(PG8_SA(0, 1), PG8_AP(a2, 1), PG8_AO(o2, 1));
            PG8_WAIT_L(8); PG8_BAR; PG8_WAIT_L(0); PG8_MMA(0, 0, At, B0); PG8_BAR; PG8_SCHED;
            PG8_LDB(B1, 1, 1); PG8_STAGE(PG8_SB(1, 0), b3, voffB);
            PG8_BAR; PG8_WAIT_L(0); PG8_MMA(0, 1, At, B1); PG8_BAR;
            PG8_LDA(At, 1, 1); PG8_STAGE(PG8_SA(1, 0), PG8_AP(a3, 0), PG8_AO(o2, 0));
            PG8_BAR; PG8_WAIT_L(0); PG8_MMA(1, 0, At, B0); PG8_BAR; PG8_SCHED;
            PG8_STAGE(PG8_SB(1, 1), b3 + hstep, voffB);
            PG8_WAIT_V(6); PG8_BAR; PG8_MMA(1, 1, At, B1); PG8_BAR;
            if constexpr (RS) { if (rs_now) {
#pragma unroll
                for (int ai = 0; ai < 2; ++ai)
#pragma unroll
                    for (int bj = 0; bj < 2; ++bj)
#pragma unroll
                        for (int m = 0; m < 4; ++m)
#pragma unroll
                            for (int n = 0; n < 2; ++n) acc[ai][bj][m][n] = acc[ai][bj][m][n] * rsv[ai][m]; } }
        }
        if constexpr (FP8) asm volatile("s_nop 15\n\ts_nop 15" ::: "memory");
        E(acc, cur, wr, wc, fr, fq);
        if (!has_next) break;
#pragma unroll
        for (int a = 0; a < 2; ++a)
#pragma unroll
            for (int b = 0; b < 2; ++b)
#pragma unroll
                for (int m = 0; m < 4; ++m)
#pragma unroll
                    for (int n = 0; n < 2; ++n) acc[a][b][m][n] = (f32x4){0.f, 0.f, 0.f, 0.f};
        cur = nxt; cB = nB; cA = nA; ++ui;
        if constexpr (GA) {
#pragma unroll
            for (int h = 0; h < 2; ++h)
#pragma unroll
                for (int i = 0; i < 2; ++i) aoc[h][i] = aon[h][i];
        }
    }
    PG8_WAIT_V(0);
    if (wr == 0) PG8_BAR;
    PG8_BAR;
#undef PG8_AP
#undef PG8_AO
#undef PG8_SA
#undef PG8_SB
#undef PG8_STAGE
#undef PG8_LO
#undef PG8_HI
#undef PG8_LDA
#undef PG8_LDB
#undef PG8_MMA
#undef PG8_WAIT_V
#undef PG8_WAIT_L
#undef PG8_BAR
#undef PG8_SCHED
}

struct RectOrder {
    static constexpr bool GATHER = false;
    const int* rowmap;
    int nM, nN, nwg, G, c, nextra, ex_m0, ex_n0, ex_nm;
    DI void init(int nM_, int nN_, int G_, int c_) { nM = nM_; nN = nN_; nwg = nM * nN; G = G_; c = c_; nextra = 0; ex_m0 = ex_n0 = 0; ex_nm = 1; rowmap = nullptr; }
    DI bool next(int i, Unit& u) const {
        const int L = i * G + c; if (L >= nwg + nextra) return false;
        if (L >= nwg) { const int e = L - nwg; u.pm = ex_m0 + e % ex_nm; u.pn = ex_n0 + e / ex_nm; return true; }
        int wgid = L; { const int q = nwg / 8, r = nwg % 8, xcd = wgid % 8, off = wgid / 8; wgid = (xcd < r ? xcd * (q + 1) : r * (q + 1) + (xcd - r) * q) + off; }
        const int nig = 8 * nN, gid = wgid / nig, fm = gid * 8, gsz = (nM - fm) < 8 ? (nM - fm) : 8;
        u.pm = fm + ((wgid % nig) % gsz); u.pn = (wgid % nig) / gsz; return true;
    }
    DI size_t bt_row0(const Unit& u) const { return (size_t)u.pn * BM; }
};
}


#define XB_TMO      128
#define XB_XCNT(j)  (256  + 64 * (j))
#define XB_XSUB(j)  (1280 + 64 * (j))
#define XB_XGEN(j)  (2304 + 64 * (j))
#define XB_TOP      3328
#define XB_TOPGEN   3392
#define XCD_BAR_WORDS 3456
#define XB_SPIN_CAP (1u << 18)
DI unsigned xb_ld(unsigned* p)              { return __hip_atomic_load(p, __ATOMIC_RELAXED, __HIP_MEMORY_SCOPE_AGENT); }
DI unsigned xb_add(unsigned* p, unsigned v) { return __hip_atomic_fetch_add(p, v, __ATOMIC_RELAXED, __HIP_MEMORY_SCOPE_AGENT); }
DI unsigned xb_xcc_id() { return (unsigned)__builtin_amdgcn_s_getreg((3 << 11) | 20) & 0xFu; }
#define XB_SPIN(cond, bar) do { unsigned _sp = 0; while (cond) { __builtin_amdgcn_s_sleep(1); \
    if ((++_sp & 255u) == 0u) { if (xb_ld(&(bar)[XB_TMO])) break; if (_sp > XB_SPIN_CAP) { atomicAdd(&(bar)[XB_TMO], 1u); break; } } } } while (0)
struct XcdBarrier { unsigned* bar; unsigned x; volatile LAS unsigned* st; };
DI XcdBarrier xcd_barrier_post(unsigned* bar, volatile LAS unsigned* st) {
    XcdBarrier b; b.bar = bar; b.x = xb_xcc_id(); b.st = st;
    if (threadIdx.x == 0) (void)xb_add(&bar[XB_XCNT(b.x)], 1u);
    return b;
}
DI void xcd_barrier_complete(unsigned* bar, unsigned x, unsigned& nloc, unsigned& nx) {
    const unsigned G = gridDim.x * gridDim.y * gridDim.z;
    unsigned sum, cnt, mine, sp = 0u;
    for (;;) {
        sum = 0u; cnt = 0u; mine = 0u;
#pragma unroll
        for (unsigned j = 0; j < 16; ++j) { const unsigned c = xb_ld(&bar[XB_XCNT(j)]); sum += c; cnt += (c > 0u) ? 1u : 0u; mine = (j == x) ? c : mine; }
        if (sum == G) break;
        __builtin_amdgcn_s_sleep(1);
        if ((++sp & 255u) == 0u) { if (xb_ld(&bar[XB_TMO])) break; if (sp > XB_SPIN_CAP) { atomicAdd(&bar[XB_TMO], 1u); break; } }
    }
    nloc = mine > 0u ? mine : 1u; nx = cnt > 0u ? cnt : 1u;
}
DI void xcd_barrier(const XcdBarrier& b) {
    asm volatile("s_waitcnt vmcnt(0)" ::: "memory");
    __syncthreads();
    if (threadIdx.x == 0) {
        unsigned* bar = b.bar;
        __builtin_amdgcn_s_waitcnt(0);
        unsigned nloc = b.st[0], nx = b.st[1];
        if (nloc == 0u) { xcd_barrier_complete(bar, b.x, nloc, nx); b.st[0] = nloc; b.st[1] = nx; }
        const unsigned old = xb_add(&bar[XB_XSUB(b.x)], 1u);
        const unsigned gen = old / nloc;
        if (old + 1u == (gen + 1u) * nloc) {
            __builtin_amdgcn_fence(__ATOMIC_RELEASE, "agent");
            asm volatile("s_waitcnt vmcnt(0)" ::: "memory");
            const unsigned og = xb_add(&bar[XB_TOP], 1u);
            const unsigned tg = og / nx;
            if (og + 1u == (tg + 1u) * nx) xb_add(&bar[XB_TOPGEN], 1u);
            else XB_SPIN(xb_ld(&bar[XB_TOPGEN]) == tg, bar);
            __builtin_amdgcn_fence(__ATOMIC_ACQUIRE, "agent");
            xb_add(&bar[XB_XGEN(b.x)], 1u);
            asm volatile("s_waitcnt vmcnt(0)" ::: "memory");
        } else {
            XB_SPIN(xb_ld(&bar[XB_XGEN(b.x)]) == gen, bar);
            __builtin_amdgcn_fence(__ATOMIC_ACQUIRE, "agent");
            asm volatile("s_waitcnt vmcnt(0)" ::: "memory");
        }
    }
    __syncthreads();
}

struct Params {
    const float* in[22];
    float* out;
    unsigned char* ws;
};

DI const float* kin(int i) {
    const __attribute__((address_space(4))) char* ka = (const __attribute__((address_space(4))) char*)__builtin_amdgcn_kernarg_segment_ptr();
    asm volatile("" : "+s"(ka));
    return *(const float* const __attribute__((address_space(4)))*)(ka + 8 * i);
}
struct Ctx;
DI void relaunder(Ctx& F);
struct Ctx {
    LAS unsigned char* lds;
    int tid, lane, wave, G, bid;
    float* out; unsigned char* ws;
};

DI void relaunder(Ctx& F) { int t = threadIdx.x; asm volatile("" : "+v"(t)); F.tid = t; F.lane = t & 63; F.wave = __builtin_amdgcn_readfirstlane(t >> 6); }

constexpr int TR_SCR = 64 * 65 * 4;
DI void transpose_item(const float* W, int ldw, int k0, int c0, int ncols, bf16_t* WT, int K, LAS float* scr, int lane, const float* kscale = nullptr) {
    const int r4 = lane >> 4, c4 = (lane & 15) * 4;
    f32x4 v[16];
#pragma unroll
    for (int i = 0; i < 16; ++i) { v[i] = (c4 < ncols) ? *(const f32x4*)(W + (size_t)(k0 + 4 * i + r4) * ldw + c0 + c4) : (f32x4){0.f, 0.f, 0.f, 0.f};
        if (kscale) v[i] = v[i] * kscale[4 * i + r4]; }
#pragma unroll
    for (int i = 0; i < 16; ++i) { LAS float* d = scr + (4 * i + r4) * 65 + c4; d[0] = v[i].x; d[1] = v[i].y; d[2] = v[i].z; d[3] = v[i].w; }
    lds_wait();
    const int c = lane & 7;
#pragma unroll
    for (int j = 0; j < 8; ++j) { const int n = (lane >> 3) + 8 * j; const LAS float* s = scr + (8 * c) * 65 + n;
        u32x4 o; o.x = cvt_pk_bf16(s[0 * 65], s[1 * 65]); o.y = cvt_pk_bf16(s[2 * 65], s[3 * 65]); o.z = cvt_pk_bf16(s[4 * 65], s[5 * 65]); o.w = cvt_pk_bf16(s[6 * 65], s[7 * 65]);
        if (n < ncols) *(u32x4*)(WT + (size_t)n * K + k0 + 8 * c) = o; }
    lds_wait();
}

DI void transpose_item_f8(const float* W, int ldw, int k0, int c0, unsigned char* WT, int KBy, LAS float* scr, int lane) {
    const int r4 = lane >> 4, c4 = (lane & 15) * 4;
    f32x4 v[16];
#pragma unroll
    for (int i = 0; i < 16; ++i) v[i] = *(const f32x4*)(W + (size_t)(k0 + 4 * i + r4) * ldw + c0 + c4);
#pragma unroll
    for (int i = 0; i < 16; ++i) { LAS float* d = scr + (4 * i + r4) * 65 + c4; d[0] = v[i].x; d[1] = v[i].y; d[2] = v[i].z; d[3] = v[i].w; }
    lds_wait();
    const int c = lane & 3;
#pragma unroll
    for (int j = 0; j < 4; ++j) { const int n = (lane >> 2) + 16 * j; const LAS float* s = scr + (16 * c) * 65 + n;
        u32x4 o;
        o.x = pk_fp8x4(s[0 * 65] * 32.f, s[1 * 65] * 32.f, s[2 * 65] * 32.f, s[3 * 65] * 32.f); o.y = pk_fp8x4(s[4 * 65] * 32.f, s[5 * 65] * 32.f, s[6 * 65] * 32.f, s[7 * 65] * 32.f);
        o.z = pk_fp8x4(s[8 * 65] * 32.f, s[9 * 65] * 32.f, s[10 * 65] * 32.f, s[11 * 65] * 32.f); o.w = pk_fp8x4(s[12 * 65] * 32.f, s[13 * 65] * 32.f, s[14 * 65] * 32.f, s[15 * 65] * 32.f);
        *(u32x4*)(WT + (size_t)n * KBy + k0 + 16 * c) = o; }
    lds_wait();
}

DI void ttab_item(const float* wf, float* TTAB, int item, const LAS float* trg  , int lane) {
    const int ib = item & 7, gc = item >> 3, g = gc & 7, cs = gc >> 3;
    const float* wfg = wf + (size_t)g * 4096;
    float wv[64];
#pragma unroll
    for (int m = 0; m < 64; ++m) wv[m] = wfg[m * 64 + lane];
#pragma unroll 1
    for (int ii = 0; ii < 8; ++ii) { const int i = ib * 8 + ii; float t = 0.f;
#pragma unroll
        for (int m = 0; m < 64; ++m) t += trg[2 * ((m * i) & 63) + cs] * wv[m];
        TTAB[((size_t)gc * 64 + i) * 64 + lane] = t; }
}
DI void fold_item(const float* w_in, const float* TTAB, bf16_t* Win_t, int item, LAS float* scr  , int lane) {
    const int kb = item & 15, gc = item >> 4, g = gc & 7, cs = gc >> 3;
    { const f32x4* tp = (const f32x4*)(TTAB + (size_t)gc * 4096) + lane;
#pragma unroll
      for (int i = 0; i < 16; ++i) *(LAS f32x4*)(scr + 4 * (lane + 64 * i)) = tp[64 * i]; }
    lds_wait();
    bf16_t* dst = Win_t + (size_t)(cs * 512 + g * 64 + lane) * DM + kb * 64;
#pragma unroll 1
    for (int k8 = 0; k8 < 8; ++k8) {
        float a[8], wv[8];
#pragma unroll
        for (int q = 0; q < 8; ++q) { a[q] = 0.f; wv[q] = w_in[(size_t)(kb * 64 + k8 * 8 + q) * DIN + g * 64 + lane]; }
#pragma unroll
        for (int i = 0; i < 64; ++i) { const float t = scr[i * 64 + lane];
#pragma unroll
            for (int q = 0; q < 8; ++q) a[q] += __builtin_bit_cast(float, __builtin_amdgcn_readlane(__builtin_bit_cast(int, wv[q]), i)) * t; }
        u32x4 o; o.x = cvt_pk_bf16(a[0], a[1]); o.y = cvt_pk_bf16(a[2], a[3]); o.z = cvt_pk_bf16(a[4], a[5]); o.w = cvt_pk_bf16(a[6], a[7]);
        *(u32x4*)(dst + k8 * 8) = o;
    }
    lds_wait();
}

DI void phase0(Ctx& F) {
    relaunder(F);
    const float* c = kin(1); const float* c_ctx = kin(3); const float* w_ada = kin(4); const float* b_ada = kin(5);
    float* MOD = (float*)(F.ws + WS_MOD);
    if (F.bid < 96) {
        LAS float* SC = (LAS float*)F.lds;
        LAS float* RED = (LAS float*)(F.lds + 9 * 1024 * 4);
        for (int i = F.tid; i < 9 * 1024; i += 512) { const float v = (i < 8192) ? c[i] : c_ctx[i - 8192]; SC[i] = silu_f(v); }
        __syncthreads();
        for (int u = F.bid; u < 96; u += F.G) {
            const int n = u * 64 + F.lane;
            float a[9];
#pragma unroll
            for (int b = 0; b < 9; ++b) a[b] = 0.f;
            const float* wp = w_ada + (size_t)(F.wave * 128) * 6144 + n;
#pragma unroll 4
            for (int k = 0; k < 128; ++k) { const float w = wp[(size_t)k * 6144];
#pragma unroll
                for (int b = 0; b < 9; ++b) a[b] += SC[b * 1024 + F.wave * 128 + k] * w; }
#pragma unroll
            for (int b = 0; b < 9; ++b) RED[(F.wave * 9 + b) * 64 + F.lane] = a[b];
            __syncthreads();
            for (int i = F.tid; i < 9 * 64; i += 512) { float s = 0.f;
#pragma unroll
                for (int w = 0; w < 8; ++w) s += RED[w * 576 + i];
                const int b = i >> 6, nn = u * 64 + (i & 63); MOD[b * 6144 + nn] = s + b_ada[nn]; }
            __syncthreads();
        }
    }
    __syncthreads();
    LAS float* scr = (LAS float*)(F.lds + F.wave * TR_SCR);
    LAS float* trg = (LAS float*)(F.lds + 8 * TR_SCR);
    if (F.tid < 64) { float s, c; sincospif((float)F.tid * (1.f / 32.f), &s, &c); trg[2 * F.tid] = c; trg[2 * F.tid + 1] = s; }
    __syncthreads();
    const int gw = F.bid * 8 + F.wave, NGW = F.G * 8;
    const float* w_in = kin(7); const float* w_out = kin(15); const float* wf = kin(14);
    bf16_t* Win_t = (bf16_t*)(F.ws + WS_WIN); bf16_t* Wout_t = (bf16_t*)(F.ws + WS_WOUT);
    float* TTAB = (float*)(F.ws + WS_SS);
    constexpr int I_IN = 16 * 73, I_OUT = 32 * 16, I_FOLD = 128, I_ZERO = 208;
    for (int it = gw; it < I_IN + I_OUT + I_FOLD + I_ZERO; it += NGW) {
        int r = it;
        if (r < I_FOLD) { ttab_item(wf, TTAB, r, trg, F.lane); continue; } r -= I_FOLD;
        if (r < I_IN) { const int kb = r / 73, nb = r % 73; const int ncols = (nb == 72) ? 48 : 64;
            transpose_item(w_in, DIN, kb * 64, nb * 64, ncols, Win_t + (size_t)(nb * 64) * DM, DM, scr, F.lane); continue; } r -= I_IN;
        if (r < I_OUT) { const int kb = r / 16, nb = r % 16; transpose_item(w_out, DM, kb * 64, nb * 64, 64, Wout_t + (size_t)(nb * 64) * DMIX, DMIX, scr, F.lane, kb >= 8 ? kin(13) + (kb * 64 - 512) : nullptr); continue; }
        { u32x4 z = {0u, 0u, 0u, 0u}; u32x4* p = (u32x4*)(Win_t + (size_t)(4656 + r) * DM); p[F.lane] = z; p[F.lane + 64] = z; }
    }
}

DI void phase_h(Ctx& F) {
    relaunder(F);
    const float* x = kin(0); const float* ctx = kin(2); const float* nw = kin(6);
    const float* MOD = (const float*)(F.ws + WS_MOD);
    bf16_t* HALL = (bf16_t*)(F.ws + WS_R1);
    const int gw = F.bid * 8 + F.wave, NGW = F.G * 8;
    f32x4 nx[4];
    if (gw < NROWS) { const f32x4* xr = (const f32x4*)((gw < NTOK) ? x + (size_t)gw * DM : ctx + (size_t)(gw - NTOK) * DM) + F.lane;
#pragma unroll
        for (int j = 0; j < 4; ++j) nx[j] = xr[64 * j]; }
    for (int m = gw; m < NROWS; m += NGW) {
        const int b = (m < NTOK) ? (m >> 12) : 8;
        f32x4 v[4]; float s = 0.f;
#pragma unroll
        for (int j = 0; j < 4; ++j) v[j] = nx[j];
        { const int mn = m + NGW;
          if (mn < NROWS) { const f32x4* xr = (const f32x4*)((mn < NTOK) ? x + (size_t)mn * DM : ctx + (size_t)(mn - NTOK) * DM) + F.lane;
#pragma unroll
            for (int j = 0; j < 4; ++j) nx[j] = xr[64 * j]; } }
#pragma unroll
        for (int j = 0; j < 4; ++j) s += (v[j].x * v[j].x + v[j].y * v[j].y) + (v[j].z * v[j].z + v[j].w * v[j].w);
        const float rstd = rsqrtf(wave_sum(s) * (1.f / DM) + 1e-6f);
        const f32x4* w4 = (const f32x4*)nw + F.lane; const f32x4* sh4 = (const f32x4*)(MOD + b * 6144) + F.lane; const f32x4* sc4 = (const f32x4*)(MOD + b * 6144 + 1024) + F.lane;
        u32x2* o = (u32x2*)(HALL + (size_t)m * DM) + F.lane;
#pragma unroll
        for (int j = 0; j < 4; ++j) { const f32x4 w = w4[64 * j], sh = sh4[64 * j], sc = sc4[64 * j];
            const f32x4 h = (v[j] * rstd * w) * (sc + 1.f) + sh;
            u32x2 p; p.x = cvt_pk_bf16(h.x, h.y); p.y = cvt_pk_bf16(h.z, h.w); o[64 * j] = p; }
    }
}

struct EpiInProj {
    static constexpr bool PERM = true;
    bf16_t* FIN; bf16_t* ZS; bf16_t* XBC; float* DT; const float* dt_bias;
    DI void operator()(const f32x4 (&acc)[2][2][4][2], const pg8::Unit& u, int wr, int wc, int fr, int fq) const {
        const int row0 = u.pm * 256 + wr * 64 + fr, cl = wc * 32 + 8 * fq;
        if (u.pn < 18) {
            bf16_t* base; int ld, c0; bool act = false;
            if (u.pn < 2) { base = FIN; ld = 512; c0 = u.pn * 256; }
            else if (u.pn < 8) { base = ZS; ld = DSSM; c0 = (u.pn - 2) * 256; act = true; }
            else { base = XBC; ld = CONVD; c0 = (u.pn - 8) * 256; }
#pragma unroll
            for (int ai = 0; ai < 2; ++ai)
#pragma unroll
                for (int m = 0; m < 4; ++m) { bf16_t* rowp = base + (size_t)(row0 + ai * 128 + m * 16) * ld + c0 + cl;
#pragma unroll
                    for (int bj = 0; bj < 2; ++bj) { f32x4 v0 = acc[ai][bj][m][0], v1 = acc[ai][bj][m][1];
                        if (act) {
#pragma unroll
                            for (int j = 0; j < 4; ++j) { v0[j] = silu_f(v0[j]); v1[j] = silu_f(v1[j]); } }
                        u32x4 w; w.x = cvt_pk_bf16(v0[0], v0[1]); w.y = cvt_pk_bf16(v0[2], v0[3]); w.z = cvt_pk_bf16(v1[0], v1[1]); w.w = cvt_pk_bf16(v1[2], v1[3]);
                        *(u32x4*)(rowp + bj * 128) = w; } }
        } else if (cl < 48) {
            float bia[8];
#pragma unroll
            for (int q = 0; q < 8; ++q) bia[q] = dt_bias[cl + q];
#pragma unroll
            for (int ai = 0; ai < 2; ++ai)
#pragma unroll
                for (int m = 0; m < 4; ++m) { float* rowp = DT + (size_t)(row0 + ai * 128 + m * 16) * 48 + cl;
                    f32x4 o0, o1;
#pragma unroll
                    for (int j = 0; j < 4; ++j) { o0[j] = softplus_f(acc[ai][0][m][0][j] + bia[j]); o1[j] = softplus_f(acc[ai][0][m][1][j] + bia[4 + j]); }
                    *(f32x4*)rowp = o0; *(f32x4*)(rowp + 4) = o1; }
        }
    }
};

constexpr int FT_T = 0;
constexpr int FT_TAB = 73728;
constexpr int FT_TW = FT_TAB + 128 * 272;
constexpr int FT_TR = FT_TW + 512;
constexpr int F1_U = 0, F1_TT = 64 * 528, F1_TAB = F1_TT + 8 * 64 * 144, F1_TW = F1_TAB + 128 * 272, F1_TR = F1_TW + 512;
static_assert(F1_TR + 512 <= LDS_BYTES - 32, "FFT step 1 LDS layout");

DI bf16x8 tr_read2(unsigned a0, unsigned a1) {
    s16x4 lo, hi;
    asm volatile("ds_read_b64_tr_b16 %0, %2\n\tds_read_b64_tr_b16 %1, %3\n\ts_waitcnt lgkmcnt(0)" : "=&v"(lo), "=&v"(hi) : "v"(a0), "v"(a1) : "memory");
    return __builtin_shufflevector(lo, hi, 0, 1, 2, 3, 4, 5, 6, 7);
}
DI int crow(int reg, int h) { return (reg & 3) + 8 * (reg >> 2) + 4 * h; }

DI void fft_step1(Ctx& F) {
    relaunder(F);
    const bf16_t* FIN = (const bf16_t*)(F.ws + WS_R2); bf16_t* A1 = (bf16_t*)(F.ws + WS_R1); const float* TTAB = (const float*)(F.ws + WS_SS);
    LAS unsigned char* lds = F.lds;
    LAS float* TR = (LAS float*)(lds + F1_TR);
    const int chh = F.bid & 1;
    if (F.tid < 64) { float s, c; sincospif((float)F.tid * (1.f / 32.f), &s, &c); TR[2 * F.tid] = c; TR[2 * F.tid + 1] = s; }
    __syncthreads();
    for (int i = F.tid; i < 128 * 128; i += 512) { const int m = i >> 7, k = i & 127, ri = m >> 6, k1 = m & 63, cs = k >> 6, l1 = k & 63, t = (k1 * l1) & 63;
        const float c = TR[2 * t], s = TR[2 * t + 1]; const float v = (ri == 0) ? (cs == 0 ? c : -s) : (cs == 0 ? -s : -c);
        *(LAS bf16_t*)(lds + F1_TAB + m * 272 + k * 2) = f2bf(v); }
    for (int idx = F.tid; idx < 8 * 64 * 64; idx += 512) { const int j = idx & 63, i = (idx >> 6) & 63, gc = idx >> 12, gg = gc >> 1, cs = gc & 1;
        const float v = TTAB[((size_t)(cs * 8 + 4 * chh + gg) * 64 + i) * 64 + j];
        *(LAS bf16_t*)(lds + F1_TT + ((gg * 2 + cs) * 64 + j) * 144 + i * 2) = f2bf(v); }
    __syncthreads();
    const int lane = F.lane, w = F.wave, h = lane >> 5, c31 = lane & 31, gg = w >> 1, jb = w & 1;
    u32x4 pfv[4];
    if (F.bid < NB * 64 * 2) { const int u = F.bid, l2 = (u >> 1) & 63, b = u >> 7;
#pragma unroll
        for (int i = 0; i < 4; ++i) { const int idx = F.tid + 512 * i, row = idx >> 5, c16 = idx & 31;
            pfv[i] = *(const u32x4*)(FIN + (size_t)(b * SEQ + 64 * row + l2) * 512 + chh * 256 + c16 * 8); } }
    for (int u = F.bid; u < NB * 64 * 2; u += F.G) {
        const int l2 = (u >> 1) & 63, b = u >> 7;
        LAS float* TW = (LAS float*)(lds + F1_TW);
        if (F.tid < 64) { float s, c; sincospif((float)(F.tid * l2) * (1.f / 2048.f), &s, &c); TW[2 * F.tid] = c; TW[2 * F.tid + 1] = s; }
#pragma unroll
        for (int i = 0; i < 4; ++i) { const int idx = F.tid + 512 * i, row = idx >> 5, c16 = idx & 31; *(LAS u32x4*)(lds + F1_U + row * 528 + c16 * 16) = pfv[i]; }
        __syncthreads();
        { const int un = u + F.G;
          if (un < NB * 64 * 2) { const int l2n = (un >> 1) & 63, bn = un >> 7;
#pragma unroll
            for (int i = 0; i < 4; ++i) { const int idx = F.tid + 512 * i, row = idx >> 5, c16 = idx & 31;
                pfv[i] = *(const u32x4*)(FIN + (size_t)(bn * SEQ + 64 * row + l2n) * 512 + chh * 256 + c16 * 8); } } }
        f32x16 px[2][2];
#pragma unroll
        for (int rb = 0; rb < 2; ++rb)
#pragma unroll
            for (int cs = 0; cs < 2; ++cs) {
#pragma unroll
                for (int i = 0; i < 16; ++i) px[rb][cs][i] = 0.f;
#pragma unroll
                for (int ks = 0; ks < 4; ++ks) {
                    const bf16x8 af = *(const LAS bf16x8*)(lds + F1_U + (32 * rb + c31) * 528 + (gg * 64 + 16 * ks + 8 * h) * 2);
                    const bf16x8 bf = *(const LAS bf16x8*)(lds + F1_TT + ((gg * 2 + cs) * 64 + 32 * jb + c31) * 144 + (16 * ks + 8 * h) * 2);
                    px[rb][cs] = __builtin_amdgcn_mfma_f32_32x32x16_bf16(af, bf, px[rb][cs], 0, 0, 0);
                }
            }
        f32x16 acc[4];
#pragma unroll
        for (int rbo = 0; rbo < 4; ++rbo)
#pragma unroll
            for (int i = 0; i < 16; ++i) acc[rbo][i] = 0.f;
#pragma unroll
        for (int cs = 0; cs < 2; ++cs)
#pragma unroll
            for (int rb = 0; rb < 2; ++rb)
#pragma unroll
                for (int s2 = 0; s2 < 2; ++s2) {
                    u32x4 bw; bw.x = cvt_pk_bf16(px[rb][cs][8 * s2], px[rb][cs][8 * s2 + 1]); bw.y = cvt_pk_bf16(px[rb][cs][8 * s2 + 2], px[rb][cs][8 * s2 + 3]);
                    bw.z = cvt_pk_bf16(px[rb][cs][8 * s2 + 4], px[rb][cs][8 * s2 + 5]); bw.w = cvt_pk_bf16(px[rb][cs][8 * s2 + 6], px[rb][cs][8 * s2 + 7]);
                    const bf16x8 bfr = __builtin_bit_cast(bf16x8, bw);
                    const int kc = cs * 64 + 32 * rb + 16 * s2 + 4 * h;
#pragma unroll
                    for (int rbo = 0; rbo < 4; ++rbo) {
                        const LAS unsigned char* ap = lds + F1_TAB + (32 * rbo + c31) * 272 + kc * 2;
                        const u32x2 lo = *(const LAS u32x2*)ap, hi = *(const LAS u32x2*)(ap + 16);
                        const u32x4 aw = {lo.x, lo.y, hi.x, hi.y};
                        acc[rbo] = __builtin_amdgcn_mfma_f32_32x32x16_bf16(__builtin_bit_cast(bf16x8, aw), bfr, acc[rbo], 0, 0, 0);
                    }
                }
        const int ch = chh * 256 + 32 * w + c31;
#pragma unroll
        for (int rb = 0; rb < 2; ++rb)
#pragma unroll
            for (int r = 0; r < 16; ++r) { const int k1 = 32 * rb + crow(r, h); const float ct = TW[2 * k1], st = TW[2 * k1 + 1];
                const float ar = acc[rb][r], ai = acc[rb + 2][r];
                const float orr = (ar * ct + ai * st) * (1.f / 64.f), oi = (ai * ct - ar * st) * (1.f / 64.f);
                bf16_t* dst = A1 + ((size_t)((b * 64 + k1) * 2) * 64 + l2) * 512 + ch;
                dst[0] = f2bf(orr); dst[(size_t)64 * 512] = f2bf(oi); }
        __syncthreads();
    }
}

DI void fft_step2(Ctx& F) {
    relaunder(F);
    const bf16_t* A1 = (const bf16_t*)(F.ws + WS_R1); bf16_t* AO = (bf16_t*)(F.ws + WS_R4);
    LAS unsigned char* lds = F.lds;
    LAS float* TR = (LAS float*)(lds + FT_TR);
    if (F.tid < 64) { float s, c; sincospif((float)F.tid * (1.f / 32.f), &s, &c); TR[2 * F.tid] = c; TR[2 * F.tid + 1] = s; }
    __syncthreads();
    for (int i = F.tid; i < 64 * 128; i += 512) { const int k2 = i >> 7, k = i & 127, ri = k >> 6, l2 = k & 63, t = (k2 * l2) & 63;
        *(LAS bf16_t*)(lds + FT_TAB + k2 * 272 + k * 2) = f2bf(ri ? TR[2 * t + 1] : TR[2 * t]); }
    __syncthreads();
    const int lane = F.lane, w = F.wave, h = lane >> 5, blk = (lane >> 4) & 1, q = (lane & 15) >> 2, p = lane & 3;
    const unsigned tbase = (unsigned)(size_t)(lds + FT_T);
    for (int u = F.bid; u < NB * 64 * 2; u += F.G) {
        const int chh = u & 1, k1 = (u >> 1) & 63, b = u >> 7;
#pragma unroll
        for (int i = 0; i < 8; ++i) { const int idx = F.tid + 512 * i, row = idx >> 5, c16 = idx & 31;
            const u32x4 v = *(const u32x4*)(A1 + ((size_t)(b * 64 + k1) * 128 + row) * 512 + chh * 256 + c16 * 8);
            *(LAS u32x4*)(lds + FT_T + row * 576 + c16 * 16) = v; }
        __syncthreads();
        f32x16 acc[2];
#pragma unroll
        for (int rb = 0; rb < 2; ++rb)
#pragma unroll
            for (int i = 0; i < 16; ++i) acc[rb][i] = 0.f;
#pragma unroll
        for (int ks = 0; ks < 8; ++ks) {
            const unsigned a0 = tbase + (unsigned)((16 * ks + 8 * h + q) * 576 + (32 * w + 16 * blk + 4 * p) * 2);
            const bf16x8 bfrag = tr_read2(a0, a0 + 4 * 576);
#pragma unroll
            for (int rb = 0; rb < 2; ++rb) { const bf16x8 afrag = *(const LAS bf16x8*)(lds + FT_TAB + (32 * rb + (lane & 31)) * 272 + (16 * ks + 8 * h) * 2);
                acc[rb] = __builtin_amdgcn_mfma_f32_32x32x16_bf16(afrag, bfrag, acc[rb], 0, 0, 0); }
        }
        const int ch = chh * 256 + 32 * w + (lane & 31);
#pragma unroll
        for (int rb = 0; rb < 2; ++rb)
#pragma unroll
            for (int r = 0; r < 16; ++r) { const int k2 = 32 * rb + crow(r, h);
                AO[(size_t)(b * SEQ + k1 + 64 * k2) * DMIX + ch] = f2bf(acc[rb][r] * 0.125f); }
        __syncthreads();
    }
}

constexpr int CV_B = 0, CV_C = 128 * 272;
DI void unpack8(const u32x4 v, float (&f)[8]) {
    f[0] = __uint_as_float(v.x << 16); f[1] = __uint_as_float(v.x & 0xffff0000u); f[2] = __uint_as_float(v.y << 16); f[3] = __uint_as_float(v.y & 0xffff0000u);
    f[4] = __uint_as_float(v.z << 16); f[5] = __uint_as_float(v.z & 0xffff0000u); f[6] = __uint_as_float(v.w << 16); f[7] = __uint_as_float(v.w & 0xffff0000u);
}
DI void conv_cb_phase(Ctx& F) {
    relaunder(F);
    const bf16_t* XBC = (const bf16_t*)(F.ws + WS_R4);
    bf16_t* XS = (bf16_t*)(F.ws + WS_XS); bf16_t* BMg = (bf16_t*)(F.ws + WS_BM); bf16_t* CMg = (bf16_t*)(F.ws + WS_CM); bf16_t* CBG = (bf16_t*)(F.ws + WS_CB);
    const float* conv_w = kin(8); const float* conv_b = kin(9);
    LAS unsigned char* lds = F.lds;
    const int lane = F.lane, h = lane >> 5;
    for (int u = F.bid; u < NB * 34 * NG; u += F.G) {
        const int g = u & 3, c = (u >> 2) % 34, b = (u >> 2) / 34;
        const bool lat = c < 32;
        const int seqbase = lat ? b * SEQ : NTOK + b * CTXL, L = lat ? SEQ : CTXL, t0 = lat ? c * 128 : (c - 32) * 128;
#pragma unroll
        for (int pass = 0; pass < 2; ++pass) {
            constexpr int NT0 = 16, NT1 = 4;
            const int NT = pass == 0 ? NT0 : NT1;
            int chunk, seg;
            if (pass == 0) { chunk = F.tid & 63; seg = F.tid >> 6; } else { chunk = 64 + (F.tid & 15); seg = F.tid >> 4; }
            int scol, dcol, kind;
            if (chunk < 48) { kind = 0; scol = g * 384 + chunk * 8; dcol = scol; }
            else if (chunk < 64) { kind = 1; dcol = g * 128 + (chunk - 48) * 8; scol = 1536 + dcol; }
            else { kind = 2; dcol = g * 128 + (chunk - 64) * 8; scol = 2048 + dcol; }
            const int tb = t0 + seg * NT;
            u32x4 raw[NT0 + 4];
#pragma unroll
            for (int k = 0; k < NT0 + 4; ++k) if (k < NT + 4) { const int t = tb - 2 + k; u32x4 v = {0u, 0u, 0u, 0u};
                if (t >= 0 && t < L) v = *(const u32x4*)(XBC + (size_t)(seqbase + t) * CONVD + scol);
                raw[k] = v; }
            float w[5][8], bias[8];
#pragma unroll
            for (int k = 0; k < 5; ++k) { const f32x4 a = *(const f32x4*)(conv_w + k * CONVD + scol), bb = *(const f32x4*)(conv_w + k * CONVD + scol + 4);
                w[k][0] = a.x; w[k][1] = a.y; w[k][2] = a.z; w[k][3] = a.w; w[k][4] = bb.x; w[k][5] = bb.y; w[k][6] = bb.z; w[k][7] = bb.w; }
            { const f32x4 a = *(const f32x4*)(conv_b + scol), bb = *(const f32x4*)(conv_b + scol + 4);
              bias[0] = a.x; bias[1] = a.y; bias[2] = a.z; bias[3] = a.w; bias[4] = bb.x; bias[5] = bb.y; bias[6] = bb.z; bias[7] = bb.w; }
            float win[5][8];
#pragma unroll
            for (int k = 0; k < 4; ++k) unpack8(raw[k], win[k]);
#pragma unroll
            for (int j = 0; j < NT0; ++j) if (j < NT) {
                unpack8(raw[j + 4], win[4]);
                float o[8];
#pragma unroll
                for (int e = 0; e < 8; ++e) { float a = bias[e];
#pragma unroll
                    for (int k = 0; k < 5; ++k) a += w[k][e] * win[k][e];
                    o[e] = silu_f(a); }
                u32x4 pk; pk.x = cvt_pk_bf16(o[0], o[1]); pk.y = cvt_pk_bf16(o[2], o[3]); pk.z = cvt_pk_bf16(o[4], o[5]); pk.w = cvt_pk_bf16(o[6], o[7]);
                const size_t row = (size_t)(seqbase + tb + j); const int tl = seg * NT + j;
                (void)row;
                if (kind == 0) *(u32x4*)(XS + ((size_t)((b * 34 + c) * NH + g * 6 + (chunk >> 3)) * 128 + tl) * 64 + (chunk & 7) * 8) = pk;
                else if (kind == 1) { *(u32x4*)(BMg + ((size_t)((b * 34 + c) * NG + g) * 128 + tl) * 128 + (chunk - 48) * 8) = pk; *(LAS u32x4*)(lds + CV_B + tl * 272 + (chunk - 48) * 16) = pk; }
                else { *(u32x4*)(CMg + ((size_t)((b * 34 + c) * NG + g) * 128 + tl) * 128 + (chunk - 64) * 8) = pk; *(LAS u32x4*)(lds + CV_C + tl * 272 + (chunk - 64) * 16) = pk; }
#pragma unroll
                for (int k = 0; k < 4; ++k)
#pragma unroll
                    for (int e = 0; e < 8; ++e) win[k][e] = win[k + 1][e];
            }
        }
        if (F.wave < 6) {
            const int hd = 6 * g + F.wave; const float a_f = -__expf(kin(11)[hd]), a_b = -__expf(kin(11)[24 + hd]);
            const float* DT = (const float*)(F.ws + WS_R5); float* AR = (float*)(F.ws + WS_ARRS) + (size_t)((b * 34 + c) * NH + hd) * 768;
            const size_t r0 = (size_t)(seqbase + t0);
            {
                const float d0 = DT[(r0 + 2 * lane) * 48 + hd], d1 = DT[(r0 + 2 * lane + 1) * 48 + hd], v0 = d0 * a_f, v1 = d1 * a_f; float s = v0 + v1;
#pragma unroll
                for (int o = 1; o < 64; o <<= 1) { const float t = __shfl_up(s, o); if (lane >= o) s += t; }
                const float ex = s - (v0 + v1), A0 = ex + v0, A1 = ex + v0 + v1, tot = __shfl(s, 63);
                *(f32v2*)(AR + 2 * lane) = (f32v2){A0, A1}; *(f32v2*)(AR + 128 + 2 * lane) = (f32v2){__logf(d0) - A0, __logf(d1) - A1};
                *(f32v2*)(AR + 256 + 2 * lane) = (f32v2){d0 * __expf(tot - A0), d1 * __expf(tot - A1)};
            }
            {
                const int e0 = 127 - 2 * lane, e1 = 126 - 2 * lane;
                const float d0 = DT[(r0 + e0) * 48 + 24 + hd], d1 = DT[(r0 + e1) * 48 + 24 + hd], v0 = d0 * a_b, v1 = d1 * a_b; float s = v0 + v1;
#pragma unroll
                for (int o = 1; o < 64; o <<= 1) { const float t = __shfl_up(s, o); if (lane >= o) s += t; }
                const float ex = s - (v0 + v1), A0 = ex + v0, A1 = ex + v0 + v1, tot = __shfl(s, 63);
                *(f32v2*)(AR + 384 + e1) = (f32v2){A1, A0}; *(f32v2*)(AR + 512 + e1) = (f32v2){__logf(d1) - A1, __logf(d0) - A0};
                *(f32v2*)(AR + 640 + e1) = (f32v2){d1 * __expf(tot - A1), d0 * __expf(tot - A0)};
            }
        }
        __syncthreads();
        if (lat) {
#pragma unroll
            for (int bi = 0; bi < 2; ++bi) {
                const int blk = 2 * F.wave + bi, sb = blk >> 2, lb = blk & 3;
                f32x16 acc;
#pragma unroll
                for (int i = 0; i < 16; ++i) acc[i] = 0.f;
#pragma unroll
                for (int ks = 0; ks < 8; ++ks) {
                    const bf16x8 af = *(const LAS bf16x8*)(lds + CV_B + (32 * sb + (lane & 31)) * 272 + (16 * ks + 8 * h) * 2);
                    const bf16x8 bf = *(const LAS bf16x8*)(lds + CV_C + (32 * lb + (lane & 31)) * 272 + (16 * ks + 8 * h) * 2);
                    acc = __builtin_amdgcn_mfma_f32_32x32x16_bf16(af, bf, acc, 0, 0, 0);
                }
                u32x4 o0, o1;
                o0.x = cvt_pk_bf16(acc[0], acc[1]); o0.y = cvt_pk_bf16(acc[2], acc[3]); o0.z = cvt_pk_bf16(acc[4], acc[5]); o0.w = cvt_pk_bf16(acc[6], acc[7]);
                o1.x = cvt_pk_bf16(acc[8], acc[9]); o1.y = cvt_pk_bf16(acc[10], acc[11]); o1.z = cvt_pk_bf16(acc[12], acc[13]); o1.w = cvt_pk_bf16(acc[14], acc[15]);
                u32x4* dst = (u32x4*)(CBG + ((size_t)(((b * 32 + c) * 4 + g) * 16 + blk) * 64 + lane) * 16);
                dst[0] = o0; dst[1] = o1;
            }
        }
        __syncthreads();
    }
}

constexpr int SD_C = 0;
constexpr int SD_B = SD_C + 128 * 272;
constexpr int SD_X = SD_B + 128 * 288;
constexpr int SD_XW = SD_X + 128 * 192;
constexpr int SD_H = SD_XW + 128 * 192;
constexpr int SD_ARR = SD_H + 64 * 272;
constexpr int SD_Y = SD_ARR + 8 * 512;
static_assert(SD_Y + 128 * 144 <= LDS_BYTES - 16, "SSD LDS layout");
DI float bflo(unsigned w) { return __uint_as_float(w << 16); }
DI float bfhi(unsigned w) { return __uint_as_float(w & 0xffff0000u); }
DI void tr_read4(unsigned a0, unsigned a1, unsigned b0, unsigned b1, bf16x8& fa, bf16x8& fb) {
    s16x4 alo, ahi, blo, bhi;
    asm volatile("ds_read_b64_tr_b16 %0, %4\n\tds_read_b64_tr_b16 %1, %5\n\tds_read_b64_tr_b16 %2, %6\n\tds_read_b64_tr_b16 %3, %7\n\ts_waitcnt lgkmcnt(0)"
                 : "=&v"(alo), "=&v"(ahi), "=&v"(blo), "=&v"(bhi) : "v"(a0), "v"(a1), "v"(b0), "v"(b1) : "memory");
    fa = __builtin_shufflevector(alo, ahi, 0, 1, 2, 3, 4, 5, 6, 7); fb = __builtin_shufflevector(blo, bhi, 0, 1, 2, 3, 4, 5, 6, 7);
}
DI void tr_read_state4(unsigned b0, unsigned b1, s16x4 (&o)[16]) {
    asm volatile("ds_read_b64_tr_b16 %0, %16 offset:0\n\tds_read_b64_tr_b16 %1, %16 offset:768\n\tds_read_b64_tr_b16 %2, %17 offset:0\n\tds_read_b64_tr_b16 %3, %17 offset:1152\n\tds_read_b64_tr_b16 %4, %16 offset:3072\n\tds_read_b64_tr_b16 %5, %16 offset:3840\n\tds_read_b64_tr_b16 %6, %17 offset:4608\n\tds_read_b64_tr_b16 %7, %17 offset:5760\n\tds_read_b64_tr_b16 %8, %16 offset:6144\n\tds_read_b64_tr_b16 %9, %16 offset:6912\n\tds_read_b64_tr_b16 %10, %17 offset:9216\n\tds_read_b64_tr_b16 %11, %17 offset:10368\n\tds_read_b64_tr_b16 %12, %16 offset:9216\n\tds_read_b64_tr_b16 %13, %16 offset:9984\n\tds_read_b64_tr_b16 %14, %17 offset:13824\n\tds_read_b64_tr_b16 %15, %17 offset:14976\n\ts_waitcnt lgkmcnt(0)"
                 : "=&v"(o[0]), "=&v"(o[1]), "=&v"(o[2]), "=&v"(o[3]), "=&v"(o[4]), "=&v"(o[5]), "=&v"(o[6]), "=&v"(o[7]), "=&v"(o[8]), "=&v"(o[9]), "=&v"(o[10]), "=&v"(o[11]), "=&v"(o[12]), "=&v"(o[13]), "=&v"(o[14]), "=&v"(o[15]) : "v"(b0), "v"(b1) : "memory");
}
DI void tr_read_diag16(unsigned b0, unsigned b1, unsigned b2, unsigned b3, s16x4 (&o)[16]) {
    asm volatile("ds_read_b64_tr_b16 %0, %16 offset:0\n\tds_read_b64_tr_b16 %1, %16 offset:1536\n\tds_read_b64_tr_b16 %2, %16 offset:3072\n\tds_read_b64_tr_b16 %3, %16 offset:4608\n\tds_read_b64_tr_b16 %4, %17 offset:0\n\tds_read_b64_tr_b16 %5, %17 offset:1536\n\tds_read_b64_tr_b16 %6, %17 offset:3072\n\tds_read_b64_tr_b16 %7, %17 offset:4608\n\tds_read_b64_tr_b16 %8, %18 offset:0\n\tds_read_b64_tr_b16 %9, %18 offset:1536\n\tds_read_b64_tr_b16 %10, %18 offset:3072\n\tds_read_b64_tr_b16 %11, %18 offset:4608\n\tds_read_b64_tr_b16 %12, %19 offset:0\n\tds_read_b64_tr_b16 %13, %19 offset:1536\n\tds_read_b64_tr_b16 %14, %19 offset:3072\n\tds_read_b64_tr_b16 %15, %19 offset:4608\n\ts_waitcnt lgkmcnt(0)"
                 : "=&v"(o[0]), "=&v"(o[1]), "=&v"(o[2]), "=&v"(o[3]), "=&v"(o[4]), "=&v"(o[5]), "=&v"(o[6]), "=&v"(o[7]), "=&v"(o[8]), "=&v"(o[9]), "=&v"(o[10]), "=&v"(o[11]), "=&v"(o[12]), "=&v"(o[13]), "=&v"(o[14]), "=&v"(o[15]) : "v"(b0), "v"(b1), "v"(b2), "v"(b3) : "memory");
}
DI void tr_read_diag8(unsigned b0, unsigned b1, s16x4 (&o)[8]) {
    asm volatile("ds_read_b64_tr_b16 %0, %8 offset:0\n\tds_read_b64_tr_b16 %1, %8 offset:1536\n\tds_read_b64_tr_b16 %2, %8 offset:3072\n\tds_read_b64_tr_b16 %3, %8 offset:4608\n\tds_read_b64_tr_b16 %4, %9 offset:0\n\tds_read_b64_tr_b16 %5, %9 offset:1536\n\tds_read_b64_tr_b16 %6, %9 offset:3072\n\tds_read_b64_tr_b16 %7, %9 offset:4608\n\ts_waitcnt lgkmcnt(0)"
                 : "=&v"(o[0]), "=&v"(o[1]), "=&v"(o[2]), "=&v"(o[3]), "=&v"(o[4]), "=&v"(o[5]), "=&v"(o[6]), "=&v"(o[7]) : "v"(b0), "v"(b1) : "memory");
}
struct SsdPF { u32x4 c[4], b[4], x[2], yz[4]; float w[2]; f32v2 arr; };

DI void ssd_unit(Ctx& F, const int b, const int hd) {
    relaunder(F);
    const bf16_t* XS = (const bf16_t*)(F.ws + WS_XS); const bf16_t* BMg = (const bf16_t*)(F.ws + WS_BM); const bf16_t* CMg = (const bf16_t*)(F.ws + WS_CM);
    const bf16_t* CBG = (const bf16_t*)(F.ws + WS_CB); const float* ARRS = (const float*)(F.ws + WS_ARRS);
    bf16_t* AO = (bf16_t*)(F.ws + WS_R4); const bf16_t* ZS = (const bf16_t*)F.out; float* SS = (float*)(F.ws + WS_SS);
    LAS unsigned char* lds = F.lds;
    LAS float* ARR = (LAS float*)(lds + SD_ARR);
    LAS float *AF = ARR, *LF = ARR + 128, *ABS = ARR + 384, *LB = ARR + 512, *SSP = ARR + 768;
    const int g = hd / 6, tid = F.tid, lane = F.lane, wave = F.wave;
    const int pb = wave >> 2, lb = wave & 3, h = lane >> 5, blk = (lane >> 4) & 1, q = (lane & 15) >> 2, pp = lane & 3, c31 = lane & 31;
    const float dsk = kin(12)[hd];
    const unsigned xbase = (unsigned)(size_t)(lds + SD_X), xwbase = (unsigned)(size_t)(lds + SD_XW), bbase = (unsigned)(size_t)(lds + SD_B);
    const int l = 32 * lb + c31;
#define SSD_CHUNK(dir_, step_) ((dir_) == 0 ? ((step_) >= 2 ? (step_) - 2 : 32 + (step_)) : 33 - (step_))
#define SSD_ROW0(c_) (((c_) < 32) ? b * SEQ + (c_) * 128 : NTOK + b * CTXL + ((c_) - 32) * 128)
#define SSD_ISSUE(pf, dir_, step_) do { const int c_ = SSD_CHUNK(dir_, step_), row0_ = SSD_ROW0(c_); const bool lat_ = (step_) >= 2; \
        const float* ar_ = ARRS + (size_t)((b * 34 + c_) * NH + hd) * 768; \
        _Pragma("unroll") for (int i = 0; i < 4; ++i) { const int idx = tid + 512 * i, r = idx >> 4, c16 = idx & 15; \
            if (lat_) pf.c[i] = *(const u32x4*)(CMg + (size_t)((b * 34 + c_) * NG + g) * 16384 + (size_t)idx * 8); \
            pf.b[i] = *(const u32x4*)(BMg + (size_t)((b * 34 + c_) * NG + g) * 16384 + (size_t)idx * 8); (void)r; (void)c16; } \
        _Pragma("unroll") for (int i = 0; i < 2; ++i) { const int idx = tid + 512 * i, r = idx >> 3, c16 = idx & 7; \
            pf.x[i] = *(const u32x4*)(XS + (size_t)((b * 34 + c_) * NH + hd) * 8192 + (size_t)idx * 8); pf.w[i] = ar_[((dir_) ? 640 : 256) + r]; \
            if (lat_ && (dir_) == 1) { pf.yz[i] = *(const u32x4*)(AO + (size_t)(row0_ + r) * DMIX + 512 + hd * 64 + c16 * 8); pf.yz[2 + i] = *(const u32x4*)(ZS + (size_t)(row0_ + r) * DSSM + hd * 64 + c16 * 8); } } \
        if (tid < 384) pf.arr = *(const f32v2*)(ar_ + 2 * tid); \
    } while (0)
#define SSD_ISSUE2(cbr, step_) do { const int c_ = SSD_CHUNK(0, step_); \
        const u32x4* cbp = (const u32x4*)(CBG + ((size_t)(((b * 32 + c_) * 4 + g) * 16 + lb) * 64 + lane) * 16); \
        _Pragma("unroll") for (int d = 0; d < 4; ++d) { const int sb = (lb + d) & 3; cbr[2 * d] = cbp[(size_t)sb * 512]; cbr[2 * d + 1] = cbp[(size_t)sb * 512 + 1]; } \
    } while (0)

#pragma unroll 1
    for (int dir = 0; dir < 2; ++dir) {
        f32x16 Hacc;
#pragma unroll
        for (int i = 0; i < 16; ++i) Hacc[i] = 0.f;
        SsdPF pf;
        u32x4 cbr[8];
#pragma unroll
        for (int i = 0; i < 8; ++i) cbr[i] = (u32x4){0u, 0u, 0u, 0u};
        u32x4 ytmp[2] = {(u32x4){0u, 0u, 0u, 0u}, (u32x4){0u, 0u, 0u, 0u}}; float sstmp = 0.f; int prow0 = 0; bool pylat = false;
        SSD_ISSUE(pf, dir, 0);
#pragma unroll 1
        for (int step = 0; step < 34; ++step) {
            const bool lat = step >= 2;
            const int c = SSD_CHUNK(dir, step), row0 = SSD_ROW0(c);
            if (lat) {
#pragma unroll
                for (int i = 0; i < 4; ++i) { const int idx = tid + 512 * i, r = idx >> 4, c16 = idx & 15; *(LAS u32x4*)(lds + SD_C + r * 272 + c16 * 16) = pf.c[i]; }
            }
#pragma unroll
            for (int i = 0; i < 4; ++i) { const int idx = tid + 512 * i, r = idx >> 4, c16 = idx & 15; *(LAS u32x4*)(lds + SD_B + r * 288 + c16 * 16) = pf.b[i]; }
#pragma unroll
            for (int i = 0; i < 2; ++i) { const int idx = tid + 512 * i, r = idx >> 3, c16 = idx & 7;
                if (dir == 0) *(LAS u32x4*)(lds + SD_X + r * 192 + c16 * 16) = pf.x[i];
                else if (lat) { *(LAS u32x4*)(lds + SD_X + r * 144 + c16 * 16) = pf.yz[i]; *(LAS u32x4*)(lds + SD_Y + r * 144 + c16 * 16) = pf.yz[2 + i]; }
                float f[8]; unpack8(pf.x[i], f); const float wv = pf.w[i];
                u32x4 o; o.x = cvt_pk_bf16(f[0] * wv, f[1] * wv); o.y = cvt_pk_bf16(f[2] * wv, f[3] * wv); o.z = cvt_pk_bf16(f[4] * wv, f[5] * wv); o.w = cvt_pk_bf16(f[6] * wv, f[7] * wv);
                *(LAS u32x4*)(lds + SD_XW + r * 192 + c16 * 16) = o; }
            if (tid < 384) *(LAS f32v2*)(ARR + 2 * tid) = pf.arr;
#pragma unroll
            for (int r = 0; r < 16; ++r) *(LAS bf16_t*)(lds + SD_H + (32 * pb + crow(r, h)) * 272 + (32 * lb + c31) * 2) = f2bf(Hacc[r]);
            if (pylat) {
#pragma unroll
                for (int i = 0; i < 2; ++i) { const int idx = tid + 512 * i, r = idx >> 3, c16 = idx & 7;
                    *(u32x4*)(AO + (size_t)(prow0 + r) * DMIX + 512 + hd * 64 + c16 * 8) = ytmp[i]; }
                if (dir == 1 && tid < 128) SS[(size_t)(prow0 + tid) * NH + hd] = sstmp;
            }
            lds_barrier();
            if (step + 1 < 34) SSD_ISSUE(pf, dir, step + 1);
            if (lat) {
                f32x16 y;
#pragma unroll
                for (int i = 0; i < 16; ++i) y[i] = 0.f;
                {
#pragma unroll
                    for (int half = 0; half < 2; ++half) {
                        bf16x8 afv[4], bfv[4];
#pragma unroll
                        for (int k4 = 0; k4 < 4; ++k4) { const int ks = 4 * half + k4; afv[k4] = *(const LAS bf16x8*)(lds + SD_H + (32 * pb + c31) * 272 + (16 * ks + 8 * h) * 2);
                            bfv[k4] = *(const LAS bf16x8*)(lds + SD_C + l * 272 + (16 * ks + 8 * h) * 2); }
                        asm volatile("s_waitcnt lgkmcnt(0)" ::: "memory");
#pragma unroll
                        for (int k4 = 0; k4 < 4; ++k4) y = __builtin_amdgcn_mfma_f32_32x32x16_bf16(afv[k4], bfv[k4], y, 0, 0, 0);
                    }
                }
                const float AFl = AF[l], ABSl = ABS[l];
                const float sc = __expf(dir ? ABSl : AFl);
#pragma unroll
                for (int i = 0; i < 16; ++i) y[i] *= sc;
                if (dir == 0) {
                    int c31v = c31, hv = h; asm volatile("" : "+v"(c31v), "+v"(hv));
                    s16x4 xf[8];
                    const unsigned xcol = xbase + (unsigned)((4 * hv + q) * 192 + (32 * pb + 16 * blk + 4 * pp) * 2);
#pragma unroll
                    for (int d = 0; d < 4; ++d) {
                        const int sb = (lb + d) & 3;
                        if ((d & 1) == 0) tr_read_diag8(xcol + (unsigned)(sb * 32 * 192), xcol + (unsigned)(((sb + 1) & 3) * 32 * 192), xf);
                        const unsigned cw[8] = {cbr[2 * d].x, cbr[2 * d].y, cbr[2 * d].z, cbr[2 * d].w, cbr[2 * d + 1].x, cbr[2 * d + 1].y, cbr[2 * d + 1].z, cbr[2 * d + 1].w};
                        float mt[16];
                        if (d == 0) {
#pragma unroll
                            for (int r = 0; r < 16; ++r) {
                                const int sl = crow(r, hv), s = 32 * sb + sl;
                                const float cb = (r & 1) ? bfhi(cw[r >> 1]) : bflo(cw[r >> 1]);
                                const float ef = __expf(AFl + LF[s]), eb = __expf(ABSl + LB[s]);
                                const float wgt = (sl <= c31v ? ef : 0.f) + (sl >= c31v ? eb : 0.f);
                                mt[r] = cb * wgt + (sl == c31v ? dsk : 0.f);
                            }
                        } else {
                            const bool fw = sb < lb; const LAS float* Lp = (fw ? LF : LB) + 32 * sb; const float Al = fw ? AFl : ABSl;
#pragma unroll
                            for (int r = 0; r < 16; ++r) {
                                const float cb = (r & 1) ? bfhi(cw[r >> 1]) : bflo(cw[r >> 1]);
                                mt[r] = cb * __expf(Al + Lp[crow(r, hv)]);
                            }
                        }
#pragma unroll
                        for (int s2 = 0; s2 < 2; ++s2) {
                            u32x4 bw; bw.x = cvt_pk_bf16(mt[8 * s2], mt[8 * s2 + 1]); bw.y = cvt_pk_bf16(mt[8 * s2 + 2], mt[8 * s2 + 3]);
                            bw.z = cvt_pk_bf16(mt[8 * s2 + 4], mt[8 * s2 + 5]); bw.w = cvt_pk_bf16(mt[8 * s2 + 6], mt[8 * s2 + 7]);
                            const bf16x8 bfr = __builtin_bit_cast(bf16x8, bw);
                            const bf16x8 afr = __builtin_shufflevector(xf[4 * (d & 1) + 2 * s2], xf[4 * (d & 1) + 2 * s2 + 1], 0, 1, 2, 3, 4, 5, 6, 7);
                            y = __builtin_amdgcn_mfma_f32_32x32x16_bf16(afr, bfr, y, 0, 0, 0);
                        }
                        asm volatile("" ::: "memory");
                    }
#pragma unroll
                    for (int g4 = 0; g4 < 4; ++g4) { u32x2 o; o.x = cvt_pk_bf16(y[4 * g4], y[4 * g4 + 1]); o.y = cvt_pk_bf16(y[4 * g4 + 2], y[4 * g4 + 3]); *(LAS u32x2*)(lds + SD_Y + l * 144 + (32 * pb + 8 * g4 + 4 * h) * 2) = o; }
                } else {
                    float ssq = 0.f;
#pragma unroll
                    for (int g4 = 0; g4 < 4; ++g4) {
                        const u32x2 yf = *(const LAS u32x2*)(lds + SD_X + l * 144 + (32 * pb + 8 * g4 + 4 * h) * 2), zz = *(const LAS u32x2*)(lds + SD_Y + l * 144 + (32 * pb + 8 * g4 + 4 * h) * 2);
                        const float o0 = (y[4 * g4] + bflo(yf.x)) * bflo(zz.x), o1 = (y[4 * g4 + 1] + bfhi(yf.x)) * bfhi(zz.x);
                        const float o2 = (y[4 * g4 + 2] + bflo(yf.y)) * bflo(zz.y), o3 = (y[4 * g4 + 3] + bfhi(yf.y)) * bfhi(zz.y);
                        ssq += (o0 * o0 + o1 * o1) + (o2 * o2 + o3 * o3);
                        u32x2 o; o.x = cvt_pk_bf16(o0, o1); o.y = cvt_pk_bf16(o2, o3); *(LAS u32x2*)(lds + SD_X + l * 144 + (32 * pb + 8 * g4 + 4 * h) * 2) = o;
                    }
                    ssq += __shfl_xor(ssq, 32);
                    if (lane < 32) SSP[pb * 128 + l] = ssq;
                }
            }
            if (dir == 0 && step + 1 < 34 && step + 1 >= 2) SSD_ISSUE2(cbr, step + 1);
            {
                const float dec = __expf(dir ? ABS[0] : AF[127]);
#pragma unroll
                for (int i = 0; i < 16; ++i) Hacc[i] *= dec;
                const unsigned ab = xwbase + (unsigned)((8 * h + q) * 192 + (32 * pb + 16 * blk + 4 * pp) * 2);
                const unsigned bb = bbase + (unsigned)((8 * h + q) * 288 + (32 * lb + 16 * blk + 4 * pp) * 2);
#pragma unroll
                for (int half = 0; half < 2; ++half) {
                    s16x4 f[16];
                    tr_read_state4(ab + half * 4 * 3072, bb + half * 4 * 4608, f);
#pragma unroll
                    for (int ks = 0; ks < 4; ++ks) {
                        const bf16x8 afr = __builtin_shufflevector(f[4 * ks], f[4 * ks + 1], 0, 1, 2, 3, 4, 5, 6, 7), bfr = __builtin_shufflevector(f[4 * ks + 2], f[4 * ks + 3], 0, 1, 2, 3, 4, 5, 6, 7);
                        Hacc = __builtin_amdgcn_mfma_f32_32x32x16_bf16(afr, bfr, Hacc, 0, 0, 0);
                    }
                }
            }
            lds_barrier();
            pylat = lat; prow0 = row0;
            if (lat) {
                const int ybase = dir ? SD_X : SD_Y;
#pragma unroll
                for (int i = 0; i < 2; ++i) { const int idx = tid + 512 * i, r = idx >> 3, c16 = idx & 7; ytmp[i] = *(const LAS u32x4*)(lds + ybase + r * 144 + c16 * 16); }
                if (dir == 1 && tid < 128) sstmp = SSP[tid] + SSP[128 + tid];
            }
        }
        if (pylat) {
#pragma unroll
            for (int i = 0; i < 2; ++i) { const int idx = tid + 512 * i, r = idx >> 3, c16 = idx & 7;
                *(u32x4*)(AO + (size_t)(prow0 + r) * DMIX + 512 + hd * 64 + c16 * 8) = ytmp[i]; }
            if (dir == 1 && tid < 128) SS[(size_t)(prow0 + tid) * NH + hd] = sstmp;
        }
        asm volatile("s_waitcnt vmcnt(0)" ::: "memory");
        __syncthreads();
    }
#undef SSD_ISSUE
#undef SSD_ISSUE2
#undef SSD_CHUNK
#undef SSD_ROW0
}

struct EpiOutProj {
    static constexpr bool PERM = true;
    const float* x; const float* MOD; bf16_t* x1;
    DI void operator()(const f32x4 (&acc)[2][2][4][2], const pg8::Unit& u, int wr, int wc, int fr, int fq) const {
        const int row0 = u.pm * 256 + wr * 64 + fr, col0 = u.pn * 256 + wc * 32 + 8 * fq;
        const int b = (u.pm * 256) >> 12;
        f32x4 g[2][2];
#pragma unroll
        for (int bj = 0; bj < 2; ++bj)
#pragma unroll
            for (int n = 0; n < 2; ++n) g[bj][n] = *(const f32x4*)(MOD + b * 6144 + 2048 + col0 + bj * 128 + n * 4);
#pragma unroll
        for (int ai = 0; ai < 2; ++ai)
#pragma unroll
            for (int m = 0; m < 4; ++m) { const size_t off = (size_t)(row0 + ai * 128 + m * 16) * DM + col0;
#pragma unroll
                for (int bj = 0; bj < 2; ++bj) { const f32x4 x0 = *(const f32x4*)(x + off + bj * 128), x4 = *(const f32x4*)(x + off + bj * 128 + 4);
                    const f32x4 v0 = x0 + g[bj][0] * acc[ai][bj][m][0], v1 = x4 + g[bj][1] * acc[ai][bj][m][1];
                    u32x4 w; w.x = cvt_pk_bf16(v0[0], v0[1]); w.y = cvt_pk_bf16(v0[2], v0[3]); w.z = cvt_pk_bf16(v1[0], v1[1]); w.w = cvt_pk_bf16(v1[2], v1[3]);
                    *(u32x4*)(x1 + off + bj * 128) = w; } }
    }
};

constexpr int RT_WP = 1032;
constexpr int RT_WL = 16 * RT_WP * 2, RT_MW = 2 * RT_WL, RT_SH = RT_MW + 4096;
DI void phase_router(Ctx& F) {
    relaunder(F);
    const float* nw = kin(16); const float* wr = kin(17);
    const float* MOD = (const float*)(F.ws + WS_MOD);
    unsigned char* H2 = F.ws + WS_H2; float* PROBS = (float*)(F.ws + WS_PROBS); int* INV = (int*)(F.ws + WS_INV);
    const bf16_t* X1 = (const bf16_t*)(F.ws + WS_X1);
    LAS unsigned char* lds = F.lds;
    const int lane = F.lane, r = lane & 15, kq = lane >> 4;
    const int row0 = (F.bid * 8 + F.wave) * 16, b = row0 >> 12;
    u32x4 xa[16], xb[16];
    { const u32x4* xp = (const u32x4*)(X1 + (size_t)(row0 + r) * DM + 16 * kq);
#pragma unroll
      for (int p = 0; p < 16; ++p) { xa[p] = xp[8 * p]; xb[p] = xp[8 * p + 1]; } }
#pragma unroll 4
    for (int i = F.tid; i < 16 * 1024; i += 512) { const int d = i >> 4, e = i & 15; const float w = wr[i]; const bf16_t hi = f2bf(w);
        *(LAS bf16_t*)(lds + (e * RT_WP + d) * 2) = hi; *(LAS bf16_t*)(lds + RT_WL + (e * RT_WP + d) * 2) = f2bf(w - bf2f(hi)); }
    for (int i = F.tid; i < 1024; i += 512) { *(LAS float*)(lds + RT_MW + 4 * i) = nw[i] * (MOD[b * 6144 + 4096 + i] + 1.f); *(LAS float*)(lds + RT_SH + 4 * i) = MOD[b * 6144 + 3072 + i]; }
    __syncthreads();
    float s = 0.f;
#pragma unroll
    for (int p = 0; p < 16; ++p) {
        const unsigned wv[8] = {xa[p].x, xa[p].y, xa[p].z, xa[p].w, xb[p].x, xb[p].y, xb[p].z, xb[p].w};
#pragma unroll
        for (int i = 0; i < 8; ++i) { const float lo = bflo(wv[i]), hi = bfhi(wv[i]); s += lo * lo + hi * hi; } }
#pragma unroll
    for (int p = 0; p < 16; ++p) asm volatile("" : "+v"(xa[p]), "+v"(xb[p]));
    s += __shfl_xor(s, 16); s += __shfl_xor(s, 32);
    const float rstd = rsqrtf(s * (1.f / DM) + 1e-6f);
    f32x4 acc = {0.f, 0.f, 0.f, 0.f};
    unsigned char* orow = H2 + (size_t)(row0 + r) * DM + 16 * kq;
#pragma unroll
    for (int p = 0; p < 16; ++p) {
        const unsigned wv[8] = {xa[p].x, xa[p].y, xa[p].z, xa[p].w, xb[p].x, xb[p].y, xb[p].z, xb[p].w};
        int kb = 16 * kq; { float a0 = acc[0]; asm volatile("" : "+v"(kb), "+v"(a0)); acc[0] = a0; }
        float h[16];
#pragma unroll
        for (int q4 = 0; q4 < 4; ++q4) { const f32x4 mw = *(const LAS f32x4*)(lds + RT_MW + (64 * p + kb + 4 * q4) * 4), sh = *(const LAS f32x4*)(lds + RT_SH + (64 * p + kb + 4 * q4) * 4);
            h[4 * q4] = (bflo(wv[2 * q4]) * rstd) * mw.x + sh.x; h[4 * q4 + 1] = (bfhi(wv[2 * q4]) * rstd) * mw.y + sh.y;
            h[4 * q4 + 2] = (bflo(wv[2 * q4 + 1]) * rstd) * mw.z + sh.z; h[4 * q4 + 3] = (bfhi(wv[2 * q4 + 1]) * rstd) * mw.w + sh.w; }
        u32x4 o; o.x = pk_fp8x4(h[0], h[1], h[2], h[3]); o.y = pk_fp8x4(h[4], h[5], h[6], h[7]); o.z = pk_fp8x4(h[8], h[9], h[10], h[11]); o.w = pk_fp8x4(h[12], h[13], h[14], h[15]);
        *(u32x4*)(orow + 64 * p) = o;
#pragma unroll
        for (int half = 0; half < 2; ++half) {
            u32x4 ah, al;
            unsigned hw[4], lw[4];
#pragma unroll
            for (int i = 0; i < 4; ++i) { const float f0 = h[8 * half + 2 * i], f1 = h[8 * half + 2 * i + 1]; hw[i] = cvt_pk_bf16(f0, f1); lw[i] = cvt_pk_bf16(f0 - bflo(hw[i]), f1 - bfhi(hw[i])); }
            ah.x = hw[0]; ah.y = hw[1]; ah.z = hw[2]; ah.w = hw[3]; al.x = lw[0]; al.y = lw[1]; al.z = lw[2]; al.w = lw[3];
            const bf16x8 bh = *(const LAS bf16x8*)(lds + (r * RT_WP + 64 * p + kb + 8 * half) * 2), bl = *(const LAS bf16x8*)(lds + RT_WL + (r * RT_WP + 64 * p + kb + 8 * half) * 2);
            const bf16x8 ahv = __builtin_bit_cast(bf16x8, ah), alv = __builtin_bit_cast(bf16x8, al);
            acc = __builtin_amdgcn_mfma_f32_16x16x32_bf16(ahv, bh, acc, 0, 0, 0);
            acc = __builtin_amdgcn_mfma_f32_16x16x32_bf16(ahv, bl, acc, 0, 0, 0);
            acc = __builtin_amdgcn_mfma_f32_16x16x32_bf16(alv, bh, acc, 0, 0, 0);
        }
    }
    f32x4 pr;
#pragma unroll
    for (int j = 0; j < 4; ++j) { float mx = acc[j];
        mx = fmaxf(mx, __shfl_xor(mx, 1)); mx = fmaxf(mx, __shfl_xor(mx, 2)); mx = fmaxf(mx, __shfl_xor(mx, 4)); mx = fmaxf(mx, __shfl_xor(mx, 8));
        const float ex = expf(acc[j] - mx); float den = ex;
        den += __shfl_xor(den, 1); den += __shfl_xor(den, 2); den += __shfl_xor(den, 4); den += __shfl_xor(den, 8);
        pr[j] = ex / den; }
    *(f32x4*)(PROBS + (size_t)(b * 16 + r) * SEQ + (row0 & 4095) + 4 * kq) = pr;
#pragma unroll
    for (int j = 0; j < 4; ++j) INV[(size_t)(row0 + 4 * kq + j) * 16 + r] = -1;
}

DI void moe_weight_items(Ctx& F, int w, int nw) {
    relaunder(F);
    const int lane = F.lane;
    LAS float* scr = (LAS float*)(F.lds + F.wave * TR_SCR);
    const float* w_gate = kin(18); const float* w_up = kin(19); const float* w_down = kin(20);
    unsigned char* Wgu = F.ws + WS_WGU; unsigned char* Wd = F.ws + WS_WD;
    constexpr int I_G = NE * 16 * 32, I_D = NE * 32 * 16;
    for (int it = w; it < 2 * I_G + I_D; it += nw) {
        int r = it;
        if (r < 2 * I_G) { const int up = r >= I_G; if (up) r -= I_G; const int e = r / 512, kb = (r % 512) / 32, nb = r % 32, f0 = nb * 64;
            transpose_item_f8((up ? w_up : w_gate) + (size_t)e * DM * DEXP, DEXP, kb * 64, f0, Wgu + ((size_t)e * 4096 + (f0 >> 7) * 256 + (f0 & 127) + up * 128) * DM, DM, scr, lane); continue; }
        r -= 2 * I_G;
        { const int e = r / 512, kb = (r % 512) / 16, nb = r % 16;
          transpose_item_f8(w_down + (size_t)e * DEXP * DM, DM, kb * 64, nb * 64, Wd + ((size_t)e * DM + nb * 64) * DEXP, DEXP, scr, lane); }
    }
}

DI void phase_topk(Ctx& F) {
    relaunder(F);
    const float* PROBS = (const float*)(F.ws + WS_PROBS); int* ROWMAP = (int*)(F.ws + WS_ROWMAP); float* VAL = (float*)(F.ws + WS_VAL); int* INV = (int*)(F.ws + WS_INV);
    LAS unsigned* HIST = (LAS unsigned*)F.lds;
    LAS unsigned* CTL = HIST + 256;
    LAS unsigned* WS1 = HIST + 272;
    const int tid = F.tid, lane = F.lane, wave = F.wave;
    for (int u = F.bid; u < NB * NE; u += F.G) {
        const int b = u >> 4, e = u & 15;
        const float* pr = PROBS + (size_t)u * SEQ + tid * 8;
        const f32x4 p0 = *(const f32x4*)pr, p1 = *(const f32x4*)(pr + 4);
        unsigned key[8] = {__float_as_uint(p0.x), __float_as_uint(p0.y), __float_as_uint(p0.z), __float_as_uint(p0.w), __float_as_uint(p1.x), __float_as_uint(p1.y), __float_as_uint(p1.z), __float_as_uint(p1.w)};
        unsigned prefix = 0u, kk = CAP;
        for (int pass = 0; pass < 4; ++pass) {
            const int shift = 24 - 8 * pass;
            if (tid < 256) HIST[tid] = 0u;
            __syncthreads();
            const unsigned himask = pass == 0 ? 0u : (0xffffffffu << (shift + 8));
#pragma unroll
            for (int i = 0; i < 8; ++i) if ((key[i] & himask) == prefix) __hip_atomic_fetch_add(&HIST[(key[i] >> shift) & 255u], 1u, __ATOMIC_RELAXED, __HIP_MEMORY_SCOPE_WORKGROUP);
            __syncthreads();
            if (wave == 0) {
                const unsigned h0 = HIST[4 * lane], h1 = HIST[4 * lane + 1], h2 = HIST[4 * lane + 2], h3 = HIST[4 * lane + 3];
                const unsigned tot = h0 + h1 + h2 + h3; unsigned sfx = tot;
#pragma unroll
                for (int o = 1; o < 64; o <<= 1) { const unsigned t = __shfl_down(sfx, o); if (lane + o < 64) sfx += t; }
                const unsigned above = sfx - tot;
                const unsigned a3 = above, a2 = a3 + h3, a1 = a2 + h2, a0 = a1 + h1;
                int bin = -1; unsigned cum = 0u;
                if (a3 < kk && kk <= a3 + h3) { bin = 4 * lane + 3; cum = a3; }
                else if (a2 < kk && kk <= a2 + h2) { bin = 4 * lane + 2; cum = a2; }
                else if (a1 < kk && kk <= a1 + h1) { bin = 4 * lane + 1; cum = a1; }
                else if (a0 < kk && kk <= a0 + h0) { bin = 4 * lane; cum = a0; }
                if (bin >= 0) { CTL[0] = prefix | ((unsigned)bin << shift); CTL[1] = kk - cum; }
            }
            __syncthreads();
            prefix = CTL[0]; kk = CTL[1];
            __syncthreads();
        }
        int ceq = 0;
#pragma unroll
        for (int i = 0; i < 8; ++i) ceq += (key[i] == prefix);
        int seq = ceq;
#pragma unroll
        for (int o = 1; o < 64; o <<= 1) { const int t = __shfl_up(seq, o); if (lane >= o) seq += t; }
        if (lane == 63) WS1[wave] = (unsigned)seq;
        __syncthreads();
        int eqbase = seq - ceq;
        for (int w = 0; w < wave; ++w) eqbase += (int)WS1[w];
        int csel = 0; unsigned selmask = 0u; int er = eqbase;
#pragma unroll
        for (int i = 0; i < 8; ++i) { bool s = key[i] > prefix; if (key[i] == prefix) { s = (unsigned)er < kk; ++er; } if (s) { selmask |= 1u << i; ++csel; } }
        int ssel = csel;
#pragma unroll
        for (int o = 1; o < 64; o <<= 1) { const int t = __shfl_up(ssel, o); if (lane >= o) ssel += t; }
        if (lane == 63) WS1[8 + wave] = (unsigned)ssel;
        __syncthreads();
        int pos = ssel - csel;
        for (int w = 0; w < wave; ++w) pos += (int)WS1[8 + w];
        const int obase = (e * 8 + b) * CAP;
#pragma unroll
        for (int i = 0; i < 8; ++i) if (selmask & (1u << i)) { if (pos < CAP) { const int tok = b * SEQ + tid * 8 + i; ROWMAP[obase + pos] = tok; VAL[obase + pos] = __uint_as_float(key[i]); INV[(size_t)tok * 16 + e] = obase + pos; } ++pos; }
        __syncthreads();
    }
}

struct MoeGUOrder {
    static constexpr bool GATHER = true;
    const int* rowmap; int G, c;
    DI bool next(int i, pg8::Unit& u) const {
        const int cc = (G % 8 == 0) ? (c % 8) * (G / 8) + c / 8 : c;
        const int L = i * G + cc; if (L >= NE * 256) return false;
        const int e = L >> 8, loc = L & 255, xg = loc >> 5, r = loc & 31;
        u.pm = e * 16 + (xg >> 1) * 4 + (r >> 3); u.pn = (xg & 1) * 8 + (r & 7); return true;
    }
    DI size_t bt_row0(const pg8::Unit& u) const { return (size_t)(u.pm >> 4) * 4096 + (size_t)u.pn * 256; }
};
struct EpiGU {
    static constexpr bool PERM = true;
    unsigned char* ACT; LAS unsigned char* ebuf;
    DI void operator()(const f32x4 (&acc)[2][2][4][2], const pg8::Unit& u, int wr, int wc, int fr, int fq) const {
        int tid = threadIdx.x; asm volatile("" : "+v"(tid));
        if (wr == 0) __builtin_amdgcn_s_barrier();
#pragma unroll
        for (int ai = 0; ai < 2; ++ai) {
            if (ai) lds_barrier();
#pragma unroll
            for (int m = 0; m < 4; ++m) { float o[8];
#pragma unroll
                for (int n = 0; n < 2; ++n)
#pragma unroll
                    for (int j = 0; j < 4; ++j) o[4 * n + j] = silu_f(acc[ai][0][m][n][j]) * acc[ai][1][m][n][j];
                u32x2 w; w.x = pk_fp8x4(o[0], o[1], o[2], o[3]); w.y = pk_fp8x4(o[4], o[5], o[6], o[7]);
                *(LAS u32x2*)(ebuf + (wr * 64 + m * 16 + fr) * 144 + wc * 32 + 8 * fq) = w; }
            lds_barrier();
#pragma unroll
            for (int i = 0; i < 2; ++i) { const int q = tid + 512 * i, row = q >> 3, c16 = q & 7;
                const u32x4 v = *(const LAS u32x4*)(ebuf + row * 144 + c16 * 16);
                *(u32x4*)(ACT + (size_t)(u.pm * 256 + ai * 128 + row) * DEXP + u.pn * 128 + c16 * 16) = v; }
        }
        if (wr == 1) __builtin_amdgcn_s_barrier();
    }
};
struct MoeDownOrder {
    static constexpr bool GATHER = false;
    const int* rowmap; int G, c;
    DI bool next(int i, pg8::Unit& u) const {
        const int cc = (G % 8 == 0) ? (c % 8) * (G / 8) + c / 8 : c;
        const int L = i * G + cc; if (L >= 1024) return false;
        u.pm = L >> 2; u.pn = L & 3; return true;
    }
    DI size_t bt_row0(const pg8::Unit& u) const { return (size_t)(u.pm >> 4) * 1024 + (size_t)u.pn * 256; }
};
struct EpiDown {
    static constexpr bool PERM = true;
    const float* val; unsigned char* YB; LAS unsigned char* ebuf;
    DI void operator()(const f32x4 (&acc)[2][2][4][2], const pg8::Unit& u, int wr, int wc, int fr, int fq) const {
        int tid = threadIdx.x; asm volatile("" : "+v"(tid));
        if (wr == 0) __builtin_amdgcn_s_barrier();
#pragma unroll
        for (int ps = 0; ps < 4; ++ps) { const int ai = ps >> 1, mh = ps & 1;
            if (ps) lds_barrier();
#pragma unroll
            for (int mm = 0; mm < 2; ++mm) { const int m = 2 * mh + mm; const int r = u.pm * 256 + ai * 128 + wr * 64 + m * 16 + fr; const float v = val[r] * 16.f;
#pragma unroll
                for (int bj = 0; bj < 2; ++bj) { const f32x4 v0 = acc[ai][bj][m][0] * v, v1 = acc[ai][bj][m][1] * v;
                    u32x2 w; w.x = pk_fp8x4(v0[0], v0[1], v0[2], v0[3]); w.y = pk_fp8x4(v1[0], v1[1], v1[2], v1[3]);
                    *(LAS u32x2*)(ebuf + (wr * 32 + mm * 16 + fr) * 272 + bj * 128 + wc * 32 + 8 * fq) = w; } }
            lds_barrier();
#pragma unroll
            for (int i = 0; i < 2; ++i) { const int q = tid + 512 * i, lr = q >> 4, c16 = q & 15;
                const u32x4 vv = *(const LAS u32x4*)(ebuf + lr * 272 + c16 * 16);
                *(u32x4*)(YB + (size_t)(u.pm * 256 + ai * 128 + (lr >> 5) * 64 + mh * 32 + (lr & 31)) * DM + u.pn * 256 + c16 * 16) = vv; }
        }
        if (wr == 1) __builtin_amdgcn_s_barrier();
    }
};

DI void final_slots(const unsigned char* YB, int inv, int lane, unsigned& mask, int& cnt, unsigned (&yb)[4][4]) {
    mask = (unsigned)(__ballot(inv >= 0) & 0xffffull); cnt = __builtin_popcount(mask);
    unsigned mm = mask;
#pragma unroll
    for (int k = 0; k < 4; ++k) { if (mm != 0u) { const int e = __builtin_ctz(mm); mm &= mm - 1u; const int r = __builtin_amdgcn_readlane(inv, e);
            const unsigned* yr = (const unsigned*)(YB + (size_t)r * DM) + lane;
#pragma unroll
            for (int j = 0; j < 4; ++j) yb[k][j] = yr[64 * j]; } }
}
DI void phase_final(Ctx& F) {
    relaunder(F);
    const float* fw = kin(21); const float* MOD = (const float*)(F.ws + WS_MOD);
    const int* INV = (const int*)(F.ws + WS_INV); const unsigned char* YB = F.ws + WS_YB; const bf16_t* X1 = (const bf16_t*)(F.ws + WS_X1);
    const int gw = F.bid * 8 + F.wave, NGW = F.G * 8, lane = F.lane;
    if (gw >= NTOK) return;
    int inv_c = (lane < 16) ? INV[(size_t)gw * 16 + lane] : -1;
    int inv_n = (lane < 16 && gw + NGW < NTOK) ? INV[(size_t)(gw + NGW) * 16 + lane] : -1;
    u32x2 xc[4], xn[4];
    { const u32x2* x1r = (const u32x2*)(X1 + (size_t)gw * DM) + lane;
#pragma unroll
      for (int j = 0; j < 4; ++j) { xc[j] = x1r[64 * j]; xn[j] = xc[j]; } }
    unsigned ybc[4][4], ybn[4][4]; unsigned mask_c = 0u, mask_n = 0u; int cnt_c = 0, cnt_n = 0;
#pragma unroll
    for (int k = 0; k < 4; ++k)
#pragma unroll
        for (int j = 0; j < 4; ++j) { ybc[k][j] = 0u; ybn[k][j] = 0u; }
    final_slots(YB, inv_c, lane, mask_c, cnt_c, ybc);
    for (int m = gw; m < NTOK; m += NGW) {
        const int b = m >> 12, mn = m + NGW, mnn = m + 2 * NGW;
        int inv_nn = -1;
        if (mn < NTOK) { const u32x2* x1r = (const u32x2*)(X1 + (size_t)mn * DM) + lane;
#pragma unroll
            for (int j = 0; j < 4; ++j) xn[j] = x1r[64 * j];
            final_slots(YB, inv_n, lane, mask_n, cnt_n, ybn);
            if (lane < 16 && mnn < NTOK) inv_nn = INV[(size_t)mnn * 16 + lane]; }
        f32x4 v[4], a[4];
#pragma unroll
        for (int j = 0; j < 4; ++j) { v[j] = (f32x4){bflo(xc[j].x), bfhi(xc[j].x), bflo(xc[j].y), bfhi(xc[j].y)}; a[j] = (f32x4){0.f, 0.f, 0.f, 0.f}; }
#pragma unroll
        for (int k = 0; k < 4; ++k) if (k < cnt_c) {
#pragma unroll
            for (int j = 0; j < 4; ++j) { const f32v2 lo = __builtin_amdgcn_cvt_pk_f32_fp8(ybc[k][j], false), hi = __builtin_amdgcn_cvt_pk_f32_fp8(ybc[k][j], true);
                a[j].x += lo.x; a[j].y += lo.y; a[j].z += hi.x; a[j].w += hi.y; } }
        if (cnt_c > 4) {
            unsigned mm = mask_c; mm &= mm - 1u; mm &= mm - 1u; mm &= mm - 1u; mm &= mm - 1u;
            while (mm != 0u) { const int e = __builtin_ctz(mm); mm &= mm - 1u; const int r = __builtin_amdgcn_readlane(inv_c, e);
                const unsigned* yr = (const unsigned*)(YB + (size_t)r * DM) + lane;
#pragma unroll
                for (int j = 0; j < 4; ++j) { const unsigned y = yr[64 * j]; const f32v2 lo = __builtin_amdgcn_cvt_pk_f32_fp8(y, false), hi = __builtin_amdgcn_cvt_pk_f32_fp8(y, true);
                    a[j].x += lo.x; a[j].y += lo.y; a[j].z += hi.x; a[j].w += hi.y; } } }
        const f32x4* g4 = (const f32x4*)(MOD + b * 6144 + 5120) + lane;
        float s = 0.f;
#pragma unroll
        for (int j = 0; j < 4; ++j) { v[j] = v[j] + g4[64 * j] * a[j] * (1.f / 16.f); s += (v[j].x * v[j].x + v[j].y * v[j].y) + (v[j].z * v[j].z + v[j].w * v[j].w); }
        const float rstd = rsqrtf(wave_sum(s) * (1.f / DM) + 1e-6f);
        const f32x4* w4 = (const f32x4*)fw + lane;
        f32x4* xr = (f32x4*)(F.out + (size_t)m * DM) + lane;
#pragma unroll
        for (int j = 0; j < 4; ++j) xr[64 * j] = v[j] * rstd * w4[64 * j];
#pragma unroll
        for (int j = 0; j < 4; ++j) xc[j] = xn[j];
#pragma unroll
        for (int k = 0; k < 4; ++k)
#pragma unroll
            for (int j = 0; j < 4; ++j) ybc[k][j] = ybn[k][j];
        mask_c = mask_n; cnt_c = cnt_n; inv_c = inv_n; inv_n = inv_nn;
    }
}

__global__ void __launch_bounds__(512) fwd_megakernel(Params p) {
    extern __shared__ __attribute__((aligned(16))) unsigned char lds_raw[];
    cg::grid_group grid = cg::this_grid();
    Ctx F;
    F.lds = (LAS unsigned char*)lds_raw;
    F.tid = threadIdx.x; F.lane = F.tid & 63; F.wave = __builtin_amdgcn_readfirstlane(F.tid >> 6); F.G = gridDim.x; F.bid = blockIdx.x;
    F.out = p.out; F.ws = p.ws;

    {
        if (F.tid == 0) { ((LAS unsigned*)(F.lds + LDS_BYTES - 16))[0] = 0u; ((LAS unsigned*)(F.lds + LDS_BYTES - 16))[1] = 0u; }
        if (F.bid == 0) { unsigned* bw = (unsigned*)(F.ws + WS_BAR); for (int i = F.tid; i < XCD_BAR_WORDS + 256; i += 512) bw[i] = 0u; }
        __syncthreads();
    }
    phase0(F);
    grid.sync();
    const XcdBarrier xbar = xcd_barrier_post((unsigned*)(F.ws + WS_BAR), (volatile LAS unsigned*)(F.lds + LDS_BYTES - 16));
    phase_h(F);
    xcd_barrier(xbar);
    {
        pg8::RectOrder S; S.init(128, 19, F.G, F.bid); S.nextra = 8 * 11; S.ex_m0 = 128; S.ex_n0 = 8; S.ex_nm = 8;
        EpiInProj E{(bf16_t*)(F.ws + WS_R2), (bf16_t*)F.out, (bf16_t*)(F.ws + WS_R4), (float*)(F.ws + WS_R5), kin(10)};
        pg8::gemm_phase<false, false>(F.lds, F.ws + WS_R1, F.ws + WS_WIN, DM * 2, S, E);
    }
    xcd_barrier(xbar);
    fft_step1(F);
    conv_cb_phase(F);
    xcd_barrier(xbar);
    if (F.bid < 192) { const int x = F.bid & 7, j = F.bid >> 3, gi = x * 4 + j / 6;
        ssd_unit(F, gi >> 2, (gi & 3) * 6 + j % 6); }
    else {
        const int sb = F.bid, sg = F.G; F.bid = sb - 192; F.G = sg - 192; fft_step2(F); F.bid = sb; F.G = sg;
        __syncthreads();
        moe_weight_items(F, (sb - 192) * 8 + F.wave, (sg - 192) * 8);
    }
    xcd_barrier(xbar);
    {
        pg8::RectOrder S; S.init(128, 4, F.G, F.bid);
        EpiOutProj E{kin(0), (const float*)(F.ws + WS_MOD), (bf16_t*)(F.ws + WS_X1)};
        LAS float* rs_tab = (LAS float*)(F.lds + pg8::STAGE_BYTES);
        { const float* SS = (const float*)(F.ws + WS_SS);
          for (int i = F.tid; i < 512; i += 512) { pg8::Unit u; if (!S.next(i >> 8, u)) break;
              const float* sp = SS + (size_t)(u.pm * 256 + (i & 255)) * NH; float r[4];
#pragma unroll
              for (int g = 0; g < 4; ++g) { float t = 0.f;
#pragma unroll
                  for (int k = 0; k < 6; ++k) t += sp[g * 6 + k];
                  r[g] = rsqrtf(t * (1.f / 384.f) + 1e-6f); }
              LAS float* o = rs_tab + (size_t)i * 8;
              o[0] = 1.f / r[0]; o[1] = r[0] / r[1]; o[2] = r[1] / r[2]; o[3] = r[2] / r[3]; o[4] = r[3]; }
          __syncthreads(); }
        pg8::gemm_phase<false, true>(F.lds, F.ws + WS_R4, F.ws + WS_WOUT, DMIX * 2, S, E, rs_tab);
    }
    xcd_barrier(xbar);
    phase_router(F);
    xcd_barrier(xbar);
    phase_topk(F);
    xcd_barrier(xbar);
    {
        MoeGUOrder S; S.rowmap = (const int*)(F.ws + WS_ROWMAP); S.G = F.G; S.c = F.bid;
        EpiGU E{F.ws + WS_ACT, F.lds + pg8::STAGE_BYTES};
        pg8::gemm_phase<true, false>(F.lds, F.ws + WS_H2, F.ws + WS_WGU, DM, S, E);
    }
    xcd_barrier(xbar);
    {
        MoeDownOrder S; S.rowmap = nullptr; S.G = F.G; S.c = F.bid;
        EpiDown E{(const float*)(F.ws + WS_VAL), F.ws + WS_YB, F.lds + pg8::STAGE_BYTES};
        pg8::gemm_phase<true, false>(F.lds, F.ws + WS_ACT, F.ws + WS_WD, DEXP, S, E);
    }
    xcd_barrier(xbar);
    phase_final(F);
}

extern "C" void kernel_launch(void* const* d_in, const int* in_sizes, int n_in, void* d_out, int out_size, void* d_ws, size_t ws_size, hipStream_t stream) {
    static int grid_blocks = 0;
    if (!grid_blocks) {
        int dev = 0, cus = 0, per_cu = 0;
        (void)hipGetDevice(&dev);
        (void)hipDeviceGetAttribute(&cus, hipDeviceAttributeMultiprocessorCount, dev);
        (void)hipFuncSetAttribute((const void*)fwd_megakernel, hipFuncAttributeMaxDynamicSharedMemorySize, LDS_BYTES);
        (void)hipOccupancyMaxActiveBlocksPerMultiprocessor(&per_cu, (const void*)fwd_megakernel, 512, LDS_BYTES);
        if (per_cu < 1) per_cu = 1;
        grid_blocks = cus * per_cu;
        fprintf(stderr, "grid %d (cus %d per_cu %d) ws %zu need %zu\n", grid_blocks, cus, per_cu, ws_size, (size_t)WS_NEED);
        if (grid_blocks != 256) { fprintf(stderr, "this kernel's phase program is written for a 256-workgroup grid (one per CU); got %d\n", grid_blocks); grid_blocks = -1; }
        else if (ws_size < WS_NEED || n_in != 22) { fprintf(stderr, "workspace too small or bad inputs\n"); grid_blocks = -1; }
    }
    if (grid_blocks < 0) return;
    Params p{};
    for (int i = 0; i < 22; ++i) p.in[i] = (const float*)d_in[i];
    p.out = (float*)d_out; p.ws = (unsigned char*)d_ws;
    void* args[] = {&p};
    hipError_t e = hipLaunchCooperativeKernel((void*)fwd_megakernel, dim3(grid_blocks), dim3(512), args, LDS_BYTES, stream);
    if (e != hipSuccess) fprintf(stderr, "cooperative launch failed: %s (grid %d)\n", hipGetErrorString(e), grid_blocks);
}
```

```cpp
#include <hip/hip_runtime.h>
#include <hip/hip_cooperative_groups.h>
#include <cstdio>
namespace cg = cooperative_groups;

#define LAS __attribute__((address_space(3)))
#define DI __device__ __forceinline__
typedef unsigned short bf16_t;
typedef short bf16x8 __attribute__((ext_vector_type(8)));
typedef short s16x4 __attribute__((ext_vector_type(4)));
typedef float f32x4 __attribute__((ext_vector_type(4)));
typedef float f32x16 __attribute__((ext_vector_type(16)));
typedef unsigned u32x4 __attribute__((ext_vector_type(4)));
typedef unsigned u32x2 __attribute__((ext_vector_type(2)));

constexpr int NB = 8, SEQ = 4096, DM = 1024, CTXL = 256;
constexpr int NTOK = NB * SEQ;
constexpr int NCTX = NB * CTXL;
constexpr int NROWS = NTOK + NCTX;
constexpr int DIN = 4656, DIN_T = 4864;
constexpr int DSSM = 1536, NH = 24, HD = 64, NG = 4, DST = 128, CONVD = 2560, DMIX = 2048;
constexpr int NE = 16, CAP = 512, DEXP = 2048;
constexpr int LDS_BYTES = 163840;

constexpr size_t MB = 1u << 20;
constexpr size_t WS_MOD   = 4096;
constexpr size_t WS_WOUT  = 1 * MB;
constexpr size_t WS_WIN   = WS_WOUT + (size_t)DM * DMIX * 2;
constexpr size_t WS_R1    = WS_WIN + (size_t)DIN_T * DM * 2;
constexpr size_t WS_R2    = WS_R1 + (size_t)NROWS * DM * 2;
constexpr size_t WS_R4    = WS_R2 + (size_t)NTOK * DM * 2;
constexpr size_t WS_R5    = WS_R4 + (size_t)NROWS * CONVD * 2;
constexpr size_t WS_XS    = WS_R5 + (size_t)NROWS * 48 * 4;
constexpr size_t WS_BM    = WS_XS + (size_t)NROWS * DSSM * 2;
constexpr size_t WS_CM    = WS_BM + (size_t)NROWS * 512 * 2;
constexpr size_t WS_CB    = WS_CM + (size_t)NROWS * 512 * 2;
constexpr size_t WS_SS    = WS_CB + (size_t)NB * 32 * NG * 16384 * 2;
constexpr size_t WS_ARRS  = WS_SS + (size_t)NTOK * NH * 4;
constexpr int ARN = 1152;
constexpr size_t WS_END1  = WS_ARRS + (size_t)NB * 34 * NH * ARN * 4;

constexpr size_t WS_ROWMAP = 256 * 1024;
constexpr size_t WS_VAL    = 512 * 1024;
constexpr size_t WS_WGU    = WS_R2;
constexpr size_t WS_WD     = WS_R4 + (size_t)NTOK * DMIX * 2;
constexpr size_t WS_H2     = WS_R1;
constexpr size_t WS_ACT    = WS_XS;
constexpr size_t WS_PROBS  = WS_ACT + (size_t)NE * NB * CAP * DEXP;
constexpr size_t WS_INV    = WS_PROBS + (size_t)NB * NE * SEQ * 4;
constexpr size_t WS_YB     = WS_R4;
constexpr size_t WS_X1     = WS_INV + (size_t)NTOK * NE * 4;
constexpr size_t WS_END2   = WS_X1 + (size_t)NTOK * DM * 2;
constexpr size_t WS_BAR    = 768 * 1024;
static_assert(WS_WD + (size_t)NE * DM * DEXP <= WS_R5 && WS_WGU + (size_t)NE * 4096 * DM <= WS_R4 && WS_END2 <= WS_SS && WS_H2 + (size_t)NTOK * DM <= WS_R2, "MoE stage layout");
constexpr size_t WS_NEED   = WS_END1 > WS_END2 ? WS_END1 : WS_END2;

typedef __bf16 bf16v2 __attribute__((ext_vector_type(2)));
typedef float f32v2 __attribute__((ext_vector_type(2)));
DI unsigned cvt_pk_bf16(float lo, float hi) { f32v2 f = {lo, hi}; bf16v2 h = __builtin_convertvector(f, bf16v2); return __builtin_bit_cast(unsigned, h); }
DI bf16_t f2bf(float f) { return (bf16_t)(cvt_pk_bf16(f, 0.f) & 0xffffu); }
DI float bf2f(bf16_t b) { return __uint_as_float(((unsigned)b) << 16); }
DI float silu_f(float x) { return x * __builtin_amdgcn_rcpf(1.f + __expf(-x)); }
DI float softplus_f(float x) { return fmaxf(x, 0.f) + log1pf(__expf(-fabsf(x))); }
DI float wave_sum(float v) {
#pragma unroll
    for (int o = 1; o < 64; o <<= 1) v += __shfl_xor(v, o);
    return v;
}
DI unsigned pk_fp8x4(float a, float b, float c, float d) { unsigned w = 0u; w = __builtin_amdgcn_cvt_pk_fp8_f32(a, b, w, false); w = __builtin_amdgcn_cvt_pk_fp8_f32(c, d, w, true); return w; }
DI void lds_wait() { asm volatile("s_waitcnt lgkmcnt(0)" ::: "memory"); }
DI void lds_barrier() { asm volatile("s_waitcnt lgkmcnt(0)" ::: "memory"); __builtin_amdgcn_s_barrier(); asm volatile("" ::: "memory"); }

namespace pg8 {
constexpr int BM = 256, BK = 64, HALF = 128, HTB = HALF * BK * 2, STAGE_BYTES = 8 * HTB;
DI int lds_byte(int r, int c) { const int st = (r >> 4) * 2 + (c >> 5), rr = r & 15, cc = c & 31, ob = rr * 64 + cc * 2; return st * 1024 + (ob ^ (((ob >> 9) & 1) << 5)); }
DI void stage_rc(int b, int& R, int& C) { const int st = b / 1024, sb = b % 1024, swz = sb ^ (((sb >> 9) & 1) << 5); R = (st >> 1) * 16 + swz / 64; C = (st & 1) * 32 + (swz % 64) / 2; }
DI int perm32(int rho) { const int n = rho >> 4, i = rho & 15; return 8 * (i >> 2) + 4 * n + (i & 3); }
struct Unit { int pm, pn; };

template <class Ord>
DI void a_offsets(const Ord& S, const Unit& u, int KB, int tid, unsigned (&ao)[2][2]) {
#pragma unroll
    for (int h = 0; h < 2; ++h)
#pragma unroll
        for (int i = 0; i < 2; ++i) { int R, C; stage_rc(tid * 16 + i * 8192, R, C); const int r = S.rowmap[u.pm * BM + h * HALF + R]; ao[h][i] = (unsigned)r * (unsigned)KB + (unsigned)C * 2u; }
}

typedef int i32x4v __attribute__((ext_vector_type(4)));
typedef int i32x8v __attribute__((ext_vector_type(8)));
DI i32x8v cat8(bf16x8 a, bf16x8 b) { return __builtin_shufflevector(__builtin_bit_cast(i32x4v, a), __builtin_bit_cast(i32x4v, b), 0, 1, 2, 3, 4, 5, 6, 7); }
template <bool FP8, bool RS, class Epi, class Ord>
DI void gemm_phase(LAS unsigned char* lds, const void* A, const void* Bt, const int KB, const Ord& S, const Epi& E, const LAS float* rs_tab = nullptr) {
    int tid_ = threadIdx.x; asm volatile("" : "+v"(tid_));
    const int tid = tid_, wid = __builtin_amdgcn_readfirstlane(tid >> 6), lane = tid & 63, wr = wid >> 2, wc = wid & 3, fr = lane & 15, fq = lane >> 4;
    const int nt = KB / 128;
    constexpr bool GA = Ord::GATHER;
    unsigned voffA[2], voffB[2];
#pragma unroll
    for (int i = 0; i < 2; ++i) { int R, C; stage_rc(tid * 16 + i * 8192, R, C); const int Rb = Epi::PERM ? ((R & ~31) + perm32(R & 31)) : R; voffA[i] = (unsigned)(R * KB + C * 2); voffB[i] = (unsigned)(Rb * KB + C * 2); }
    const size_t tstep = (size_t)BM * KB;
    const size_t kstep = (size_t)(BK * 2);
    const size_t hstep = (size_t)HALF * KB;
    const unsigned ldsw = (unsigned)wid * 1024u;
    const int aoff = lds_byte(wr * 64 + fr, fq * 8), boff = lds_byte(wc * 32 + fr, fq * 8);
#define PG8_SA(b, h) (((b) * 2 + (h)) * HTB)
#define PG8_SB(b, h) ((4 + (b) * 2 + (h)) * HTB)
#define PG8_STAGE(bufoff, gbase, voff) do { _Pragma("unroll") for (int _i = 0; _i < 2; ++_i) \
        __builtin_amdgcn_global_load_lds((const unsigned*)((const char*)(gbase) + (voff)[_i]), (LAS unsigned*)(lds + (bufoff) + ldsw + _i * 8192), 16, 0, 0); } while (0)
#define PG8_LDA(dst, b, h) do { _Pragma("unroll") for (int m = 0; m < 4; ++m) dst[m] = cat8(*(const LAS bf16x8*)(lds + PG8_SA(b, h) + aoff + m * 2048), *(const LAS bf16x8*)(lds + PG8_SA(b, h) + aoff + m * 2048 + 1024)); } while (0)
#define PG8_LDB(dst, b, h) do { _Pragma("unroll") for (int n = 0; n < 2; ++n) dst[n] = cat8(*(const LAS bf16x8*)(lds + PG8_SB(b, h) + boff + n * 2048), *(const LAS bf16x8*)(lds + PG8_SB(b, h) + boff + n * 2048 + 1024)); } while (0)
#define PG8_LO(v) __builtin_bit_cast(bf16x8, __builtin_shufflevector(v, v, 0, 1, 2, 3))
#define PG8_HI(v) __builtin_bit_cast(bf16x8, __builtin_shufflevector(v, v, 4, 5, 6, 7))
#define PG8_MMA(ai, bj, At, Bt_) do { __builtin_amdgcn_s_setprio(1); _Pragma("unroll") for (int m = 0; m < 4; ++m) _Pragma("unroll") for (int n = 0; n < 2; ++n) { \
        if constexpr (FP8) asm volatile("v_mfma_scale_f32_16x16x128_f8f6f4 %0, %1, %2, %0, %3, %4 op_sel_hi:[0,0,0]" : "+v"(acc[ai][bj][m][n]) : "v"(Bt_[n]), "v"(At[m]), "v"(scl_w), "v"(scl_a)); \
        else { acc[ai][bj][m][n] = __builtin_amdgcn_mfma_f32_16x16x32_bf16(PG8_LO(Bt_[n]), PG8_LO(At[m]), acc[ai][bj][m][n], 0, 0, 0); \
               acc[ai][bj][m][n] = __builtin_amdgcn_mfma_f32_16x16x32_bf16(PG8_HI(Bt_[n]), PG8_HI(At[m]), acc[ai][bj][m][n], 0, 0, 0); } } \
        __builtin_amdgcn_s_setprio(0); } while (0)
#define PG8_WAIT_V(n) asm volatile("s_waitcnt vmcnt(" #n ")" ::: "memory")
#define PG8_WAIT_L(n) asm volatile("s_waitcnt lgkmcnt(" #n ")" ::: "memory")
#define PG8_BAR __builtin_amdgcn_s_barrier()
#define PG8_SCHED __builtin_amdgcn_sched_barrier(0)
    Unit cur, nxt; int ui = 0;
    if (!S.next(0, cur)) return;
    f32x4 acc[2][2][4][2];
#pragma unroll
    for (int a = 0; a < 2; ++a)
#pragma unroll
        for (int b = 0; b < 2; ++b)
#pragma unroll
            for (int m = 0; m < 4; ++m)
#pragma unroll
                for (int n = 0; n < 2; ++n) acc[a][b][m][n] = (f32x4){0.f, 0.f, 0.f, 0.f};
    i32x8v At[4], B0[2], B1[2];
    const int scl_w = 0x7a7a7a7a, scl_a = 0x7f7f7f7f;
    unsigned aoc[2][2], aon[2][2];
    if constexpr (GA) a_offsets(S, cur, KB, tid, aoc);
    const char* const Ab = (const char*)A;
    const char* cA = GA ? Ab : Ab + (size_t)cur.pm * tstep;
#define PG8_AP(p, h) (GA ? (p) : (p) + (h) * hstep)
#define PG8_AO(o, h) (GA ? (o)[h] : voffA)
    const char* cB = (const char*)Bt + S.bt_row0(cur) * (size_t)KB;
    PG8_STAGE(PG8_SB(0, 0), cB, voffB); PG8_STAGE(PG8_SA(0, 0), PG8_AP(cA, 0), PG8_AO(aoc, 0)); PG8_STAGE(PG8_SB(0, 1), cB + hstep, voffB); PG8_STAGE(PG8_SA(0, 1), PG8_AP(cA, 1), PG8_AO(aoc, 1));
    if (wr == 1) PG8_BAR;
    PG8_WAIT_V(4); PG8_BAR;
    PG8_STAGE(PG8_SB(1, 0), cB + kstep, voffB); PG8_STAGE(PG8_SA(1, 0), PG8_AP(cA + kstep, 0), PG8_AO(aoc, 0)); PG8_STAGE(PG8_SB(1, 1), cB + hstep + kstep, voffB);
    PG8_WAIT_V(6); PG8_BAR;
    for (;;) {
        const bool has_next = S.next(ui + 1, nxt);
        const char* nB = cB; const char* nA = cA;
        if (has_next) { if constexpr (GA) a_offsets(S, nxt, KB, tid, aon); else nA = Ab + (size_t)nxt.pm * tstep; nB = (const char*)Bt + S.bt_row0(nxt) * (size_t)KB; }
        else if constexpr (GA) {
#pragma unroll
            for (int h = 0; h < 2; ++h)
#pragma unroll
                for (int i = 0; i < 2; ++i) aon[h][i] = aoc[h][i];
        }
#pragma unroll 1
        for (int t = 0; t < nt; t += 2) {
            const bool last = (t == nt - 2);
            float rsv[2][4]; bool rs_now = false;
            if constexpr (RS) { const int tn = t + 2; rs_now = (tn >= 8) && ((tn - 8) % 6 == 0);
                if (rs_now) { const int bi = (tn - 8) / 6; const LAS float* tb = rs_tab + (size_t)(ui & 1) * 256 * 8 + bi;
#pragma unroll
                    for (int ai = 0; ai < 2; ++ai)
#pragma unroll
                        for (int m = 0; m < 4; ++m) rsv[ai][m] = tb[(ai * HALF + wr * 64 + m * 16 + fr) * 8]; } }
            const char* a1 = cA + (size_t)(t + 1) * kstep;
            const char* a2 = last ? nA : cA + (size_t)(t + 2) * kstep; const char* b2 = last ? nB : cB + (size_t)(t + 2) * kstep;
            const char* a3 = a2 + kstep; const char* b3 = b2 + kstep;
            unsigned o2[2][2];
            if constexpr (GA) {
#pragma unroll
                for (int h = 0; h < 2; ++h)
#pragma unroll
                    for (int i = 0; i < 2; ++i) o2[h][i] = last ? aon[h][i] : aoc[h][i];
            }
            PG8_LDB(B0, 0, 0); PG8_SCHED; PG8_LDA(At, 0, 0); PG8_STAGE(PG8_SA(1, 1), PG8_AP(a1, 1), PG8_AO(aoc, 1));
            PG8_WAIT_L(8); PG8_BAR; PG8_WAIT_L(0); PG8_MMA(0, 0, At, B0); PG8_BAR; PG8_SCHED;
            PG8_LDB(B1, 0, 1); PG8_STAGE(PG8_SB(0, 0), b2, voffB);
            PG8_BAR; PG8_WAIT_L(0); PG8_MMA(0, 1, At, B1); PG8_BAR;
            PG8_LDA(At, 0, 1); PG8_STAGE(PG8_SA(0, 0), PG8_AP(a2, 0), PG8_AO(o2, 0));
            PG8_BAR; PG8_WAIT_L(0); PG8_MMA(1, 0, At, B0); PG8_BAR; PG8_SCHED;
            PG8_STAGE(PG8_SB(0, 1), b2 + hstep, voffB);
            PG8_WAIT_V(6); PG8_BAR; PG8_MMA(1, 1, At, B1); PG8_BAR;
            PG8_LDB(B0, 1, 0); PG8_SCHED; PG8_LDA(At, 1, 0); PG8_STAGE(PG8_SA(0, 1), PG8_AP(a2, 1), PG8_AO(o2, 1));
            PG8_WAIT_L(8); PG8_BAR; PG8_WAIT_L(0); PG8_MMA(0, 0, At, B0); PG8_BAR; PG8_SCHED;
            PG8_LDB(B1, 1, 1); PG8_STAGE(PG8_SB(1, 0), b3, voffB);
            PG8_BAR; PG8_WAIT_L(0); PG8_MMA(0, 1, At, B1); PG8_BAR;
            PG8_LDA(At, 1, 1); PG8_STAGE(PG8_SA(1, 0), PG8_AP(a3, 0), PG8_AO(o2, 0));
            PG8_BAR; PG8_WAIT_L(0); PG8_MMA(1, 0, At, B0); PG8_BAR; PG8_SCHED;
            PG8_STAGE(PG8_SB(1, 1), b3 + hstep, voffB);
            PG8_WAIT_V(6); PG8_BAR; PG8_MMA(1, 1, At, B1); PG8_BAR;
            if constexpr (RS) { if (rs_now) {
#pragma unroll
                for (int ai = 0; ai < 2; ++ai)
#pragma unroll
                    for (int bj = 0; bj < 2; ++bj)
#pragma unroll
                        for (int m = 0; m < 4; ++m)
#pragma unroll
                            for (int n = 0; n < 2; ++n) acc[ai][bj][m][n] = acc[ai][bj][m][n] * rsv[ai][m]; } }
        }
        if constexpr (FP8) asm volatile("s_nop 15\n\ts_nop 15" ::: "memory");
        E(acc, cur, wr, wc, fr, fq);
        if (!has_next) break;
#pragma unroll
        for (int a = 0; a < 2; ++a)
#pragma unroll
            for (int b = 0; b < 2; ++b)
#pragma unroll
                for (int m = 0; m < 4; ++m)
#pragma unroll
                    for (int n = 0; n < 2; ++n) acc[a][b][m][n] = (f32x4){0.f, 0.f, 0.f, 0.f};
        cur = nxt; cB = nB; cA = nA; ++ui;
        if constexpr (GA) {
#pragma unroll
            for (int h = 0; h < 2; ++h)
#pragma unroll
                for (int i = 0; i < 2; ++i) aoc[h][i] = aon[h][i];
        }
    }
    PG8_WAIT_V(0);
    if (wr == 0) PG8_BAR;
    PG8_BAR;
#undef PG8_AP
#undef PG8_AO
#undef PG8_SA
#undef PG8_SB
#undef PG8_STAGE
#undef PG8_LO
#undef PG8_HI
#undef PG8_LDA
#undef PG8_LDB
#undef PG8_MMA
#undef PG8_WAIT_V
#undef PG8_WAIT_L
#undef PG8_BAR
#undef PG8_SCHED
}

struct RectOrder {
    static constexpr bool GATHER = false;
    const int* rowmap;
    int nM, nN, nwg, G, c, nextra, ex_m0, ex_n0, ex_nm;
    DI void init(int nM_, int nN_, int G_, int c_) { nM = nM_; nN = nN_; nwg = nM * nN; G = G_; c = c_; nextra = 0; ex_m0 = ex_n0 = 0; ex_nm = 1; rowmap = nullptr; }
    DI bool next(int i, Unit& u) const {
        const int L = i * G + c; if (L >= nwg + nextra) return false;
        if (L >= nwg) { const int e = L - nwg; u.pm = ex_m0 + e % ex_nm; u.pn = ex_n0 + e / ex_nm; return true; }
        int wgid = L; { const int q = nwg / 8, r = nwg % 8, xcd = wgid % 8, off = wgid / 8; wgid = (xcd < r ? xcd * (q + 1) : r * (q + 1) + (xcd - r) * q) + off; }
        const int nig = 8 * nN, gid = wgid / nig, fm = gid * 8, gsz = (nM - fm) < 8 ? (nM - fm) : 8;
        u.pm = fm + ((wgid % nig) % gsz); u.pn = (wgid % nig) / gsz; return true;
    }
    DI size_t bt_row0(const Unit& u) const { return (size_t)u.pn * BM; }
};
}


#define XB_TMO      128
#define XB_XCNT(j)  (256  + 64 * (j))
#define XB_XSUB(j)  (1280 + 64 * (j))
#define XB_XGEN(j)  (2304 + 64 * (j))
#define XB_TOP      3328
#define XB_TOPGEN   3392
#define XCD_BAR_WORDS 3456
#define XB_SPIN_CAP (1u << 18)
DI unsigned xb_ld(unsigned* p)              { return __hip_atomic_load(p, __ATOMIC_RELAXED, __HIP_MEMORY_SCOPE_AGENT); }
DI unsigned xb_add(unsigned* p, unsigned v) { return __hip_atomic_fetch_add(p, v, __ATOMIC_RELAXED, __HIP_MEMORY_SCOPE_AGENT); }
DI unsigned xb_xcc_id() { return (unsigned)__builtin_amdgcn_s_getreg((3 << 11) | 20) & 0xFu; }
#define XB_SPIN(cond, bar) do { unsigned _sp = 0; while (cond) { __builtin_amdgcn_s_sleep(1); \
    if ((++_sp & 255u) == 0u) { if (xb_ld(&(bar)[XB_TMO])) break; if (_sp > XB_SPIN_CAP) { atomicAdd(&(bar)[XB_TMO], 1u); break; } } } } while (0)
struct XcdBarrier { unsigned* bar; unsigned x; volatile LAS unsigned* st; };
DI XcdBarrier xcd_barrier_post(unsigned* bar, volatile LAS unsigned* st) {
    XcdBarrier b; b.bar = bar; b.x = xb_xcc_id(); b.st = st;
    if (threadIdx.x == 0) (void)xb_add(&bar[XB_XCNT(b.x)], 1u);
    return b;
}
DI void xcd_barrier_complete(unsigned* bar, unsigned x, unsigned& nloc, unsigned& nx) {
    const unsigned G = gridDim.x * gridDim.y * gridDim.z;
    unsigned sum, cnt, mine, sp = 0u;
    for (;;) {
        sum = 0u; cnt = 0u; mine = 0u;
#pragma unroll
        for (unsigned j = 0; j < 16; ++j) { const unsigned c = xb_ld(&bar[XB_XCNT(j)]); sum += c; cnt += (c > 0u) ? 1u : 0u; mine = (j == x) ? c : mine; }
        if (sum == G) break;
        __builtin_amdgcn_s_sleep(1);
        if ((++sp & 255u) == 0u) { if (xb_ld(&bar[XB_TMO])) break; if (sp > XB_SPIN_CAP) { atomicAdd(&bar[XB_TMO], 1u); break; } }
    }
    nloc = mine > 0u ? mine : 1u; nx = cnt > 0u ? cnt : 1u;
}
DI void xcd_barrier(const XcdBarrier& b) {
    asm volatile("s_waitcnt vmcnt(0)" ::: "memory");
    __syncthreads();
    if (threadIdx.x == 0) {
        unsigned* bar = b.bar;
        __builtin_amdgcn_s_waitcnt(0);
        unsigned nloc = b.st[0], nx = b.st[1];
        if (nloc == 0u) { xcd_barrier_complete(bar, b.x, nloc, nx); b.st[0] = nloc; b.st[1] = nx; }
        const unsigned old = xb_add(&bar[XB_XSUB(b.x)], 1u);
        const unsigned gen = old / nloc;
        if (old + 1u == (gen + 1u) * nloc) {
            __builtin_amdgcn_fence(__ATOMIC_RELEASE, "agent");
            asm volatile("s_waitcnt vmcnt(0)" ::: "memory");
            const unsigned og = xb_add(&bar[XB_TOP], 1u);
            const unsigned tg = og / nx;
            if (og + 1u == (tg + 1u) * nx) xb_add(&bar[XB_TOPGEN], 1u);
            else XB_SPIN(xb_ld(&bar[XB_TOPGEN]) == tg, bar);
            __builtin_amdgcn_fence(__ATOMIC_ACQUIRE, "agent");
            xb_add(&bar[XB_XGEN(b.x)], 1u);
            asm volatile("s_waitcnt vmcnt(0)" ::: "memory");
        } else {
            XB_SPIN(xb_ld(&bar[XB_XGEN(b.x)]) == gen, bar);
            __builtin_amdgcn_fence(__ATOMIC_ACQUIRE, "agent");
            asm volatile("s_waitcnt vmcnt(0)" ::: "memory");
        }
    }
    __syncthreads();
}

struct Params {
    const float* in[22];
    float* out;
    unsigned char* ws;
};

DI const float* kin(int i) {
    const __attribute__((address_space(4))) char* ka = (const __attribute__((address_space(4))) char*)__builtin_amdgcn_kernarg_segment_ptr();
    asm volatile("" : "+s"(ka));
    return *(const float* const __attribute__((address_space(4)))*)(ka + 8 * i);
}
struct Ctx;
DI void relaunder(Ctx& F);
struct Ctx {
    LAS unsigned char* lds;
    int tid, lane, wave, G, bid;
    float* out; unsigned char* ws;
};

DI void relaunder(Ctx& F) { int t = threadIdx.x; asm volatile("" : "+v"(t)); F.tid = t; F.lane = t & 63; F.wave = __builtin_amdgcn_readfirstlane(t >> 6); }

constexpr int TR_SCR = 64 * 65 * 4;
DI void transpose_item(const float* W, int ldw, int k0, int c0, int ncols, bf16_t* WT, int K, LAS float* scr, int lane, const float* kscale = nullptr) {
    const int r4 = lane >> 4, c4 = (lane & 15) * 4;
    f32x4 v[16];
#pragma unroll
    for (int i = 0; i < 16; ++i) { v[i] = (c4 < ncols) ? *(const f32x4*)(W + (size_t)(k0 + 4 * i + r4) * ldw + c0 + c4) : (f32x4){0.f, 0.f, 0.f, 0.f};
        if (kscale) v[i] = v[i] * kscale[4 * i + r4]; }
#pragma unroll
    for (int i = 0; i < 16; ++i) { LAS float* d = scr + (4 * i + r4) * 65 + c4; d[0] = v[i].x; d[1] = v[i].y; d[2] = v[i].z; d[3] = v[i].w; }
    lds_wait();
    const int c = lane & 7;
#pragma unroll
    for (int j = 0; j < 8; ++j) { const int n = (lane >> 3) + 8 * j; const LAS float* s = scr + (8 * c) * 65 + n;
        u32x4 o; o.x = cvt_pk_bf16(s[0 * 65], s[1 * 65]); o.y = cvt_pk_bf16(s[2 * 65], s[3 * 65]); o.z = cvt_pk_bf16(s[4 * 65], s[5 * 65]); o.w = cvt_pk_bf16(s[6 * 65], s[7 * 65]);
        if (n < ncols) *(u32x4*)(WT + (size_t)n * K + k0 + 8 * c) = o; }
    lds_wait();
}

DI void transpose_item_f8(const float* W, int ldw, int k0, int c0, unsigned char* WT, int KBy, LAS float* scr, int lane) {
    const int r4 = lane >> 4, c4 = (lane & 15) * 4;
    f32x4 v[16];
#pragma unroll
    for (int i = 0; i < 16; ++i) v[i] = *(const f32x4*)(W + (size_t)(k0 + 4 * i + r4) * ldw + c0 + c4);
#pragma unroll
    for (int i = 0; i < 16; ++i) { LAS float* d = scr + (4 * i + r4) * 65 + c4; d[0] = v[i].x; d[1] = v[i].y; d[2] = v[i].z; d[3] = v[i].w; }
    lds_wait();
    const int c = lane & 3;
#pragma unroll
    for (int j = 0; j < 4; ++j) { const int n = (lane >> 2) + 16 * j; const LAS float* s = scr + (16 * c) * 65 + n;
        u32x4 o;
        o.x = pk_fp8x4(s[0 * 65] * 32.f, s[1 * 65] * 32.f, s[2 * 65] * 32.f, s[3 * 65] * 32.f); o.y = pk_fp8x4(s[4 * 65] * 32.f, s[5 * 65] * 32.f, s[6 * 65] * 32.f, s[7 * 65] * 32.f);
        o.z = pk_fp8x4(s[8 * 65] * 32.f, s[9 * 65] * 32.f, s[10 * 65] * 32.f, s[11 * 65] * 32.f); o.w = pk_fp8x4(s[12 * 65] * 32.f, s[13 * 65] * 32.f, s[14 * 65] * 32.f, s[15 * 65] * 32.f);
        *(u32x4*)(WT + (size_t)n * KBy + k0 + 16 * c) = o; }
    lds_wait();
}

DI void ttab_item(const float* wf, float* TTAB, int item, const LAS float* trg  , int lane) {
    const int ib = item & 7, gc = item >> 3, g = gc & 7, cs = gc >> 3;
    const float* wfg = wf + (size_t)g * 4096;
    float wv[64];
#pragma unroll
    for (int m = 0; m < 64; ++m) wv[m] = wfg[m * 64 + lane];
#pragma unroll 1
    for (int ii = 0; ii < 8; ++ii) { const int i = ib * 8 + ii; float t = 0.f;
#pragma unroll
        for (int m = 0; m < 64; ++m) t += trg[2 * ((m * i) & 63) + cs] * wv[m];
        TTAB[((size_t)gc * 64 + i) * 64 + lane] = t; }
}
DI void fold_item(const float* w_in, const float* TTAB, bf16_t* Win_t, int item, LAS float* scr  , int lane) {
    const int kb = item & 15, gc = item >> 4, g = gc & 7, cs = gc >> 3;
    { const f32x4* tp = (const f32x4*)(TTAB + (size_t)gc * 4096) + lane;
#pragma unroll
      for (int i = 0; i < 16; ++i) *(LAS f32x4*)(scr + 4 * (lane + 64 * i)) = tp[64 * i]; }
    lds_wait();
    bf16_t* dst = Win_t + (size_t)(cs * 512 + g * 64 + lane) * DM + kb * 64;
#pragma unroll 1
    for (int k8 = 0; k8 < 8; ++k8) {
        float a[8], wv[8];
#pragma unroll
        for (int q = 0; q < 8; ++q) { a[q] = 0.f; wv[q] = w_in[(size_t)(kb * 64 + k8 * 8 + q) * DIN + g * 64 + lane]; }
#pragma unroll
        for (int i = 0; i < 64; ++i) { const float t = scr[i * 64 + lane];
#pragma unroll
            for (int q = 0; q < 8; ++q) a[q] += __builtin_bit_cast(float, __builtin_amdgcn_readlane(__builtin_bit_cast(int, wv[q]), i)) * t; }
        u32x4 o; o.x = cvt_pk_bf16(a[0], a[1]); o.y = cvt_pk_bf16(a[2], a[3]); o.z = cvt_pk_bf16(a[4], a[5]); o.w = cvt_pk_bf16(a[6], a[7]);
        *(u32x4*)(dst + k8 * 8) = o;
    }
    lds_wait();
}

DI void phase0(Ctx& F) {
    relaunder(F);
    const float* c = kin(1); const float* c_ctx = kin(3); const float* w_ada = kin(4); const float* b_ada = kin(5);
    float* MOD = (float*)(F.ws + WS_MOD);
    if (F.bid < 96) {
        LAS float* SC = (LAS float*)F.lds;
        LAS float* RED = (LAS float*)(F.lds + 9 * 1024 * 4);
        for (int i = F.tid; i < 9 * 1024; i += 512) { const float v = (i < 8192) ? c[i] : c_ctx[i - 8192]; SC[i] = silu_f(v); }
        __syncthreads();
        for (int u = F.bid; u < 96; u += F.G) {
            const int n = u * 64 + F.lane;
            float a[9];
#pragma unroll
            for (int b = 0; b < 9; ++b) a[b] = 0.f;
            const float* wp = w_ada + (size_t)(F.wave * 128) * 6144 + n;
#pragma unroll 4
            for (int k = 0; k < 128; ++k) { const float w = wp[(size_t)k * 6144];
#pragma unroll
                for (int b = 0; b < 9; ++b) a[b] += SC[b * 1024 + F.wave * 128 + k] * w; }
#pragma unroll
            for (int b = 0; b < 9; ++b) RED[(F.wave * 9 + b) * 64 + F.lane] = a[b];
            __syncthreads();
            for (int i = F.tid; i < 9 * 64; i += 512) { float s = 0.f;
#pragma unroll
                for (int w = 0; w < 8; ++w) s += RED[w * 576 + i];
                const int b = i >> 6, nn = u * 64 + (i & 63); MOD[b * 6144 + nn] = s + b_ada[nn]; }
            __syncthreads();
        }
    }
    __syncthreads();
    LAS float* scr = (LAS float*)(F.lds + F.wave * TR_SCR);
    LAS float* trg = (LAS float*)(F.lds + 8 * TR_SCR);
    if (F.tid < 64) { float s, c; sincospif((float)F.tid * (1.f / 32.f), &s, &c); trg[2 * F.tid] = c; trg[2 * F.tid + 1] = s; }
    __syncthreads();
    const int gw = F.bid * 8 + F.wave, NGW = F.G * 8;
    const float* w_in = kin(7); const float* w_out = kin(15); const float* wf = kin(14);
    bf16_t* Win_t = (bf16_t*)(F.ws + WS_WIN); bf16_t* Wout_t = (bf16_t*)(F.ws + WS_WOUT);
    float* TTAB = (float*)(F.ws + WS_SS);
    constexpr int I_IN = 16 * 73, I_OUT = 32 * 16, I_FOLD = 128, I_ZERO = 208;
    for (int it = gw; it < I_IN + I_OUT + I_FOLD + I_ZERO; it += NGW) {
        int r = it;
        if (r < I_FOLD) { ttab_item(wf, TTAB, r, trg, F.lane); continue; } r -= I_FOLD;
        if (r < I_IN) { const int kb = r / 73, nb = r % 73; const int ncols = (nb == 72) ? 48 : 64;
            transpose_item(w_in, DIN, kb * 64, nb * 64, ncols, Win_t + (size_t)(nb * 64) * DM, DM, scr, F.lane); continue; } r -= I_IN;
        if (r < I_OUT) { const int kb = r / 16, nb = r % 16; transpose_item(w_out, DM, kb * 64, nb * 64, 64, Wout_t + (size_t)(nb * 64) * DMIX, DMIX, scr, F.lane, kb >= 8 ? kin(13) + (kb * 64 - 512) : nullptr); continue; }
        { u32x4 z = {0u, 0u, 0u, 0u}; u32x4* p = (u32x4*)(Win_t + (size_t)(4656 + r) * DM); p[F.lane] = z; p[F.lane + 64] = z; }
    }
}

DI void phase_h(Ctx& F) {
    relaunder(F);
    const float* x = kin(0); const float* ctx = kin(2); const float* nw = kin(6);
    const float* MOD = (const float*)(F.ws + WS_MOD);
    bf16_t* HALL = (bf16_t*)(F.ws + WS_R1);
    const int gw = F.bid * 8 + F.wave, NGW = F.G * 8;
    f32x4 nx[4];
    if (gw < NROWS) { const f32x4* xr = (const f32x4*)((gw < NTOK) ? x + (size_t)gw * DM : ctx + (size_t)(gw - NTOK) * DM) + F.lane;
#pragma unroll
        for (int j = 0; j < 4; ++j) nx[j] = xr[64 * j]; }
    for (int m = gw; m < NROWS; m += NGW) {
        const int b = (m < NTOK) ? (m >> 12) : 8;
        f32x4 v[4]; float s = 0.f;
#pragma unroll
        for (int j = 0; j < 4; ++j) v[j] = nx[j];
        { const int mn = m + NGW;
          if (mn < NROWS) { const f32x4* xr = (const f32x4*)((mn < NTOK) ? x + (size_t)mn * DM : ctx + (size_t)(mn - NTOK) * DM) + F.lane;
#pragma unroll
            for (int j = 0; j < 4; ++j) nx[j] = xr[64 * j]; } }
#pragma unroll
        for (int j = 0; j < 4; ++j) s += (v[j].x * v[j].x + v[j].y * v[j].y) + (v[j].z * v[j].z + v[j].w * v[j].w);
        const float rstd = rsqrtf(wave_sum(s) * (1.f / DM) + 1e-6f);
        const f32x4* w4 = (const f32x4*)nw + F.lane; const f32x4* sh4 = (const f32x4*)(MOD + b * 6144) + F.lane; const f32x4* sc4 = (const f32x4*)(MOD + b * 6144 + 1024) + F.lane;
        u32x2* o = (u32x2*)(HALL + (size_t)m * DM) + F.lane;
#pragma unroll
        for (int j = 0; j < 4; ++j) { const f32x4 w = w4[64 * j], sh = sh4[64 * j], sc = sc4[64 * j];
            const f32x4 h = (v[j] * rstd * w) * (sc + 1.f) + sh;
            u32x2 p; p.x = cvt_pk_bf16(h.x, h.y); p.y = cvt_pk_bf16(h.z, h.w); o[64 * j] = p; }
    }
}

struct EpiInProj {
    static constexpr bool PERM = true;
    bf16_t* FIN; bf16_t* ZS; bf16_t* XBC; float* DT; const float* dt_bias;
    DI void operator()(const f32x4 (&acc)[2][2][4][2], const pg8::Unit& u, int wr, int wc, int fr, int fq) const {
        const int row0 = u.pm * 256 + wr * 64 + fr, cl = wc * 32 + 8 * fq;
        if (u.pn < 18) {
            bf16_t* base; int ld, c0; bool act = false;
            if (u.pn < 2) { base = FIN; ld = 512; c0 = u.pn * 256; }
            else if (u.pn < 8) { base = ZS; ld = DSSM; c0 = (u.pn - 2) * 256; act = true; }
            else { base = XBC; ld = CONVD; c0 = (u.pn - 8) * 256; }
#pragma unroll
            for (int ai = 0; ai < 2; ++ai)
#pragma unroll
                for (int m = 0; m < 4; ++m) { bf16_t* rowp = base + (size_t)(row0 + ai * 128 + m * 16) * ld + c0 + cl;
#pragma unroll
                    for (int bj = 0; bj < 2; ++bj) { f32x4 v0 = acc[ai][bj][m][0], v1 = acc[ai][bj][m][1];
                        if (act) {
#pragma unroll
                            for (int j = 0; j < 4; ++j) { v0[j] = silu_f(v0[j]); v1[j] = silu_f(v1[j]); } }
                        u32x4 w; w.x = cvt_pk_bf16(v0[0], v0[1]); w.y = cvt_pk_bf16(v0[2], v0[3]); w.z = cvt_pk_bf16(v1[0], v1[1]); w.w = cvt_pk_bf16(v1[2], v1[3]);
                        *(u32x4*)(rowp + bj * 128) = w; } }
        } else if (cl < 48) {
            float bia[8];
#pragma unroll
            for (int q = 0; q < 8; ++q) bia[q] = dt_bias[cl + q];
#pragma unroll
            for (int ai = 0; ai < 2; ++ai)
#pragma unroll
                for (int m = 0; m < 4; ++m) { float* rowp = DT + (size_t)(row0 + ai * 128 + m * 16) * 48 + cl;
                    f32x4 o0, o1;
#pragma unroll
                    for (int j = 0; j < 4; ++j) { o0[j] = softplus_f(acc[ai][0][m][0][j] + bia[j]); o1[j] = softplus_f(acc[ai][0][m][1][j] + bia[4 + j]); }
                    *(f32x4*)rowp = o0; *(f32x4*)(rowp + 4) = o1; }
        }
    }
};

constexpr int FT_T = 0;
constexpr int FT_TAB = 73728;
constexpr int FT_TW = FT_TAB + 128 * 272;
constexpr int FT_TR = FT_TW + 512;
constexpr int F1_U = 0, F1_TT = 64 * 528, F1_TAB = F1_TT + 8 * 64 * 144, F1_TW = F1_TAB + 128 * 272, F1_TR = F1_TW + 512;
static_assert(F1_TR + 512 <= LDS_BYTES - 32, "FFT step 1 LDS layout");

DI bf16x8 tr_read2(unsigned a0, unsigned a1) {
    s16x4 lo, hi;
    asm volatile("ds_read_b64_tr_b16 %0, %2\n\tds_read_b64_tr_b16 %1, %3\n\ts_waitcnt lgkmcnt(0)" : "=&v"(lo), "=&v"(hi) : "v"(a0), "v"(a1) : "memory");
    return __builtin_shufflevector(lo, hi, 0, 1, 2, 3, 4, 5, 6, 7);
}
DI int crow(int reg, int h) { return (reg & 3) + 8 * (reg >> 2) + 4 * h; }

DI void fft_step1(Ctx& F) {
    relaunder(F);
    const bf16_t* FIN = (const bf16_t*)(F.ws + WS_R2); bf16_t* A1 = (bf16_t*)(F.ws + WS_R1); const float* TTAB = (const float*)(F.ws + WS_SS);
    LAS unsigned char* lds = F.lds;
    LAS float* TR = (LAS float*)(lds + F1_TR);
    const int chh = F.bid & 1;
    if (F.tid < 64) { float s, c; sincospif((float)F.tid * (1.f / 32.f), &s, &c); TR[2 * F.tid] = c; TR[2 * F.tid + 1] = s; }
    __syncthreads();
    for (int i = F.tid; i < 128 * 128; i += 512) { const int m = i >> 7, k = i & 127, ri = m >> 6, k1 = m & 63, cs = k >> 6, l1 = k & 63, t = (k1 * l1) & 63;
        const float c = TR[2 * t], s = TR[2 * t + 1]; const float v = (ri == 0) ? (cs == 0 ? c : -s) : (cs == 0 ? -s : -c);
        *(LAS bf16_t*)(lds + F1_TAB + m * 272 + k * 2) = f2bf(v); }
    for (int idx = F.tid; idx < 8 * 64 * 64; idx += 512) { const int j = idx & 63, i = (idx >> 6) & 63, gc = idx >> 12, gg = gc >> 1, cs = gc & 1;
        const float v = TTAB[((size_t)(cs * 8 + 4 * chh + gg) * 64 + i) * 64 + j];
        *(LAS bf16_t*)(lds + F1_TT + ((gg * 2 + cs) * 64 + j) * 144 + i * 2) = f2bf(v); }
    __syncthreads();
    const int lane = F.lane, w = F.wave, h = lane >> 5, c31 = lane & 31, gg = w >> 1, jb = w & 1;
    u32x4 pfv[4];
    if (F.bid < NB * 64 * 2) { const int u = F.bid, l2 = (u >> 1) & 63, b = u >> 7;
#pragma unroll
        for (int i = 0; i < 4; ++i) { const int idx = F.tid + 512 * i, row = idx >> 5, c16 = idx & 31;
            pfv[i] = *(const u32x4*)(FIN + (size_t)(b * SEQ + 64 * row + l2) * 512 + chh * 256 + c16 * 8); } }
    for (int u = F.bid; u < NB * 64 * 2; u += F.G) {
        const int l2 = (u >> 1) & 63, b = u >> 7;
        LAS float* TW = (LAS float*)(lds + F1_TW);
        if (F.tid < 64) { float s, c; sincospif((float)(F.tid * l2) * (1.f / 2048.f), &s, &c); TW[2 * F.tid] = c; TW[2 * F.tid + 1] = s; }
#pragma unroll
        for (int i = 0; i < 4; ++i) { const int idx = F.tid + 512 * i, row = idx >> 5, c16 = idx & 31; *(LAS u32x4*)(lds + F1_U + row * 528 + c16 * 16) = pfv[i]; }
        __syncthreads();
        { const int un = u + F.G;
          if (un < NB * 64 * 2) { const int l2n = (un >> 1) & 63, bn = un >> 7;
#pragma unroll
            for (int i = 0; i < 4; ++i) { const int idx = F.tid + 512 * i, row = idx >> 5, c16 = idx & 31;
                pfv[i] = *(const u32x4*)(FIN + (size_t)(bn * SEQ + 64 * row + l2n) * 512 + chh * 256 + c16 * 8); } } }
        f32x16 px[2][2];
#pragma unroll
        for (int rb = 0; rb < 2; ++rb)
#pragma unroll
            for (int cs = 0; cs < 2; ++cs) {
#pragma unroll
                for (int i = 0; i < 16; ++i) px[rb][cs][i] = 0.f;
#pragma unroll
                for (int ks = 0; ks < 4; ++ks) {
                    const bf16x8 af = *(const LAS bf16x8*)(lds + F1_U + (32 * rb + c31) * 528 + (gg * 64 + 16 * ks + 8 * h) * 2);
                    const bf16x8 bf = *(const LAS bf16x8*)(lds + F1_TT + ((gg * 2 + cs) * 64 + 32 * jb + c31) * 144 + (16 * ks + 8 * h) * 2);
                    px[rb][cs] = __builtin_amdgcn_mfma_f32_32x32x16_bf16(af, bf, px[rb][cs], 0, 0, 0);
                }
            }
        f32x16 acc[4];
#pragma unroll
        for (int rbo = 0; rbo < 4; ++rbo)
#pragma unroll
            for (int i = 0; i < 16; ++i) acc[rbo][i] = 0.f;
#pragma unroll
        for (int cs = 0; cs < 2; ++cs)
#pragma unroll
            for (int rb = 0; rb < 2; ++rb)
#pragma unroll
                for (int s2 = 0; s2 < 2; ++s2) {
                    u32x4 bw; bw.x = cvt_pk_bf16(px[rb][cs][8 * s2], px[rb][cs][8 * s2 + 1]); bw.y = cvt_pk_bf16(px[rb][cs][8 * s2 + 2], px[rb][cs][8 * s2 + 3]);
                    bw.z = cvt_pk_bf16(px[rb][cs][8 * s2 + 4], px[rb][cs][8 * s2 + 5]); bw.w = cvt_pk_bf16(px[rb][cs][8 * s2 + 6], px[rb][cs][8 * s2 + 7]);
                    const bf16x8 bfr = __builtin_bit_cast(bf16x8, bw);
                    const int kc = cs * 64 + 32 * rb + 16 * s2 + 4 * h;
#pragma unroll
                    for (int rbo = 0; rbo < 4; ++rbo) {
                        const LAS unsigned char* ap = lds + F1_TAB + (32 * rbo + c31) * 272 + kc * 2;
                        const u32x2 lo = *(const LAS u32x2*)ap, hi = *(const LAS u32x2*)(ap + 16);
                        const u32x4 aw = {lo.x, lo.y, hi.x, hi.y};
                        acc[rbo] = __builtin_amdgcn_mfma_f32_32x32x16_bf16(__builtin_bit_cast(bf16x8, aw), bfr, acc[rbo], 0, 0, 0);
                    }
                }
        const int ch = chh * 256 + 32 * w + c31;
#pragma unroll
        for (int rb = 0; rb < 2; ++rb)
#pragma unroll
            for (int r = 0; r < 16; ++r) { const int k1 = 32 * rb + crow(r, h); const float ct = TW[2 * k1], st = TW[2 * k1 + 1];
                const float ar = acc[rb][r], ai = acc[rb + 2][r];
                const float orr = (ar * ct + ai * st) * (1.f / 64.f), oi = (ai * ct - ar * st) * (1.f / 64.f);
                bf16_t* dst = A1 + ((size_t)((b * 64 + k1) * 2) * 64 + l2) * 512 + ch;
                dst[0] = f2bf(orr); dst[(size_t)64 * 512] = f2bf(oi); }
        __syncthreads();
    }
}

DI void fft_step2(Ctx& F) {
    relaunder(F);
    const bf16_t* A1 = (const bf16_t*)(F.ws + WS_R1); bf16_t* AO = (bf16_t*)(F.ws + WS_R4);
    LAS unsigned char* lds = F.lds;
    LAS float* TR = (LAS float*)(lds + FT_TR);
    if (F.tid < 64) { float s, c; sincospif((float)F.tid * (1.f / 32.f), &s, &c); TR[2 * F.tid] = c; TR[2 * F.tid + 1] = s; }
    __syncthreads();
    for (int i = F.tid; i < 64 * 128; i += 512) { const int k2 = i >> 7, k = i & 127, ri = k >> 6, l2 = k & 63, t = (k2 * l2) & 63;
        *(LAS bf16_t*)(lds + FT_TAB + k2 * 272 + k * 2) = f2bf(ri ? TR[2 * t + 1] : TR[2 * t]); }
    __syncthreads();
    const int lane = F.lane, w = F.wave, h = lane >> 5, blk = (lane >> 4) & 1, q = (lane & 15) >> 2, p = lane & 3;
    const unsigned tbase = (unsigned)(size_t)(lds + FT_T);
    for (int u = F.bid; u < NB * 64 * 2; u += F.G) {
        const int chh = u & 1, k1 = (u >> 1) & 63, b = u >> 7;
#pragma unroll
        for (int i = 0; i < 8; ++i) { const int idx = F.tid + 512 * i, row = idx >> 5, c16 = idx & 31;
            const u32x4 v = *(const u32x4*)(A1 + ((size_t)(b * 64 + k1) * 128 + row) * 512 + chh * 256 + c16 * 8);
            *(LAS u32x4*)(lds + FT_T + row * 576 + c16 * 16) = v; }
        __syncthreads();
        f32x16 acc[2];
#pragma unroll
        for (int rb = 0; rb < 2; ++rb)
#pragma unroll
            for (int i = 0; i < 16; ++i) acc[rb][i] = 0.f;
#pragma unroll
        for (int ks = 0; ks < 8; ++ks) {
            const unsigned a0 = tbase + (unsigned)((16 * ks + 8 * h + q) * 576 + (32 * w + 16 * blk + 4 * p) * 2);
            const bf16x8 bfrag = tr_read2(a0, a0 + 4 * 576);
#pragma unroll
            for (int rb = 0; rb < 2; ++rb) { const bf16x8 afrag = *(const LAS bf16x8*)(lds + FT_TAB + (32 * rb + (lane & 31)) * 272 + (16 * ks + 8 * h) * 2);
                acc[rb] = __builtin_amdgcn_mfma_f32_32x32x16_bf16(afrag, bfrag, acc[rb], 0, 0, 0); }
        }
        const int ch = chh * 256 + 32 * w + (lane & 31);
#pragma unroll
        for (int rb = 0; rb < 2; ++rb)
#pragma unroll
            for (int r = 0; r < 16; ++r) { const int k2 = 32 * rb + crow(r, h);
                AO[(size_t)(b * SEQ + k1 + 64 * k2) * DMIX + ch] = f2bf(acc[rb][r] * 0.125f); }
        __syncthreads();
    }
}

constexpr int CV_B = 0, CV_C = 128 * 272;
DI void unpack8(const u32x4 v, float (&f)[8]) {
    f[0] = __uint_as_float(v.x << 16); f[1] = __uint_as_float(v.x & 0xffff0000u); f[2] = __uint_as_float(v.y << 16); f[3] = __uint_as_float(v.y & 0xffff0000u);
    f[4] = __uint_as_float(v.z << 16); f[5] = __uint_as_float(v.z & 0xffff0000u); f[6] = __uint_as_float(v.w << 16); f[7] = __uint_as_float(v.w & 0xffff0000u);
}
DI void conv_cb_phase(Ctx& F) {
    relaunder(F);
    const bf16_t* XBC = (const bf16_t*)(F.ws + WS_R4);
    bf16_t* XS = (bf16_t*)(F.ws + WS_XS); bf16_t* BMg = (bf16_t*)(F.ws + WS_BM); bf16_t* CMg = (bf16_t*)(F.ws + WS_CM); bf16_t* CBG = (bf16_t*)(F.ws + WS_CB);
    const float* conv_w = kin(8); const float* conv_b = kin(9);
    LAS unsigned char* lds = F.lds;
    const int lane = F.lane, h = lane >> 5;
    for (int u = F.bid; u < NB * 34 * NG; u += F.G) {
        const int g = u & 3, c = (u >> 2) % 34, b = (u >> 2) / 34;
        const bool lat = c < 32;
        const int seqbase = lat ? b * SEQ : NTOK + b * CTXL, L = lat ? SEQ : CTXL, t0 = lat ? c * 128 : (c - 32) * 128;
#pragma unroll
        for (int pass = 0; pass < 2; ++pass) {
            constexpr int NT0 = 16, NT1 = 4;
            const int NT = pass == 0 ? NT0 : NT1;
            int chunk, seg;
            if (pass == 0) { chunk = F.tid & 63; seg = F.tid >> 6; } else { chunk = 64 + (F.tid & 15); seg = F.tid >> 4; }
            int scol, dcol, kind;
            if (chunk < 48) { kind = 0; scol = g * 384 + chunk * 8; dcol = scol; }
            else if (chunk < 64) { kind = 1; dcol = g * 128 + (chunk - 48) * 8; scol = 1536 + dcol; }
            else { kind = 2; dcol = g * 128 + (chunk - 64) * 8; scol = 2048 + dcol; }
            const int tb = t0 + seg * NT;
            u32x4 raw[NT0 + 4];
#pragma unroll
            for (int k = 0; k < NT0 + 4; ++k) if (k < NT + 4) { const int t = tb - 2 + k; u32x4 v = {0u, 0u, 0u, 0u};
                if (t >= 0 && t < L) v = *(const u32x4*)(XBC + (size_t)(seqbase + t) * CONVD + scol);
                raw[k] = v; }
            float w[5][8], bias[8];
#pragma unroll
            for (int k = 0; k < 5; ++k) { const f32x4 a = *(const f32x4*)(conv_w + k * CONVD + scol), bb = *(const f32x4*)(conv_w + k * CONVD + scol + 4);
                w[k][0] = a.x; w[k][1] = a.y; w[k][2] = a.z; w[k][3] = a.w; w[k][4] = bb.x; w[k][5] = bb.y; w[k][6] = bb.z; w[k][7] = bb.w; }
            { const f32x4 a = *(const f32x4*)(conv_b + scol), bb = *(const f32x4*)(conv_b + scol + 4);
              bias[0] = a.x; bias[1] = a.y; bias[2] = a.z; bias[3] = a.w; bias[4] = bb.x; bias[5] = bb.y; bias[6] = bb.z; bias[7] = bb.w; }
            float win[5][8];
#pragma unroll
            for (int k = 0; k < 4; ++k) unpack8(raw[k], win[k]);
#pragma unroll
            for (int j = 0; j < NT0; ++j) if (j < NT) {
                unpack8(raw[j + 4], win[4]);
                float o[8];
#pragma unroll
                for (int e = 0; e < 8; ++e) { float a = bias[e];
#pragma unroll
                    for (int k = 0; k < 5; ++k) a += w[k][e] * win[k][e];
                    o[e] = silu_f(a); }
                u32x4 pk; pk.x = cvt_pk_bf16(o[0], o[1]); pk.y = cvt_pk_bf16(o[2], o[3]); pk.z = cvt_pk_bf16(o[4], o[5]); pk.w = cvt_pk_bf16(o[6], o[7]);
                const size_t row = (size_t)(seqbase + tb + j); const int tl = seg * NT + j;
                (void)row;
                if (kind == 0) *(u32x4*)(XS + ((size_t)((b * 34 + c) * NH + g * 6 + (chunk >> 3)) * 128 + tl) * 64 + (chunk & 7) * 8) = pk;
                else if (kind == 1) { *(u32x4*)(BMg + ((size_t)((b * 34 + c) * NG + g) * 128 + tl) * 128 + (chunk - 48) * 8) = pk; *(LAS u32x4*)(lds + CV_B + tl * 272 + (chunk - 48) * 16) = pk; }
                else { *(u32x4*)(CMg + ((size_t)((b * 34 + c) * NG + g) * 128 + tl) * 128 + (chunk - 64) * 8) = pk; *(LAS u32x4*)(lds + CV_C + tl * 272 + (chunk - 64) * 16) = pk; }
#pragma unroll
                for (int k = 0; k < 4; ++k)
#pragma unroll
                    for (int e = 0; e < 8; ++e) win[k][e] = win[k + 1][e];
            }
        }
        if (F.wave < 6) {
            const int hd = 6 * g + F.wave; const float a_f = -__expf(kin(11)[hd]), a_b = -__expf(kin(11)[24 + hd]);
            const float* DT = (const float*)(F.ws + WS_R5); float* AR = (float*)(F.ws + WS_ARRS) + (size_t)((b * 34 + c) * NH + hd) * ARN;
            const size_t r0 = (size_t)(seqbase + t0);
            {
                const float d0 = DT[(r0 + 2 * lane) * 48 + hd], d1 = DT[(r0 + 2 * lane + 1) * 48 + hd], v0 = d0 * a_f, v1 = d1 * a_f; float s = v0 + v1;
#pragma unroll
                for (int o = 1; o < 64; o <<= 1) { const float t = __shfl_up(s, o); if (lane >= o) s += t; }
                const float ex = s - (v0 + v1), A0 = ex + v0, A1 = ex + v0 + v1, tot = __shfl(s, 63);
                *(f32v2*)(AR + 2 * lane) = (f32v2){A0, A1}; *(f32v2*)(AR + 128 + 2 * lane) = (f32v2){__logf(d0) - A0, __logf(d1) - A1};
                *(f32v2*)(AR + 896 + 2 * lane) = (f32v2){d0 * __expf(tot - A0), d1 * __expf(tot - A1)};
#pragma unroll 1
                for (int q = 1; q < 4; ++q) { int ln = lane; asm volatile("" : "+v"(ln)); const float R = __shfl(A1, 16 * q - 1);
                    if (ln < 16 * q) *(f32v2*)(AR + 512 + 16 * q * (q - 1) + 2 * ln) = (f32v2){d0 * __expf(R - A0), d1 * __expf(R - A1)}; }
            }
            {
                const int e0 = 127 - 2 * lane, e1 = 126 - 2 * lane;
                const float d0 = DT[(r0 + e0) * 48 + 24 + hd], d1 = DT[(r0 + e1) * 48 + 24 + hd], v0 = d0 * a_b, v1 = d1 * a_b; float s = v0 + v1;
#pragma unroll
                for (int o = 1; o < 64; o <<= 1) { const float t = __shfl_up(s, o); if (lane >= o) s += t; }
                const float ex = s - (v0 + v1), A0 = ex + v0, A1 = ex + v0 + v1, tot = __shfl(s, 63);
                *(f32v2*)(AR + 256 + e1) = (f32v2){A1, A0}; *(f32v2*)(AR + 384 + e1) = (f32v2){__logf(d1) - A1, __logf(d0) - A0};
                *(f32v2*)(AR + 1024 + e1) = (f32v2){d1 * __expf(tot - A1), d0 * __expf(tot - A0)};
#pragma unroll 1
                for (int q = 0; q < 3; ++q) { int ln = lane; asm volatile("" : "+v"(ln)); const float Q = __shfl(A1, 47 - 16 * q);
                    if (ln < 16 * (3 - q)) *(f32v2*)(AR + 704 + 96 * q - 16 * q * (q - 1) + (126 - 2 * ln - 32 * (q + 1))) = (f32v2){d1 * __expf(Q - A1), d0 * __expf(Q - A0)}; }
            }
        }
        __syncthreads();
        if (lat) {
#pragma unroll
            for (int bi = 0; bi < 2; ++bi) {
                const int blk = 2 * F.wave + bi, sb = blk >> 2, lb = blk & 3;
                f32x16 acc;
#pragma unroll
                for (int i = 0; i < 16; ++i) acc[i] = 0.f;
#pragma unroll
                for (int ks = 0; ks < 8; ++ks) {
                    const bf16x8 af = *(const LAS bf16x8*)(lds + CV_B + (32 * sb + (lane & 31)) * 272 + (16 * ks + 8 * h) * 2);
                    const bf16x8 bf = *(const LAS bf16x8*)(lds + CV_C + (32 * lb + (lane & 31)) * 272 + (16 * ks + 8 * h) * 2);
                    acc = __builtin_amdgcn_mfma_f32_32x32x16_bf16(af, bf, acc, 0, 0, 0);
                }
                u32x4 o0, o1;
                o0.x = cvt_pk_bf16(acc[0], acc[1]); o0.y = cvt_pk_bf16(acc[2], acc[3]); o0.z = cvt_pk_bf16(acc[4], acc[5]); o0.w = cvt_pk_bf16(acc[6], acc[7]);
                o1.x = cvt_pk_bf16(acc[8], acc[9]); o1.y = cvt_pk_bf16(acc[10], acc[11]); o1.z = cvt_pk_bf16(acc[12], acc[13]); o1.w = cvt_pk_bf16(acc[14], acc[15]);
                u32x4* dst = (u32x4*)(CBG + ((size_t)(((b * 32 + c) * 4 + g) * 16 + blk) * 64 + lane) * 16);
                dst[0] = o0; dst[1] = o1;
            }
        }
        __syncthreads();
    }
}

constexpr int SD_C = 0;
constexpr int SD_B = SD_C + 128 * 272;
constexpr int SD_X = SD_B + 128 * 288;
constexpr int SD_XW = SD_X + 128 * 192;
constexpr int SD_H = SD_XW + 128 * 192;
constexpr int SD_ARR = SD_H + 64 * 272;
constexpr int SD_Y = SD_ARR + (896 + 256) * 4;
static_assert(SD_Y + 128 * 144 <= LDS_BYTES - 16, "SSD LDS layout");
DI float bflo(unsigned w) { return __uint_as_float(w << 16); }
DI float bfhi(unsigned w) { return __uint_as_float(w & 0xffff0000u); }
DI void tr_read4(unsigned a0, unsigned a1, unsigned b0, unsigned b1, bf16x8& fa, bf16x8& fb) {
    s16x4 alo, ahi, blo, bhi;
    asm volatile("ds_read_b64_tr_b16 %0, %4\n\tds_read_b64_tr_b16 %1, %5\n\tds_read_b64_tr_b16 %2, %6\n\tds_read_b64_tr_b16 %3, %7\n\ts_waitcnt lgkmcnt(0)"
                 : "=&v"(alo), "=&v"(ahi), "=&v"(blo), "=&v"(bhi) : "v"(a0), "v"(a1), "v"(b0), "v"(b1) : "memory");
    fa = __builtin_shufflevector(alo, ahi, 0, 1, 2, 3, 4, 5, 6, 7); fb = __builtin_shufflevector(blo, bhi, 0, 1, 2, 3, 4, 5, 6, 7);
}
DI void tr_read_state4(unsigned b0, unsigned b1, s16x4 (&o)[16]) {
    asm volatile("ds_read_b64_tr_b16 %0, %16 offset:0\n\tds_read_b64_tr_b16 %1, %16 offset:768\n\tds_read_b64_tr_b16 %2, %17 offset:0\n\tds_read_b64_tr_b16 %3, %17 offset:1152\n\tds_read_b64_tr_b16 %4, %16 offset:3072\n\tds_read_b64_tr_b16 %5, %16 offset:3840\n\tds_read_b64_tr_b16 %6, %17 offset:4608\n\tds_read_b64_tr_b16 %7, %17 offset:5760\n\tds_read_b64_tr_b16 %8, %16 offset:6144\n\tds_read_b64_tr_b16 %9, %16 offset:6912\n\tds_read_b64_tr_b16 %10, %17 offset:9216\n\tds_read_b64_tr_b16 %11, %17 offset:10368\n\tds_read_b64_tr_b16 %12, %16 offset:9216\n\tds_read_b64_tr_b16 %13, %16 offset:9984\n\tds_read_b64_tr_b16 %14, %17 offset:13824\n\tds_read_b64_tr_b16 %15, %17 offset:14976\n\ts_waitcnt lgkmcnt(0)"
                 : "=&v"(o[0]), "=&v"(o[1]), "=&v"(o[2]), "=&v"(o[3]), "=&v"(o[4]), "=&v"(o[5]), "=&v"(o[6]), "=&v"(o[7]), "=&v"(o[8]), "=&v"(o[9]), "=&v"(o[10]), "=&v"(o[11]), "=&v"(o[12]), "=&v"(o[13]), "=&v"(o[14]), "=&v"(o[15]) : "v"(b0), "v"(b1) : "memory");
}
DI void tr_read_diag16(unsigned b0, unsigned b1, unsigned b2, unsigned b3, s16x4 (&o)[16]) {
    asm volatile("ds_read_b64_tr_b16 %0, %16 offset:0\n\tds_read_b64_tr_b16 %1, %16 offset:1536\n\tds_read_b64_tr_b16 %2, %16 offset:3072\n\tds_read_b64_tr_b16 %3, %16 offset:4608\n\tds_read_b64_tr_b16 %4, %17 offset:0\n\tds_read_b64_tr_b16 %5, %17 offset:1536\n\tds_read_b64_tr_b16 %6, %17 offset:3072\n\tds_read_b64_tr_b16 %7, %17 offset:4608\n\tds_read_b64_tr_b16 %8, %18 offset:0\n\tds_read_b64_tr_b16 %9, %18 offset:1536\n\tds_read_b64_tr_b16 %10, %18 offset:3072\n\tds_read_b64_tr_b16 %11, %18 offset:4608\n\tds_read_b64_tr_b16 %12, %19 offset:0\n\tds_read_b64_tr_b16 %13, %19 offset:1536\n\tds_read_b64_tr_b16 %14, %19 offset:3072\n\tds_read_b64_tr_b16 %15, %19 offset:4608\n\ts_waitcnt lgkmcnt(0)"
                 : "=&v"(o[0]), "=&v"(o[1]), "=&v"(o[2]), "=&v"(o[3]), "=&v"(o[4]), "=&v"(o[5]), "=&v"(o[6]), "=&v"(o[7]), "=&v"(o[8]), "=&v"(o[9]), "=&v"(o[10]), "=&v"(o[11]), "=&v"(o[12]), "=&v"(o[13]), "=&v"(o[14]), "=&v"(o[15]) : "v"(b0), "v"(b1), "v"(b2), "v"(b3) : "memory");
}
DI void tr_read_diag8(unsigned b0, unsigned b1, s16x4 (&o)[8]) {
    asm volatile("ds_read_b64_tr_b16 %0, %8 offset:0\n\tds_read_b64_tr_b16 %1, %8 offset:1536\n\tds_read_b64_tr_b16 %2, %8 offset:3072\n\tds_read_b64_tr_b16 %3, %8 offset:4608\n\tds_read_b64_tr_b16 %4, %9 offset:0\n\tds_read_b64_tr_b16 %5, %9 offset:1536\n\tds_read_b64_tr_b16 %6, %9 offset:3072\n\tds_read_b64_tr_b16 %7, %9 offset:4608\n\ts_waitcnt lgkmcnt(0)"
                 : "=&v"(o[0]), "=&v"(o[1]), "=&v"(o[2]), "=&v"(o[3]), "=&v"(o[4]), "=&v"(o[5]), "=&v"(o[6]), "=&v"(o[7]) : "v"(b0), "v"(b1) : "memory");
}
struct SsdPF { u32x4 c[4], b[4], x[2], yz[4]; float w[2]; f32v2 arr; };

DI void ssd_unit(Ctx& F, const int b, const int hd) {
    relaunder(F);
    const bf16_t* XS = (const bf16_t*)(F.ws + WS_XS); const bf16_t* BMg = (const bf16_t*)(F.ws + WS_BM); const bf16_t* CMg = (const bf16_t*)(F.ws + WS_CM);
    const bf16_t* CBG = (const bf16_t*)(F.ws + WS_CB); const float* ARRS = (const float*)(F.ws + WS_ARRS);
    bf16_t* AO = (bf16_t*)(F.ws + WS_R4); const bf16_t* ZS = (const bf16_t*)F.out; float* SS = (float*)(F.ws + WS_SS);
    LAS unsigned char* lds = F.lds;
    LAS float* ARR = (LAS float*)(lds + SD_ARR);
    LAS float *AF = ARR, *LF = ARR + 128, *ABS = ARR + 256, *LB = ARR + 384, *SSP = ARR + 896;
    const int g = hd / 6, tid = F.tid, lane = F.lane, wave = F.wave;
    const int pb = wave >> 2, lb = wave & 3, h = lane >> 5, blk = (lane >> 4) & 1, q = (lane & 15) >> 2, pp = lane & 3, c31 = lane & 31;
    const float dsk = kin(12)[hd];
    const unsigned xbase = (unsigned)(size_t)(lds + SD_X), xwbase = (unsigned)(size_t)(lds + SD_XW), bbase = (unsigned)(size_t)(lds + SD_B);
    const int l = 32 * lb + c31;
#define SSD_CHUNK(dir_, step_) ((dir_) == 0 ? ((step_) >= 2 ? (step_) - 2 : 32 + (step_)) : 33 - (step_))
#define SSD_ROW0(c_) (((c_) < 32) ? b * SEQ + (c_) * 128 : NTOK + b * CTXL + ((c_) - 32) * 128)
#define SSD_ISSUE(pf, dir_, step_) do { const int c_ = SSD_CHUNK(dir_, step_), row0_ = SSD_ROW0(c_); const bool lat_ = (step_) >= 2; \
        const float* ar_ = ARRS + (size_t)((b * 34 + c_) * NH + hd) * ARN; \
        _Pragma("unroll") for (int i = 0; i < 4; ++i) { const int idx = tid + 512 * i, r = idx >> 4, c16 = idx & 15; \
            if (lat_) pf.c[i] = *(const u32x4*)(CMg + (size_t)((b * 34 + c_) * NG + g) * 16384 + (size_t)idx * 8); \
            pf.b[i] = *(const u32x4*)(BMg + (size_t)((b * 34 + c_) * NG + g) * 16384 + (size_t)idx * 8); (void)r; (void)c16; } \
        _Pragma("unroll") for (int i = 0; i < 2; ++i) { const int idx = tid + 512 * i, r = idx >> 3, c16 = idx & 7; \
            pf.x[i] = *(const u32x4*)(XS + (size_t)((b * 34 + c_) * NH + hd) * 8192 + (size_t)idx * 8); pf.w[i] = ar_[((dir_) ? 1024 : 896) + r]; \
            if (lat_ && (dir_) == 1) { pf.yz[i] = *(const u32x4*)(AO + (size_t)(row0_ + r) * DMIX + 512 + hd * 64 + c16 * 8); pf.yz[2 + i] = *(const u32x4*)(ZS + (size_t)(row0_ + r) * DSSM + hd * 64 + c16 * 8); } } \
        if (tid < ((dir_) ? 256 : 448)) pf.arr = *(const f32v2*)(ar_ + 2 * tid); \
    } while (0)
#define SSD_ISSUE2(cbr, step_) do { const int c_ = SSD_CHUNK(0, step_); \
        const u32x4* cbp = (const u32x4*)(CBG + ((size_t)(((b * 32 + c_) * 4 + g) * 16 + lb) * 64 + lane) * 16); \
        _Pragma("unroll") for (int d = 0; d < 4; ++d) { const int sb = (lb + d) & 3; cbr[2 * d] = cbp[(size_t)sb * 512]; cbr[2 * d + 1] = cbp[(size_t)sb * 512 + 1]; } \
    } while (0)

#pragma unroll 1
    for (int dir = 0; dir < 2; ++dir) {
        f32x16 Hacc;
#pragma unroll
        for (int i = 0; i < 16; ++i) Hacc[i] = 0.f;
        SsdPF pf;
        u32x4 cbr[8];
#pragma unroll
        for (int i = 0; i < 8; ++i) cbr[i] = (u32x4){0u, 0u, 0u, 0u};
        u32x4 ytmp[2] = {(u32x4){0u, 0u, 0u, 0u}, (u32x4){0u, 0u, 0u, 0u}}; float sstmp = 0.f; int prow0 = 0; bool pylat = false;
        SSD_ISSUE(pf, dir, 0);
#pragma unroll 1
        for (int step = 0; step < 34; ++step) {
            const bool lat = step >= 2;
            const int c = SSD_CHUNK(dir, step), row0 = SSD_ROW0(c);
            if (lat) {
#pragma unroll
                for (int i = 0; i < 4; ++i) { const int idx = tid + 512 * i, r = idx >> 4, c16 = idx & 15; *(LAS u32x4*)(lds + SD_C + r * 272 + c16 * 16) = pf.c[i]; }
            }
#pragma unroll
            for (int i = 0; i < 4; ++i) { const int idx = tid + 512 * i, r = idx >> 4, c16 = idx & 15; *(LAS u32x4*)(lds + SD_B + r * 288 + c16 * 16) = pf.b[i]; }
#pragma unroll
            for (int i = 0; i < 2; ++i) { const int idx = tid + 512 * i, r = idx >> 3, c16 = idx & 7;
                if (dir == 0) *(LAS u32x4*)(lds + SD_X + r * 192 + c16 * 16) = pf.x[i];
                else if (lat) { *(LAS u32x4*)(lds + SD_X + r * 144 + c16 * 16) = pf.yz[i]; *(LAS u32x4*)(lds + SD_Y + r * 144 + c16 * 16) = pf.yz[2 + i]; }
                float f[8]; unpack8(pf.x[i], f); const float wv = pf.w[i];
                u32x4 o; o.x = cvt_pk_bf16(f[0] * wv, f[1] * wv); o.y = cvt_pk_bf16(f[2] * wv, f[3] * wv); o.z = cvt_pk_bf16(f[4] * wv, f[5] * wv); o.w = cvt_pk_bf16(f[6] * wv, f[7] * wv);
                *(LAS u32x4*)(lds + SD_XW + r * 192 + c16 * 16) = o; }
            if (tid < (dir ? 256 : 448)) *(LAS f32v2*)(ARR + 2 * tid) = pf.arr;
#pragma unroll
            for (int r = 0; r < 16; ++r) *(LAS bf16_t*)(lds + SD_H + (32 * pb + crow(r, h)) * 272 + (32 * lb + c31) * 2) = f2bf(Hacc[r]);
            if (pylat) {
#pragma unroll
                for (int i = 0; i < 2; ++i) { const int idx = tid + 512 * i, r = idx >> 3, c16 = idx & 7;
                    *(u32x4*)(AO + (size_t)(prow0 + r) * DMIX + 512 + hd * 64 + c16 * 8) = ytmp[i]; }
                if (dir == 1 && tid < 128) SS[(size_t)(prow0 + tid) * NH + hd] = sstmp;
            }
            lds_barrier();
            if (step + 1 < 34) SSD_ISSUE(pf, dir, step + 1);
            if (lat) {
                f32x16 y;
#pragma unroll
                for (int i = 0; i < 16; ++i) y[i] = 0.f;
                {
#pragma unroll
                    for (int half = 0; half < 2; ++half) {
                        bf16x8 afv[4], bfv[4];
#pragma unroll
                        for (int k4 = 0; k4 < 4; ++k4) { const int ks = 4 * half + k4; afv[k4] = *(const LAS bf16x8*)(lds + SD_H + (32 * pb + c31) * 272 + (16 * ks + 8 * h) * 2);
                            bfv[k4] = *(const LAS bf16x8*)(lds + SD_C + l * 272 + (16 * ks + 8 * h) * 2); }
                        asm volatile("s_waitcnt lgkmcnt(0)" ::: "memory");
#pragma unroll
                        for (int k4 = 0; k4 < 4; ++k4) y = __builtin_amdgcn_mfma_f32_32x32x16_bf16(afv[k4], bfv[k4], y, 0, 0, 0);
                    }
                }
                const float AFl = AF[l], ABSl = ABS[l];
                const float sc = __expf(dir ? ABSl : AFl);
#pragma unroll
                for (int i = 0; i < 16; ++i) y[i] *= sc;
                if (dir == 0) {
                    int c31v = c31, hv = h; asm volatile("" : "+v"(c31v), "+v"(hv));
                    s16x4 xf[8];
                    const unsigned xcol = xbase + (unsigned)((4 * hv + q) * 192 + (32 * pb + 16 * blk + 4 * pp) * 2);
#pragma unroll
                    for (int d = 0; d < 4; ++d) {
                        const int sb = (lb + d) & 3;
                        if ((d & 1) == 0) tr_read_diag8(xcol + (unsigned)(sb * 32 * 192), xcol + (unsigned)(((sb + 1) & 3) * 32 * 192), xf);
                        const unsigned cw[8] = {cbr[2 * d].x, cbr[2 * d].y, cbr[2 * d].z, cbr[2 * d].w, cbr[2 * d + 1].x, cbr[2 * d + 1].y, cbr[2 * d + 1].z, cbr[2 * d + 1].w};
                        float mt[16];
                        if (d == 0) {
                            const float ddg = __expf(AFl + LF[l]) + __expf(ABSl + LB[l]);
#pragma unroll
                            for (int r = 0; r < 16; ++r) {
                                const int sl = crow(r, hv), s = 32 * sb + sl;
                                const float cb = (r & 1) ? bfhi(cw[r >> 1]) : bflo(cw[r >> 1]);
                                const float wo = __expf(sl < c31v ? AFl + LF[s] : ABSl + LB[s]);
                                mt[r] = (sl == c31v) ? cb * ddg + dsk : cb * wo;
                            }
                        } else {
                            const bool fw = sb < lb;
                            const LAS float* Ep = fw ? ARR + 512 + (lb == 3 ? 96 : (lb == 2 ? 32 : 0)) + 32 * sb : ARR + 704 + (lb == 0 ? 0 : (lb == 1 ? 96 : 160)) + 32 * (sb - lb - 1);
                            const float el = fw ? __expf(AFl - AF[32 * lb - 1]) : __expf(ABSl - ABS[32 * lb + 32]);
#pragma unroll
                            for (int r = 0; r < 16; ++r) {
                                const float cb = (r & 1) ? bfhi(cw[r >> 1]) : bflo(cw[r >> 1]);
                                mt[r] = (cb * el) * Ep[crow(r, hv)];
                            }
                        }
#pragma unroll
                        for (int s2 = 0; s2 < 2; ++s2) {
                            u32x4 bw; bw.x = cvt_pk_bf16(mt[8 * s2], mt[8 * s2 + 1]); bw.y = cvt_pk_bf16(mt[8 * s2 + 2], mt[8 * s2 + 3]);
                            bw.z = cvt_pk_bf16(mt[8 * s2 + 4], mt[8 * s2 + 5]); bw.w = cvt_pk_bf16(mt[8 * s2 + 6], mt[8 * s2 + 7]);
                            const bf16x8 bfr = __builtin_bit_cast(bf16x8, bw);
                            const bf16x8 afr = __builtin_shufflevector(xf[4 * (d & 1) + 2 * s2], xf[4 * (d & 1) + 2 * s2 + 1], 0, 1, 2, 3, 4, 5, 6, 7);
                            y = __builtin_amdgcn_mfma_f32_32x32x16_bf16(afr, bfr, y, 0, 0, 0);
                        }
                        asm volatile("" ::: "memory");
                    }
#pragma unroll
                    for (int g4 = 0; g4 < 4; ++g4) { u32x2 o; o.x = cvt_pk_bf16(y[4 * g4], y[4 * g4 + 1]); o.y = cvt_pk_bf16(y[4 * g4 + 2], y[4 * g4 + 3]); *(LAS u32x2*)(lds + SD_Y + l * 144 + (32 * pb + 8 * g4 + 4 * h) * 2) = o; }
                } else {
                    float ssq = 0.f;
#pragma unroll
                    for (int g4 = 0; g4 < 4; ++g4) {
                        const u32x2 yf = *(const LAS u32x2*)(lds + SD_X + l * 144 + (32 * pb + 8 * g4 + 4 * h) * 2), zz = *(const LAS u32x2*)(lds + SD_Y + l * 144 + (32 * pb + 8 * g4 + 4 * h) * 2);
                        const float o0 = (y[4 * g4] + bflo(yf.x)) * bflo(zz.x), o1 = (y[4 * g4 + 1] + bfhi(yf.x)) * bfhi(zz.x);
                        const float o2 = (y[4 * g4 + 2] + bflo(yf.y)) * bflo(zz.y), o3 = (y[4 * g4 + 3] + bfhi(yf.y)) * bfhi(zz.y);
                        ssq += (o0 * o0 + o1 * o1) + (o2 * o2 + o3 * o3);
                        u32x2 o; o.x = cvt_pk_bf16(o0, o1); o.y = cvt_pk_bf16(o2, o3); *(LAS u32x2*)(lds + SD_X + l * 144 + (32 * pb + 8 * g4 + 4 * h) * 2) = o;
                    }
                    ssq += __shfl_xor(ssq, 32);
                    if (lane < 32) SSP[pb * 128 + l] = ssq;
                }
            }
            if (dir == 0 && step + 1 < 34 && step + 1 >= 2) SSD_ISSUE2(cbr, step + 1);
            {
                const float dec = __expf(dir ? ABS[0] : AF[127]);
#pragma unroll
                for (int i = 0; i < 16; ++i) Hacc[i] *= dec;
                const unsigned ab = xwbase + (unsigned)((8 * h + q) * 192 + (32 * pb + 16 * blk + 4 * pp) * 2);
                const unsigned bb = bbase + (unsigned)((8 * h + q) * 288 + (32 * lb + 16 * blk + 4 * pp) * 2);
#pragma unroll
                for (int half = 0; half < 2; ++half) {
                    s16x4 f[16];
                    tr_read_state4(ab + half * 4 * 3072, bb + half * 4 * 4608, f);
#pragma unroll
                    for (int ks = 0; ks < 4; ++ks) {
                        const bf16x8 afr = __builtin_shufflevector(f[4 * ks], f[4 * ks + 1], 0, 1, 2, 3, 4, 5, 6, 7), bfr = __builtin_shufflevector(f[4 * ks + 2], f[4 * ks + 3], 0, 1, 2, 3, 4, 5, 6, 7);
                        Hacc = __builtin_amdgcn_mfma_f32_32x32x16_bf16(afr, bfr, Hacc, 0, 0, 0);
                    }
                }
            }
            lds_barrier();
            pylat = lat; prow0 = row0;
            if (lat) {
                const int ybase = dir ? SD_X : SD_Y;
#pragma unroll
                for (int i = 0; i < 2; ++i) { const int idx = tid + 512 * i, r = idx >> 3, c16 = idx & 7; ytmp[i] = *(const LAS u32x4*)(lds + ybase + r * 144 + c16 * 16); }
                if (dir == 1 && tid < 128) sstmp = SSP[tid] + SSP[128 + tid];
            }
        }
        if (pylat) {
#pragma unroll
            for (int i = 0; i < 2; ++i) { const int idx = tid + 512 * i, r = idx >> 3, c16 = idx & 7;
                *(u32x4*)(AO + (size_t)(prow0 + r) * DMIX + 512 + hd * 64 + c16 * 8) = ytmp[i]; }
            if (dir == 1 && tid < 128) SS[(size_t)(prow0 + tid) * NH + hd] = sstmp;
        }
        asm volatile("s_waitcnt vmcnt(0)" ::: "memory");
        __syncthreads();
    }
#undef SSD_ISSUE
#undef SSD_ISSUE2
#undef SSD_CHUNK
#undef SSD_ROW0
}

struct EpiOutProj {
    static constexpr bool PERM = true;
    const float* x; const float* MOD; bf16_t* x1;
    DI void operator()(const f32x4 (&acc)[2][2][4][2], const pg8::Unit& u, int wr, int wc, int fr, int fq) const {
        const int row0 = u.pm * 256 + wr * 64 + fr, col0 = u.pn * 256 + wc * 32 + 8 * fq;
        const int b = (u.pm * 256) >> 12;
        f32x4 g[2][2];
#pragma unroll
        for (int bj = 0; bj < 2; ++bj)
#pragma unroll
            for (int n = 0; n < 2; ++n) g[bj][n] = *(const f32x4*)(MOD + b * 6144 + 2048 + col0 + bj * 128 + n * 4);
#pragma unroll
        for (int ai = 0; ai < 2; ++ai)
#pragma unroll
            for (int m = 0; m < 4; ++m) { const size_t off = (size_t)(row0 + ai * 128 + m * 16) * DM + col0;
#pragma unroll
                for (int bj = 0; bj < 2; ++bj) { const f32x4 x0 = *(const f32x4*)(x + off + bj * 128), x4 = *(const f32x4*)(x + off + bj * 128 + 4);
                    const f32x4 v0 = x0 + g[bj][0] * acc[ai][bj][m][0], v1 = x4 + g[bj][1] * acc[ai][bj][m][1];
                    u32x4 w; w.x = cvt_pk_bf16(v0[0], v0[1]); w.y = cvt_pk_bf16(v0[2], v0[3]); w.z = cvt_pk_bf16(v1[0], v1[1]); w.w = cvt_pk_bf16(v1[2], v1[3]);
                    *(u32x4*)(x1 + off + bj * 128) = w; } }
    }
};

constexpr int RT_WP = 1032;
constexpr int RT_WL = 16 * RT_WP * 2, RT_MW = 2 * RT_WL, RT_SH = RT_MW + 4096;
DI void phase_router(Ctx& F) {
    relaunder(F);
    const float* nw = kin(16); const float* wr = kin(17);
    const float* MOD = (const float*)(F.ws + WS_MOD);
    unsigned char* H2 = F.ws + WS_H2; float* PROBS = (float*)(F.ws + WS_PROBS); int* INV = (int*)(F.ws + WS_INV);
    const bf16_t* X1 = (const bf16_t*)(F.ws + WS_X1);
    LAS unsigned char* lds = F.lds;
    const int lane = F.lane, r = lane & 15, kq = lane >> 4;
    const int row0 = (F.bid * 8 + F.wave) * 16, b = row0 >> 12;
    u32x4 xa[16], xb[16];
    { const u32x4* xp = (const u32x4*)(X1 + (size_t)(row0 + r) * DM + 16 * kq);
#pragma unroll
      for (int p = 0; p < 16; ++p) { xa[p] = xp[8 * p]; xb[p] = xp[8 * p + 1]; } }
#pragma unroll 4
    for (int i = F.tid; i < 16 * 1024; i += 512) { const int d = i >> 4, e = i & 15; const float w = wr[i]; const bf16_t hi = f2bf(w);
        *(LAS bf16_t*)(lds + (e * RT_WP + d) * 2) = hi; *(LAS bf16_t*)(lds + RT_WL + (e * RT_WP + d) * 2) = f2bf(w - bf2f(hi)); }
    for (int i = F.tid; i < 1024; i += 512) { *(LAS float*)(lds + RT_MW + 4 * i) = nw[i] * (MOD[b * 6144 + 4096 + i] + 1.f); *(LAS float*)(lds + RT_SH + 4 * i) = MOD[b * 6144 + 3072 + i]; }
    __syncthreads();
    float s = 0.f;
#pragma unroll
    for (int p = 0; p < 16; ++p) {
        const unsigned wv[8] = {xa[p].x, xa[p].y, xa[p].z, xa[p].w, xb[p].x, xb[p].y, xb[p].z, xb[p].w};
#pragma unroll
        for (int i = 0; i < 8; ++i) { const float lo = bflo(wv[i]), hi = bfhi(wv[i]); s += lo * lo + hi * hi; } }
#pragma unroll
    for (int p = 0; p < 16; ++p) asm volatile("" : "+v"(xa[p]), "+v"(xb[p]));
    s += __shfl_xor(s, 16); s += __shfl_xor(s, 32);
    const float rstd = rsqrtf(s * (1.f / DM) + 1e-6f);
    f32x4 acc = {0.f, 0.f, 0.f, 0.f};
    unsigned char* orow = H2 + (size_t)(row0 + r) * DM + 16 * kq;
#pragma unroll
    for (int p = 0; p < 16; ++p) {
        const unsigned wv[8] = {xa[p].x, xa[p].y, xa[p].z, xa[p].w, xb[p].x, xb[p].y, xb[p].z, xb[p].w};
        int kb = 16 * kq; { float a0 = acc[0]; asm volatile("" : "+v"(kb), "+v"(a0)); acc[0] = a0; }
        float h[16];
#pragma unroll
        for (int q4 = 0; q4 < 4; ++q4) { const f32x4 mw = *(const LAS f32x4*)(lds + RT_MW + (64 * p + kb + 4 * q4) * 4), sh = *(const LAS f32x4*)(lds + RT_SH + (64 * p + kb + 4 * q4) * 4);
            h[4 * q4] = (bflo(wv[2 * q4]) * rstd) * mw.x + sh.x; h[4 * q4 + 1] = (bfhi(wv[2 * q4]) * rstd) * mw.y + sh.y;
            h[4 * q4 + 2] = (bflo(wv[2 * q4 + 1]) * rstd) * mw.z + sh.z; h[4 * q4 + 3] = (bfhi(wv[2 * q4 + 1]) * rstd) * mw.w + sh.w; }
        u32x4 o; o.x = pk_fp8x4(h[0], h[1], h[2], h[3]); o.y = pk_fp8x4(h[4], h[5], h[6], h[7]); o.z = pk_fp8x4(h[8], h[9], h[10], h[11]); o.w = pk_fp8x4(h[12], h[13], h[14], h[15]);
        *(u32x4*)(orow + 64 * p) = o;
#pragma unroll
        for (int half = 0; half < 2; ++half) {
            u32x4 ah, al;
            unsigned hw[4], lw[4];
#pragma unroll
            for (int i = 0; i < 4; ++i) { const float f0 = h[8 * half + 2 * i], f1 = h[8 * half + 2 * i + 1]; hw[i] = cvt_pk_bf16(f0, f1); lw[i] = cvt_pk_bf16(f0 - bflo(hw[i]), f1 - bfhi(hw[i])); }
            ah.x = hw[0]; ah.y = hw[1]; ah.z = hw[2]; ah.w = hw[3]; al.x = lw[0]; al.y = lw[1]; al.z = lw[2]; al.w = lw[3];
            const bf16x8 bh = *(const LAS bf16x8*)(lds + (r * RT_WP + 64 * p + kb + 8 * half) * 2), bl = *(const LAS bf16x8*)(lds + RT_WL + (r * RT_WP + 64 * p + kb + 8 * half) * 2);
            const bf16x8 ahv = __builtin_bit_cast(bf16x8, ah), alv = __builtin_bit_cast(bf16x8, al);
            acc = __builtin_amdgcn_mfma_f32_16x16x32_bf16(ahv, bh, acc, 0, 0, 0);
            acc = __builtin_amdgcn_mfma_f32_16x16x32_bf16(ahv, bl, acc, 0, 0, 0);
            acc = __builtin_amdgcn_mfma_f32_16x16x32_bf16(alv, bh, acc, 0, 0, 0);
        }
    }
    f32x4 pr;
#pragma unroll
    for (int j = 0; j < 4; ++j) { float mx = acc[j];
        mx = fmaxf(mx, __shfl_xor(mx, 1)); mx = fmaxf(mx, __shfl_xor(mx, 2)); mx = fmaxf(mx, __shfl_xor(mx, 4)); mx = fmaxf(mx, __shfl_xor(mx, 8));
        const float ex = expf(acc[j] - mx); float den = ex;
        den += __shfl_xor(den, 1); den += __shfl_xor(den, 2); den += __shfl_xor(den, 4); den += __shfl_xor(den, 8);
        pr[j] = ex / den; }
    *(f32x4*)(PROBS + (size_t)(b * 16 + r) * SEQ + (row0 & 4095) + 4 * kq) = pr;
#pragma unroll
    for (int j = 0; j < 4; ++j) INV[(size_t)(row0 + 4 * kq + j) * 16 + r] = -1;
}

DI void moe_weight_items(Ctx& F, int w, int nw) {
    relaunder(F);
    const int lane = F.lane;
    LAS float* scr = (LAS float*)(F.lds + F.wave * TR_SCR);
    const float* w_gate = kin(18); const float* w_up = kin(19); const float* w_down = kin(20);
    unsigned char* Wgu = F.ws + WS_WGU; unsigned char* Wd = F.ws + WS_WD;
    constexpr int I_G = NE * 16 * 32, I_D = NE * 32 * 16;
    for (int it = w; it < 2 * I_G + I_D; it += nw) {
        int r = it;
        if (r < 2 * I_G) { const int up = r >= I_G; if (up) r -= I_G; const int e = r / 512, kb = (r % 512) / 32, nb = r % 32, f0 = nb * 64;
            transpose_item_f8((up ? w_up : w_gate) + (size_t)e * DM * DEXP, DEXP, kb * 64, f0, Wgu + ((size_t)e * 4096 + (f0 >> 7) * 256 + (f0 & 127) + up * 128) * DM, DM, scr, lane); continue; }
        r -= 2 * I_G;
        { const int e = r / 512, kb = (r % 512) / 16, nb = r % 16;
          transpose_item_f8(w_down + (size_t)e * DEXP * DM, DM, kb * 64, nb * 64, Wd + ((size_t)e * DM + nb * 64) * DEXP, DEXP, scr, lane); }
    }
}

DI void phase_topk(Ctx& F) {
    relaunder(F);
    const float* PROBS = (const float*)(F.ws + WS_PROBS); int* ROWMAP = (int*)(F.ws + WS_ROWMAP); float* VAL = (float*)(F.ws + WS_VAL); int* INV = (int*)(F.ws + WS_INV);
    LAS unsigned* HIST = (LAS unsigned*)F.lds;
    LAS unsigned* CTL = HIST + 256;
    LAS unsigned* WS1 = HIST + 272;
    const int tid = F.tid, lane = F.lane, wave = F.wave;
    for (int u = F.bid; u < NB * NE; u += F.G) {
        const int b = u >> 4, e = u & 15;
        const float* pr = PROBS + (size_t)u * SEQ + tid * 8;
        const f32x4 p0 = *(const f32x4*)pr, p1 = *(const f32x4*)(pr + 4);
        unsigned key[8] = {__float_as_uint(p0.x), __float_as_uint(p0.y), __float_as_uint(p0.z), __float_as_uint(p0.w), __float_as_uint(p1.x), __float_as_uint(p1.y), __float_as_uint(p1.z), __float_as_uint(p1.w)};
        unsigned prefix = 0u, kk = CAP;
        for (int pass = 0; pass < 4; ++pass) {
            const int shift = 24 - 8 * pass;
            if (tid < 256) HIST[tid] = 0u;
            __syncthreads();
            const unsigned himask = pass == 0 ? 0u : (0xffffffffu << (shift + 8));
#pragma unroll
            for (int i = 0; i < 8; ++i) if ((key[i] & himask) == prefix) __hip_atomic_fetch_add(&HIST[(key[i] >> shift) & 255u], 1u, __ATOMIC_RELAXED, __HIP_MEMORY_SCOPE_WORKGROUP);
            __syncthreads();
            if (wave == 0) {
                const unsigned h0 = HIST[4 * lane], h1 = HIST[4 * lane + 1], h2 = HIST[4 * lane + 2], h3 = HIST[4 * lane + 3];
                const unsigned tot = h0 + h1 + h2 + h3; unsigned sfx = tot;
#pragma unroll
                for (int o = 1; o < 64; o <<= 1) { const unsigned t = __shfl_down(sfx, o); if (lane + o < 64) sfx += t; }
                const unsigned above = sfx - tot;
                const unsigned a3 = above, a2 = a3 + h3, a1 = a2 + h2, a0 = a1 + h1;
                int bin = -1; unsigned cum = 0u;
                if (a3 < kk && kk <= a3 + h3) { bin = 4 * lane + 3; cum = a3; }
                else if (a2 < kk && kk <= a2 + h2) { bin = 4 * lane + 2; cum = a2; }
                else if (a1 < kk && kk <= a1 + h1) { bin = 4 * lane + 1; cum = a1; }
                else if (a0 < kk && kk <= a0 + h0) { bin = 4 * lane; cum = a0; }
                if (bin >= 0) { CTL[0] = prefix | ((unsigned)bin << shift); CTL[1] = kk - cum; }
            }
            __syncthreads();
            prefix = CTL[0]; kk = CTL[1];
            __syncthreads();
        }
        int ceq = 0;
#pragma unroll
        for (int i = 0; i < 8; ++i) ceq += (key[i] == prefix);
        int seq = ceq;
#pragma unroll
        for (int o = 1; o < 64; o <<= 1) { const int t = __shfl_up(seq, o); if (lane >= o) seq += t; }
        if (lane == 63) WS1[wave] = (unsigned)seq;
        __syncthreads();
        int eqbase = seq - ceq;
        for (int w = 0; w < wave; ++w) eqbase += (int)WS1[w];
        int csel = 0; unsigned selmask = 0u; int er = eqbase;
#pragma unroll
        for (int i = 0; i < 8; ++i) { bool s = key[i] > prefix; if (key[i] == prefix) { s = (unsigned)er < kk; ++er; } if (s) { selmask |= 1u << i; ++csel; } }
        int ssel = csel;
#pragma unroll
        for (int o = 1; o < 64; o <<= 1) { const int t = __shfl_up(ssel, o); if (lane >= o) ssel += t; }
        if (lane == 63) WS1[8 + wave] = (unsigned)ssel;
        __syncthreads();
        int pos = ssel - csel;
        for (int w = 0; w < wave; ++w) pos += (int)WS1[8 + w];
        const int obase = (e * 8 + b) * CAP;
#pragma unroll
        for (int i = 0; i < 8; ++i) if (selmask & (1u << i)) { if (pos < CAP) { const int tok = b * SEQ + tid * 8 + i; ROWMAP[obase + pos] = tok; VAL[obase + pos] = __uint_as_float(key[i]); INV[(size_t)tok * 16 + e] = obase + pos; } ++pos; }
        __syncthreads();
    }
}

struct MoeGUOrder {
    static constexpr bool GATHER = true;
    const int* rowmap; int G, c;
    DI bool next(int i, pg8::Unit& u) const {
        const int cc = (G % 8 == 0) ? (c % 8) * (G / 8) + c / 8 : c;
        const int L = i * G + cc; if (L >= NE * 256) return false;
        const int e = L >> 8, loc = L & 255, xg = loc >> 5, r = loc & 31;
        u.pm = e * 16 + (xg >> 1) * 4 + (r >> 3); u.pn = (xg & 1) * 8 + (r & 7); return true;
    }
    DI size_t bt_row0(const pg8::Unit& u) const { return (size_t)(u.pm >> 4) * 4096 + (size_t)u.pn * 256; }
};
struct EpiGU {
    static constexpr bool PERM = true;
    unsigned char* ACT; LAS unsigned char* ebuf;
    DI void operator()(const f32x4 (&acc)[2][2][4][2], const pg8::Unit& u, int wr, int wc, int fr, int fq) const {
        int tid = threadIdx.x; asm volatile("" : "+v"(tid));
        if (wr == 0) __builtin_amdgcn_s_barrier();
#pragma unroll
        for (int ai = 0; ai < 2; ++ai) {
            if (ai) lds_barrier();
#pragma unroll
            for (int m = 0; m < 4; ++m) { float o[8];
#pragma unroll
                for (int n = 0; n < 2; ++n)
#pragma unroll
                    for (int j = 0; j < 4; ++j) o[4 * n + j] = silu_f(acc[ai][0][m][n][j]) * acc[ai][1][m][n][j];
                u32x2 w; w.x = pk_fp8x4(o[0], o[1], o[2], o[3]); w.y = pk_fp8x4(o[4], o[5], o[6], o[7]);
                *(LAS u32x2*)(ebuf + (wr * 64 + m * 16 + fr) * 144 + wc * 32 + 8 * fq) = w; }
            lds_barrier();
#pragma unroll
            for (int i = 0; i < 2; ++i) { const int q = tid + 512 * i, row = q >> 3, c16 = q & 7;
                const u32x4 v = *(const LAS u32x4*)(ebuf + row * 144 + c16 * 16);
                *(u32x4*)(ACT + (size_t)(u.pm * 256 + ai * 128 + row) * DEXP + u.pn * 128 + c16 * 16) = v; }
        }
        if (wr == 1) __builtin_amdgcn_s_barrier();
    }
};
struct MoeDownOrder {
    static constexpr bool GATHER = false;
    const int* rowmap; int G, c;
    DI bool next(int i, pg8::Unit& u) const {
        const int cc = (G % 8 == 0) ? (c % 8) * (G / 8) + c / 8 : c;
        const int L = i * G + cc; if (L >= 1024) return false;
        u.pm = L >> 2; u.pn = L & 3; return true;
    }
    DI size_t bt_row0(const pg8::Unit& u) const { return (size_t)(u.pm >> 4) * 1024 + (size_t)u.pn * 256; }
};
struct EpiDown {
    static constexpr bool PERM = true;
    const float* val; unsigned char* YB; LAS unsigned char* ebuf;
    DI void operator()(const f32x4 (&acc)[2][2][4][2], const pg8::Unit& u, int wr, int wc, int fr, int fq) const {
        int tid = threadIdx.x; asm volatile("" : "+v"(tid));
        if (wr == 0) __builtin_amdgcn_s_barrier();
#pragma unroll
        for (int ps = 0; ps < 4; ++ps) { const int ai = ps >> 1, mh = ps & 1;
            if (ps) lds_barrier();
#pragma unroll
            for (int mm = 0; mm < 2; ++mm) { const int m = 2 * mh + mm; const int r = u.pm * 256 + ai * 128 + wr * 64 + m * 16 + fr; const float v = val[r] * 16.f;
#pragma unroll
                for (int bj = 0; bj < 2; ++bj) { const f32x4 v0 = acc[ai][bj][m][0] * v, v1 = acc[ai][bj][m][1] * v;
                    u32x2 w; w.x = pk_fp8x4(v0[0], v0[1], v0[2], v0[3]); w.y = pk_fp8x4(v1[0], v1[1], v1[2], v1[3]);
                    *(LAS u32x2*)(ebuf + (wr * 32 + mm * 16 + fr) * 272 + bj * 128 + wc * 32 + 8 * fq) = w; } }
            lds_barrier();
#pragma unroll
            for (int i = 0; i < 2; ++i) { const int q = tid + 512 * i, lr = q >> 4, c16 = q & 15;
                const u32x4 vv = *(const LAS u32x4*)(ebuf + lr * 272 + c16 * 16);
                *(u32x4*)(YB + (size_t)(u.pm * 256 + ai * 128 + (lr >> 5) * 64 + mh * 32 + (lr & 31)) * DM + u.pn * 256 + c16 * 16) = vv; }
        }
        if (wr == 1) __builtin_amdgcn_s_barrier();
    }
};

DI void final_slots(const unsigned char* YB, int inv, int lane, unsigned& mask, int& cnt, unsigned (&yb)[4][4]) {
    mask = (unsigned)(__ballot(inv >= 0) & 0xffffull); cnt = __builtin_popcount(mask);
    unsigned mm = mask;
#pragma unroll
    for (int k = 0; k < 4; ++k) { if (mm != 0u) { const int e = __builtin_ctz(mm); mm &= mm - 1u; const int r = __builtin_amdgcn_readlane(inv, e);
            const unsigned* yr = (const unsigned*)(YB + (size_t)r * DM) + lane;
#pragma unroll
            for (int j = 0; j < 4; ++j) yb[k][j] = yr[64 * j]; } }
}
DI void phase_final(Ctx& F) {
    relaunder(F);
    const float* fw = kin(21); const float* MOD = (const float*)(F.ws + WS_MOD);
    const int* INV = (const int*)(F.ws + WS_INV); const unsigned char* YB = F.ws + WS_YB; const bf16_t* X1 = (const bf16_t*)(F.ws + WS_X1);
    const int gw = F.bid * 8 + F.wave, NGW = F.G * 8, lane = F.lane;
    if (gw >= NTOK) return;
    int inv_c = (lane < 16) ? INV[(size_t)gw * 16 + lane] : -1;
    int inv_n = (lane < 16 && gw + NGW < NTOK) ? INV[(size_t)(gw + NGW) * 16 + lane] : -1;
    u32x2 xc[4], xn[4];
    { const u32x2* x1r = (const u32x2*)(X1 + (size_t)gw * DM) + lane;
#pragma unroll
      for (int j = 0; j < 4; ++j) { xc[j] = x1r[64 * j]; xn[j] = xc[j]; } }
    unsigned ybc[4][4], ybn[4][4]; unsigned mask_c = 0u, mask_n = 0u; int cnt_c = 0, cnt_n = 0;
#pragma unroll
    for (int k = 0; k < 4; ++k)
#pragma unroll
        for (int j = 0; j < 4; ++j) { ybc[k][j] = 0u; ybn[k][j] = 0u; }
    final_slots(YB, inv_c, lane, mask_c, cnt_c, ybc);
    for (int m = gw; m < NTOK; m += NGW) {
        const int b = m >> 12, mn = m + NGW, mnn = m + 2 * NGW;
        int inv_nn = -1;
        if (mn < NTOK) { const u32x2* x1r = (const u32x2*)(X1 + (size_t)mn * DM) + lane;
#pragma unroll
            for (int j = 0; j < 4; ++j) xn[j] = x1r[64 * j];
            final_slots(YB, inv_n, lane, mask_n, cnt_n, ybn);
            if (lane < 16 && mnn < NTOK) inv_nn = INV[(size_t)mnn * 16 + lane]; }
        f32x4 v[4], a[4];
#pragma unroll
        for (int j = 0; j < 4; ++j) { v[j] = (f32x4){bflo(xc[j].x), bfhi(xc[j].x), bflo(xc[j].y), bfhi(xc[j].y)}; a[j] = (f32x4){0.f, 0.f, 0.f, 0.f}; }
#pragma unroll
        for (int k = 0; k < 4; ++k) if (k < cnt_c) {
#pragma unroll
            for (int j = 0; j < 4; ++j) { const f32v2 lo = __builtin_amdgcn_cvt_pk_f32_fp8(ybc[k][j], false), hi = __builtin_amdgcn_cvt_pk_f32_fp8(ybc[k][j], true);
                a[j].x += lo.x; a[j].y += lo.y; a[j].z += hi.x; a[j].w += hi.y; } }
        if (cnt_c > 4) {
            unsigned mm = mask_c; mm &= mm - 1u; mm &= mm - 1u; mm &= mm - 1u; mm &= mm - 1u;
            while (mm != 0u) { const int e = __builtin_ctz(mm); mm &= mm - 1u; const int r = __builtin_amdgcn_readlane(inv_c, e);
                const unsigned* yr = (const unsigned*)(YB + (size_t)r * DM) + lane;
#pragma unroll
                for (int j = 0; j < 4; ++j) { const unsigned y = yr[64 * j]; const f32v2 lo = __builtin_amdgcn_cvt_pk_f32_fp8(y, false), hi = __builtin_amdgcn_cvt_pk_f32_fp8(y, true);
                    a[j].x += lo.x; a[j].y += lo.y; a[j].z += hi.x; a[j].w += hi.y; } } }
        const f32x4* g4 = (const f32x4*)(MOD + b * 6144 + 5120) + lane;
        float s = 0.f;
#pragma unroll
        for (int j = 0; j < 4; ++j) { v[j] = v[j] + g4[64 * j] * a[j] * (1.f / 16.f); s += (v[j].x * v[j].x + v[j].y * v[j].y) + (v[j].z * v[j].z + v[j].w * v[j].w); }
        const float rstd = rsqrtf(wave_sum(s) * (1.f / DM) + 1e-6f);
        const f32x4* w4 = (const f32x4*)fw + lane;
        f32x4* xr = (f32x4*)(F.out + (size_t)m * DM) + lane;
#pragma unroll
        for (int j = 0; j < 4; ++j) xr[64 * j] = v[j] * rstd * w4[64 * j];
#pragma unroll
        for (int j = 0; j < 4; ++j) xc[j] = xn[j];
#pragma unroll
        for (int k = 0; k < 4; ++k)
#pragma unroll
            for (int j = 0; j < 4; ++j) ybc[k][j] = ybn[k][j];
        mask_c = mask_n; cnt_c = cnt_n; inv_c = inv_n; inv_n = inv_nn;
    }
}

__global__ void __launch_bounds__(512) fwd_megakernel(Params p) {
    extern __shared__ __attribute__((aligned(16))) unsigned char lds_raw[];
    cg::grid_group grid = cg::this_grid();
    Ctx F;
    F.lds = (LAS unsigned char*)lds_raw;
    F.tid = threadIdx.x; F.lane = F.tid & 63; F.wave = __builtin_amdgcn_readfirstlane(F.tid >> 6); F.G = gridDim.x; F.bid = blockIdx.x;
    F.out = p.out; F.ws = p.ws;

    {
        if (F.tid == 0) { ((LAS unsigned*)(F.lds + LDS_BYTES - 16))[0] = 0u; ((LAS unsigned*)(F.lds + LDS_BYTES - 16))[1] = 0u; }
        if (F.bid == 0) { unsigned* bw = (unsigned*)(F.ws + WS_BAR); for (int i = F.tid; i < XCD_BAR_WORDS + 256; i += 512) bw[i] = 0u; }
        __syncthreads();
    }
    phase0(F);
    grid.sync();
    const XcdBarrier xbar = xcd_barrier_post((unsigned*)(F.ws + WS_BAR), (volatile LAS unsigned*)(F.lds + LDS_BYTES - 16));
    phase_h(F);
    xcd_barrier(xbar);
    {
        pg8::RectOrder S; S.init(128, 19, F.G, F.bid); S.nextra = 8 * 11; S.ex_m0 = 128; S.ex_n0 = 8; S.ex_nm = 8;
        EpiInProj E{(bf16_t*)(F.ws + WS_R2), (bf16_t*)F.out, (bf16_t*)(F.ws + WS_R4), (float*)(F.ws + WS_R5), kin(10)};
        pg8::gemm_phase<false, false>(F.lds, F.ws + WS_R1, F.ws + WS_WIN, DM * 2, S, E);
    }
    xcd_barrier(xbar);
    fft_step1(F);
    conv_cb_phase(F);
    xcd_barrier(xbar);
    if (F.bid < 192) { const int x = F.bid & 7, j = F.bid >> 3, gi = x * 4 + j / 6;
        ssd_unit(F, gi >> 2, (gi & 3) * 6 + j % 6); }
    else {
        const int sb = F.bid, sg = F.G; F.bid = sb - 192; F.G = sg - 192; fft_step2(F); F.bid = sb; F.G = sg;
        __syncthreads();
        moe_weight_items(F, (sb - 192) * 8 + F.wave, (sg - 192) * 8);
    }
    xcd_barrier(xbar);
    {
        pg8::RectOrder S; S.init(128, 4, F.G, F.bid);
        EpiOutProj E{kin(0), (const float*)(F.ws + WS_MOD), (bf16_t*)(F.ws + WS_X1)};
        LAS float* rs_tab = (LAS float*)(F.lds + pg8::STAGE_BYTES);
        { const float* SS = (const float*)(F.ws + WS_SS);
          for (int i = F.tid; i < 512; i += 512) { pg8::Unit u; if (!S.next(i >> 8, u)) break;
              const float* sp = SS + (size_t)(u.pm * 256 + (i & 255)) * NH; float r[4];
#pragma unroll
              for (int g = 0; g < 4; ++g) { float t = 0.f;
#pragma unroll
                  for (int k = 0; k < 6; ++k) t += sp[g * 6 + k];
                  r[g] = rsqrtf(t * (1.f / 384.f) + 1e-6f); }
              LAS float* o = rs_tab + (size_t)i * 8;
              o[0] = 1.f / r[0]; o[1] = r[0] / r[1]; o[2] = r[1] / r[2]; o[3] = r[2] / r[3]; o[4] = r[3]; }
          __syncthreads(); }
        pg8::gemm_phase<false, true>(F.lds, F.ws + WS_R4, F.ws + WS_WOUT, DMIX * 2, S, E, rs_tab);
    }
    xcd_barrier(xbar);
    phase_router(F);
    xcd_barrier(xbar);
    phase_topk(F);
    xcd_barrier(xbar);
    {
        MoeGUOrder S; S.rowmap = (const int*)(F.ws + WS_ROWMAP); S.G = F.G; S.c = F.bid;
        EpiGU E{F.ws + WS_ACT, F.lds + pg8::STAGE_BYTES};
        pg8::gemm_phase<true, false>(F.lds, F.ws + WS_H2, F.ws + WS_WGU, DM, S, E);
    }
    xcd_barrier(xbar);
    {
        MoeDownOrder S; S.rowmap = nullptr; S.G = F.G; S.c = F.bid;
        EpiDown E{(const float*)(F.ws + WS_VAL), F.ws + WS_YB, F.lds + pg8::STAGE_BYTES};
        pg8::gemm_phase<true, false>(F.lds, F.ws + WS_ACT, F.ws + WS_WD, DEXP, S, E);
    }
    xcd_barrier(xbar);
    phase_final(F);
}

extern "C" void kernel_launch(void* const* d_in, const int* in_sizes, int n_in, void* d_out, int out_size, void* d_ws, size_t ws_size, hipStream_t stream) {
    static int grid_blocks = 0;
    if (!grid_blocks) {
        int dev = 0, cus = 0, per_cu = 0;
        (void)hipGetDevice(&dev);
        (void)hipDeviceGetAttribute(&cus, hipDeviceAttributeMultiprocessorCount, dev);
        (void)hipFuncSetAttribute((const void*)fwd_megakernel, hipFuncAttributeMaxDynamicSharedMemorySize, LDS_BYTES);
        (void)hipOccupancyMaxActiveBlocksPerMultiprocessor(&per_cu, (const void*)fwd_megakernel, 512, LDS_BYTES);
        if (per_cu < 1) per_cu = 1;
        grid_blocks = cus * per_cu;
        fprintf(stderr, "grid %d (cus %d per_cu %d) ws %zu need %zu\n", grid_blocks, cus, per_cu, ws_size, (size_t)WS_NEED);
        if (grid_blocks != 256) { fprintf(stderr, "this kernel's phase program is written for a 256-workgroup grid (one per CU); got %d\n", grid_blocks); grid_blocks = -1; }
        else if (ws_size < WS_NEED || n_in != 22) { fprintf(stderr, "workspace too small or bad inputs\n"); grid_blocks = -1; }
    }
    if (grid_blocks < 0) return;
    Params p{};
    for (int i = 0; i < 22; ++i) p.in[i] = (const float*)d_in[i];
    p.out = (float*)d_out; p.ws = (unsigned char*)d_ws;
    void* args[] = {&p};
    hipError_t e = hipLaunchCooperativeKernel((void*)fwd_megakernel, dim3(grid_blocks), dim3(512), args, LDS_BYTES, stream);
    if (e != hipSuccess) fprintf(stderr, "cooperative launch failed: %s (grid %d)\n", hipGetErrorString(e), grid_blocks);
}
```
